# Optimizing an MI355X kernel written in HIP

```python
import math
import jax, jax.numpy as jnp
from jax import lax
import numpy as np

D_MODEL = 1024
BATCH = 4
SEQ = 8192
DEPTH = 2

GRID_W = 64
CTX_LEN = 256
N_MIXERS = 2
N_MOD = 6
NORM_EPS = 1e-6
POS_BASE = 10000.0
RNN_WIDTH = 1280
RNN_HEADS = 5
RNN_BLOCK = RNN_WIDTH // RNN_HEADS
CONV_WIDTH = 4
CONV_PAD_LEFT = 2
CONV_PAD_RIGHT = CONV_WIDTH - 1 - CONV_PAD_LEFT
LRU_C = 8.0
LAMBDA_MIN = 0.9
LAMBDA_MAX = 0.999
SGU_WIDTH = 2048
SGU_HEADS = 8
SGU_GROUP = SGU_WIDTH // SGU_HEADS
CHUNK = 128
N_EXPERTS = 64
TOP_K = 8
N_GROUPS = 8
TOPK_GROUPS = 4
EXPERTS_PER_GROUP = N_EXPERTS // N_GROUPS
EXPERT_FF = 256
SHARED_FF = 256
ROUTED_SCALE = 2.5
MOE_BLOCK = 128

kernel_name = 'hybrid_rglru_sgu_moe_dit'


def rmsnorm(x, g):
    x32 = x.astype(jnp.float32)
    y = x32 * lax.rsqrt(jnp.mean(x32 * x32, axis=-1, keepdims=True) + NORM_EPS)
    return (y * g.astype(jnp.float32)).astype(x.dtype)


def layernorm(x, g, b):
    x32 = x.astype(jnp.float32)
    mu = jnp.mean(x32, axis=-1, keepdims=True)
    xc = x32 - mu
    y = xc * lax.rsqrt(jnp.mean(xc * xc, axis=-1, keepdims=True) + NORM_EPS)
    return (y * g.astype(jnp.float32) + b.astype(jnp.float32)).astype(x.dtype)


def sincos_2d(rows, d):
    quarter = d // 4
    omega = 1.0 / (POS_BASE ** (jnp.arange(quarter, dtype=jnp.float32) / quarter))
    def emb(n):
        p = jnp.arange(n, dtype=jnp.float32)[:, None] * omega[None, :]
        return jnp.concatenate([jnp.sin(p), jnp.cos(p)], axis=-1)
    er, ec = emb(rows), emb(GRID_W)
    pe = jnp.concatenate([jnp.broadcast_to(er[:, None, :], (rows, GRID_W, d // 2)),
                          jnp.broadcast_to(ec[None, :, :], (rows, GRID_W, d // 2))], axis=-1)
    return pe.reshape(rows * GRID_W, d)


def dwconv_centred(u, w, b):
    t = u.shape[1]
    up = jnp.pad(u, ((0, 0), (CONV_PAD_LEFT, CONV_PAD_RIGHT), (0, 0)))
    return sum(up[:, k:k + t] * w[k] for k in range(CONV_WIDTH)) + b


def lru_coeffs(u, r_w, r_b, i_w, i_b, lam, reset_first):
    u = u.astype(jnp.float32)
    ub = u.reshape(u.shape[:2] + (RNN_HEADS, RNN_BLOCK))
    r = jax.nn.sigmoid(jnp.einsum('bthi,hij->bthj', ub, r_w.astype(jnp.float32)).reshape(u.shape) + r_b.astype(jnp.float32))
    ig = jax.nn.sigmoid(jnp.einsum('bthi,hij->bthj', ub, i_w.astype(jnp.float32)).reshape(u.shape) + i_b.astype(jnp.float32))
    log_a = LRU_C * r * jax.nn.log_sigmoid(lam.astype(jnp.float32))
    a = jnp.exp(log_a)
    mult = jnp.sqrt(-jnp.expm1(2.0 * log_a))
    if reset_first:
        mult = mult.at[:, 0].set(1.0)
    return a, mult * ig * u


def linear_scan(a, b):
    def combine(l, r):
        return l[0] * r[0], r[0] * l[1] + r[1]
    _, h = lax.associative_scan(combine, (a, b), axis=1)
    return h


def rglru_mixer(hx, hc, w_in, conv_w, conv_b, r_w, r_b, i_w, i_b, lam, w_out, ctx_out):
    gate_x, ux = jnp.split(hx @ w_in, 2, axis=-1)
    ux = dwconv_centred(ux, conv_w, conv_b)
    uc = dwconv_centred(hc @ w_in[:, RNN_WIDTH:], conv_w, conv_b)
    yx = 0.0
    yc = 0.0
    for d in range(2):
        flip = (lambda t: jnp.flip(t, axis=1)) if d == 1 else (lambda t: t)
        a_c, b_c = lru_coeffs(flip(uc), r_w[d], r_b[d], i_w[d], i_b[d], lam[d], True)
        h_c = linear_scan(a_c, b_c)
        a_x, b_x = lru_coeffs(flip(ux), r_w[d], r_b[d], i_w[d], i_b[d], lam[d], False)
        b_x = b_x.at[:, 0].add(a_x[:, 0] * h_c[:, -1])
        yx = yx + flip(linear_scan(a_x, b_x))
        if ctx_out:
            yc = yc + flip(h_c)
    out_x = (jax.nn.gelu(gate_x) * yx.astype(hx.dtype)) @ w_out
    if not ctx_out:
        return out_x, None
    gate_c = hc @ w_in[:, :RNN_WIDTH]
    out_c = (jax.nn.gelu(gate_c) * yc.astype(hc.dtype)) @ w_out
    return out_x, out_c


def sgu_mixer(h, w_in, ln_g, ln_b, w_s, b_s, w_out):
    bsz, t, _ = h.shape
    u, v = jnp.split(jax.nn.gelu(h @ w_in), 2, axis=-1)
    v = layernorm(v, ln_g, ln_b)
    vc = v.reshape(bsz, t // CHUNK, CHUNK, SGU_HEADS, SGU_GROUP)
    sv = jnp.einsum('gpq,bnqgd->bnpgd', w_s, vc) + b_s.T[:, :, None]
    return (u * sv.reshape(bsz, t, SGU_WIDTH)) @ w_out


def swiglu(x, w_gu, w_down):
    g, u = jnp.split(x @ w_gu, 2, axis=-1)
    return (jax.nn.silu(g) * u) @ w_down


def moe_ffn(xn, router_w, router_b, w_gu, w_down, ws_gu, ws_down):
    n_tok, d = xn.shape
    scores = jax.nn.sigmoid(jnp.dot(xn.astype(jnp.float32), router_w.astype(jnp.float32)))
    sel = scores + router_b.astype(jnp.float32)
    grp_score = lax.top_k(sel.reshape(n_tok, N_GROUPS, EXPERTS_PER_GROUP), 2)[0].sum(-1)
    _, top_grp = lax.top_k(grp_score, TOPK_GROUPS)
    grp_keep = jnp.any(top_grp[:, :, None] == jnp.arange(N_GROUPS)[None, None, :], axis=1)
    keep = jnp.repeat(grp_keep, EXPERTS_PER_GROUP, axis=1)
    _, eidx = lax.top_k(jnp.where(keep, sel, -jnp.inf), TOP_K)
    gate = jnp.take_along_axis(scores, eidx, axis=1)
    gate = (gate / jnp.sum(gate, axis=-1, keepdims=True) * ROUTED_SCALE).astype(xn.dtype)
    n_assign = n_tok * TOP_K
    n_blocks = (n_assign + N_EXPERTS * (MOE_BLOCK - 1) + MOE_BLOCK - 1) // MOE_BLOCK
    n_pad = n_blocks * MOE_BLOCK
    flat_e = eidx.reshape(-1)
    flat_tok = jnp.repeat(jnp.arange(n_tok, dtype=jnp.int32), TOP_K)
    order = jnp.argsort(flat_e)
    se, stok, sw = flat_e[order], flat_tok[order], gate.reshape(-1)[order]
    counts = jax.ops.segment_sum(jnp.ones_like(flat_e), flat_e, num_segments=N_EXPERTS)
    padded = (counts + MOE_BLOCK - 1) // MOE_BLOCK * MOE_BLOCK
    pad_end = jnp.cumsum(padded)
    pad_start = pad_end - padded
    start = jnp.cumsum(counts) - counts
    dest = pad_start[se] + jnp.arange(n_assign, dtype=se.dtype) - start[se]
    buf_tok = jnp.full((n_pad,), n_tok, jnp.int32).at[dest].set(stok)
    buf_w = jnp.zeros((n_pad,), xn.dtype).at[dest].set(sw)
    block_e = jnp.minimum(jnp.searchsorted(pad_end, jnp.arange(n_blocks, dtype=pad_end.dtype) * MOE_BLOCK, side='right'), N_EXPERTS - 1)
    x_pad = jnp.concatenate([xn, jnp.zeros((1, d), xn.dtype)], axis=0)
    def expert_block(args):
        tok, w, e = args
        return swiglu(x_pad[tok], w_gu[e], w_down[e]) * w[:, None]
    y = lax.map(expert_block, (buf_tok.reshape(n_blocks, MOE_BLOCK), buf_w.reshape(n_blocks, MOE_BLOCK), block_e))
    routed = jax.ops.segment_sum(y.reshape(n_pad, d), buf_tok, num_segments=n_tok + 1)[:n_tok]
    return routed + swiglu(xn, ws_gu, ws_down)


def setup_inputs(seed: int = 0) -> dict:
    key = jax.random.key(seed)
    ks = iter(jax.random.split(key, 40))
    def nrm(shape, scale):
        return jax.random.normal(next(ks), shape, jnp.float32) * scale
    d = D_MODEL
    n_a = (DEPTH + N_MIXERS - 1) // N_MIXERS
    n_b = DEPTH // N_MIXERS
    lam_u = jax.random.uniform(next(ks), (n_a, 2, RNN_WIDTH), jnp.float32, LAMBDA_MIN, LAMBDA_MAX)
    return {
        'x': nrm((BATCH, SEQ, d), 1.0),
        'c': nrm((BATCH, d), 1.0),
        'ctx': nrm((BATCH, CTX_LEN, d), 1.0),
        'c_ctx': nrm((d,), 1.0),
        'ada_w': nrm((DEPTH, d, N_MOD * d), 0.5 * d ** -0.5),
        'ada_b': nrm((DEPTH, N_MOD * d), 0.02),
        'mix_norm_g': 1.0 + nrm((DEPTH, d), 0.02),
        'ffn_norm_g': 1.0 + nrm((DEPTH, d), 0.02),
        'a_w_in': nrm((n_a, d, 2 * RNN_WIDTH), d ** -0.5),
        'a_conv_w': nrm((n_a, CONV_WIDTH, RNN_WIDTH), CONV_WIDTH ** -0.5),
        'a_conv_b': nrm((n_a, RNN_WIDTH), 0.02),
        'a_gate_r_w': nrm((n_a, 2, RNN_HEADS, RNN_BLOCK, RNN_BLOCK), RNN_BLOCK ** -0.5),
        'a_gate_r_b': nrm((n_a, 2, RNN_WIDTH), 0.02),
        'a_gate_i_w': nrm((n_a, 2, RNN_HEADS, RNN_BLOCK, RNN_BLOCK), RNN_BLOCK ** -0.5),
        'a_gate_i_b': nrm((n_a, 2, RNN_WIDTH), 0.02),
        'a_lambda': jnp.log(lam_u) - jnp.log1p(-lam_u),
        'a_w_out': nrm((n_a, RNN_WIDTH, d), RNN_WIDTH ** -0.5),
        'b_w_in': nrm((n_b, d, 2 * SGU_WIDTH), d ** -0.5),
        'b_ln_g': 1.0 + nrm((n_b, SGU_WIDTH), 0.02),
        'b_ln_b': nrm((n_b, SGU_WIDTH), 0.02),
        'b_w_s': nrm((n_b, SGU_HEADS, CHUNK, CHUNK), CHUNK ** -0.5),
        'b_b_s': 1.0 + nrm((n_b, SGU_HEADS, CHUNK), 0.02),
        'b_w_out': nrm((n_b, SGU_WIDTH, d), SGU_WIDTH ** -0.5),
        'router_w': nrm((DEPTH, d, N_EXPERTS), d ** -0.5),
        'router_b': nrm((DEPTH, N_EXPERTS), 0.01),
        'moe_w_gu': nrm((DEPTH, N_EXPERTS, d, 2 * EXPERT_FF), d ** -0.5),
        'moe_w_down': nrm((DEPTH, N_EXPERTS, EXPERT_FF, d), EXPERT_FF ** -0.5),
        'shared_w_gu': nrm((DEPTH, d, 2 * SHARED_FF), d ** -0.5),
        'shared_w_down': nrm((DEPTH, SHARED_FF, d), SHARED_FF ** -0.5),
        'final_norm_g': 1.0 + nrm((d,), 0.02),
    }


def reference(x, c, ctx, c_ctx, ada_w, ada_b, mix_norm_g, ffn_norm_g,
              a_w_in, a_conv_w, a_conv_b, a_gate_r_w, a_gate_r_b, a_gate_i_w, a_gate_i_b, a_lambda, a_w_out,
              b_w_in, b_ln_g, b_ln_b, b_w_s, b_b_s, b_w_out,
              router_w, router_b, moe_w_gu, moe_w_down, shared_w_gu, shared_w_down, final_norm_g):
    bsz, s, d = x.shape
    rows = s // GRID_W
    x = x + sincos_2d(rows, d).astype(x.dtype)[None]
    cx = ctx
    silu_c = jax.nn.silu(c)
    silu_cc = jax.nn.silu(c_ctx)
    for i in range(DEPTH):
        kind, j = i % N_MIXERS, i // N_MIXERS
        ctx_live = any(l % N_MIXERS == 0 for l in range(i + 1, DEPTH))
        mod = silu_c @ ada_w[i] + ada_b[i]
        mod_c = silu_cc @ ada_w[i] + ada_b[i]
        sh1, sc1, g1, sh2, sc2, g2 = jnp.split(mod[:, None, :], N_MOD, axis=-1)
        csh1, csc1, cg1, csh2, csc2, cg2 = jnp.split(mod_c, N_MOD)
        hx = rmsnorm(x, mix_norm_g[i]) * (1.0 + sc1) + sh1
        if kind == 0:
            hc = rmsnorm(cx, mix_norm_g[i]) * (1.0 + csc1) + csh1
            yx, yc = rglru_mixer(hx, hc, a_w_in[j], a_conv_w[j], a_conv_b[j], a_gate_r_w[j], a_gate_r_b[j],
                                 a_gate_i_w[j], a_gate_i_b[j], a_lambda[j], a_w_out[j], ctx_live)
        else:
            yx = sgu_mixer(hx, b_w_in[j], b_ln_g[j], b_ln_b[j], b_w_s[j], b_b_s[j], b_w_out[j])
            if ctx_live:
                hc = rmsnorm(cx, mix_norm_g[i]) * (1.0 + csc1) + csh1
                yc = sgu_mixer(hc, b_w_in[j], b_ln_g[j], b_ln_b[j], b_w_s[j], b_b_s[j], b_w_out[j])
        x = x + g1 * yx
        if ctx_live:
            cx = cx + cg1 * yc
        hx = rmsnorm(x, ffn_norm_g[i]) * (1.0 + sc2) + sh2
        if ctx_live:
            hc = rmsnorm(cx, ffn_norm_g[i]) * (1.0 + csc2) + csh2
            n_c = hc.shape[0] * hc.shape[1]
            out = moe_ffn(jnp.concatenate([hc.reshape(-1, d), hx.reshape(-1, d)], axis=0), router_w[i], router_b[i],
                          moe_w_gu[i], moe_w_down[i], shared_w_gu[i], shared_w_down[i])
            cx = cx + cg2 * out[:n_c].reshape(cx.shape)
            x = x + g2 * out[n_c:].reshape(x.shape)
        else:
            out = moe_ffn(hx.reshape(-1, d), router_w[i], router_b[i], moe_w_gu[i], moe_w_down[i],
                          shared_w_gu[i], shared_w_down[i])
            x = x + g2 * out.reshape(x.shape)
    return rmsnorm(x, final_norm_g)
```

```cpp
#include <hip/hip_runtime.h>
#include <hip/hip_cooperative_groups.h>
#include <cstdio>
#include <cstdint>
namespace cg = cooperative_groups;

#define LAS __attribute__((address_space(3)))
typedef unsigned short bf16_t;
typedef short bf16x8 __attribute__((ext_vector_type(8)));
typedef float f32x4 __attribute__((ext_vector_type(4)));
typedef unsigned u32x4 __attribute__((ext_vector_type(4)));
typedef unsigned u32x2 __attribute__((ext_vector_type(2)));

constexpr int D = 1024, NB = 4, SEQ = 8192, NTOK = NB * SEQ, CTXL = 256, NCTX = NB * CTXL, NROW = NTOK + NCTX;
constexpr int RW = 1280;
constexpr int SW = 2048;
constexpr int NE = 64, TOPK = 8, EFF = 256;
constexpr int TM = 128;
constexpr int NSLOT = 278528;
constexpr int NTHR = 512;
constexpr int LDS_BYTES = 73728;

constexpr size_t MiB = (size_t)1 << 20;
constexpr size_t OFF_MOD = 1 * MiB;
constexpr size_t OFF_POS = OFF_MOD + 262144;
constexpr size_t OFF_CDEC = OFF_POS + 262144;
constexpr size_t OFF_CNT = OFF_CDEC + 16384;
constexpr size_t OFF_META = OFF_CNT + 65536;
constexpr size_t OFF_AGG = 2 * MiB;
constexpr size_t OFF_CARRY = 8 * MiB;
constexpr size_t OFF_EIDX = 11 * MiB;
constexpr size_t OFF_GATEW = 12 * MiB;
constexpr size_t OFF_SLOTOF = 13 * MiB;
constexpr size_t OFF_TOKOF = 14 * MiB;
constexpr size_t OFF_WOF = 16 * MiB;
constexpr size_t OFF_W = 18 * MiB;
constexpr size_t W_AIN = OFF_W;
constexpr size_t W_AOUT = W_AIN + (size_t)2560 * 1024 * 2;
constexpr size_t W_GATE = W_AOUT + (size_t)1024 * 1280 * 2;
constexpr size_t W_BIN = W_GATE + (size_t)5 * 1024 * 256 * 2;
constexpr size_t W_BOUT = W_BIN + (size_t)4096 * 1024 * 2;
constexpr size_t W_S = W_BOUT + (size_t)1024 * 2048 * 2;
constexpr size_t W_RT = W_S + (size_t)8 * 128 * 128 * 2;
constexpr size_t W_GU = W_RT + (size_t)2 * 128 * 3072 * 2;
constexpr size_t W_DN = W_GU + (size_t)2 * 65 * 512 * 1024 * 2;
constexpr size_t W_END = W_DN + (size_t)2 * 65 * 1024 * 256 * 2;
constexpr size_t OFF_HX = 237 * MiB;
constexpr size_t OFF_BIG = OFF_HX + 66 * MiB;
constexpr size_t B_GATE0 = OFF_BIG;
constexpr size_t B_UPRE = OFF_BIG + 80 * MiB;
constexpr size_t B_UU = OFF_BIG + 163 * MiB;
constexpr size_t B_Z0 = OFF_BIG + 246 * MiB;
constexpr size_t B_UV = OFF_BIG;
constexpr size_t B_VNT = OFF_BIG + 256 * MiB;
constexpr size_t B_Z1 = OFF_BIG + 384 * MiB;
constexpr size_t B_HLO = OFF_BIG;
constexpr size_t B_HH = OFF_BIG;
constexpr size_t B_YY = OFF_BIG + 160 * MiB;
constexpr size_t WS_NEED = OFF_BIG + 704 * MiB;
static_assert(W_END <= OFF_HX, "weights overflow");
static_assert((size_t)(NSLOT + NTOK) * 256 * 2 <= 160 * MiB, "H overflow");
static_assert((size_t)NSLOT * 1024 * 2 <= 544 * MiB, "Y overflow");
static_assert(WS_NEED <= 1024 * MiB, "ws overflow");
constexpr long LO_DELTA = (long)((B_HLO - OFF_HX) / 2);

__device__ __forceinline__ unsigned f2bf(float f) { unsigned u = __builtin_bit_cast(unsigned, f); return (u + 0x7fffu + ((u >> 16) & 1u)) >> 16; }
__device__ __forceinline__ unsigned pk2(float lo, float hi) { return f2bf(lo) | (f2bf(hi) << 16); }
__device__ __forceinline__ float bf2f(unsigned b) { return __builtin_bit_cast(float, b << 16); }
__device__ __forceinline__ float bflo(unsigned w) { return __builtin_bit_cast(float, w << 16); }
__device__ __forceinline__ float bfhi(unsigned w) { return __builtin_bit_cast(float, w & 0xffff0000u); }
__device__ __forceinline__ float sigm(float x) { return 1.0f / (1.0f + __expf(-x)); }
__device__ __forceinline__ float silu(float x) { return x / (1.0f + __expf(-x)); }
__device__ __forceinline__ float gelu_t(float x) { const float y = 1.5957691216057308f * (x + 0.044715f * x * x * x); return x / (1.0f + __expf(-y)); }
__device__ __forceinline__ float wave_sum(float v) {
#pragma unroll
    for (int o = 1; o < 64; o <<= 1) v += __shfl_xor(v, o);
    return v;
}

struct Params { const float* in[30]; float* out; unsigned char* ws; };

struct KDef { __device__ __forceinline__ long operator()(int kt) const { return (long)kt * 32; } };

template <class KOffA, class Epi>
__device__ __forceinline__ void gemm_tile(const bf16_t* arow, const bf16_t* brow, int nk, KOffA koffa, Epi epi, LAS unsigned char* lds) {
    const int tid = threadIdx.x, lane = tid & 63, wid = tid >> 6, wr = wid >> 2, wc = wid & 3, fr = lane & 15, fq = lane >> 4;
    const int sw = (tid >> 2) * 80 + (tid & 3) * 16;
    f32x4 acc[4][2];
#pragma unroll
    for (int m = 0; m < 4; ++m)
#pragma unroll
        for (int n = 0; n < 2; ++n) acc[m][n] = (f32x4){0.f, 0.f, 0.f, 0.f};
    u32x4 ra = *(const u32x4*)(arow + koffa(0));
    u32x4 rb = *(const u32x4*)(brow);
    const int aoff = (wr * 64 + fr) * 80 + fq * 16, boff = 10240 + (wc * 32 + fr) * 80 + fq * 16;
    for (int kt = 0; kt < nk; ++kt) {
        LAS unsigned char* buf = lds + (kt & 1) * 20480;
        *(LAS u32x4*)(buf + sw) = ra;
        *(LAS u32x4*)(buf + 10240 + sw) = rb;
        __syncthreads();
        if (kt + 1 < nk) { ra = *(const u32x4*)(arow + koffa(kt + 1)); rb = *(const u32x4*)(brow + (long)(kt + 1) * 32); }
        bf16x8 af[4], bfv[2];
#pragma unroll
        for (int m = 0; m < 4; ++m) af[m] = *(LAS bf16x8*)(buf + aoff + m * 1280);
#pragma unroll
        for (int n = 0; n < 2; ++n) bfv[n] = *(LAS bf16x8*)(buf + boff + n * 1280);
#pragma unroll
        for (int m = 0; m < 4; ++m)
#pragma unroll
            for (int n = 0; n < 2; ++n) acc[m][n] = __builtin_amdgcn_mfma_f32_16x16x32_bf16(bfv[n], af[m], acc[m][n], 0, 0, 0);
    }
    __syncthreads();
#pragma unroll
    for (int m = 0; m < 4; ++m)
#pragma unroll
        for (int n = 0; n < 2; ++n) epi(wr * 64 + m * 16 + fr, wc * 32 + n * 16 + fq * 4, acc[m][n]);
}

__device__ __forceinline__ void tr_item(const float* W, int N, int k0, int n0, bf16_t* WT, int ldt, int mode, int rmul, int radd, LAS float* scr, int lane) {
#pragma unroll 8
    for (int i = 0; i < 32; ++i) { const int kk = 2 * i + (lane >> 5); scr[kk * 33 + (lane & 31)] = W[(size_t)(k0 + kk) * N + n0 + (lane & 31)]; }
    asm volatile("s_waitcnt lgkmcnt(0)" ::: "memory");
    const int c = lane & 7;
#pragma unroll
    for (int j = 0; j < 4; ++j) {
        const int n = (lane >> 3) + 8 * j; const LAS float* s = scr + (8 * c) * 33 + n;
        u32x4 o; o.x = pk2(s[0 * 33], s[1 * 33]); o.y = pk2(s[2 * 33], s[3 * 33]); o.z = pk2(s[4 * 33], s[5 * 33]); o.w = pk2(s[6 * 33], s[7 * 33]);
        const int ng = n0 + n;
        const int drow = mode == 1 ? ((ng & 255) * 2 + (ng >> 8)) : ng * rmul + radd;
        *(u32x4*)(WT + (size_t)drow * ldt + k0 + 8 * c) = o;
    }
    asm volatile("s_waitcnt lgkmcnt(0)" ::: "memory");
}

__device__ __forceinline__ void phase0(const Params& p, LAS unsigned char* lds, int bid, int nblk) {
    const int tid = threadIdx.x, lane = tid & 63, wid = tid >> 6;
    unsigned char* ws = p.ws;
    const int gt = bid * NTHR + tid, ngt = nblk * NTHR;
    float* pos = (float*)(ws + OFF_POS);
    for (int i = gt; i < 128 * 512; i += ngt) {
        const int r = i >> 9, c = i & 511, q = c & 255;
        const float omega = 1.0f / exp2f((float)q * (13.287712379549449f / 256.0f));
        const float ang = (float)r * omega;
        pos[i] = c < 256 ? __sinf(ang) : __cosf(ang);
    }
    float* cdec = (float*)(ws + OFF_CDEC);
    for (int i = gt; i < 2 * RW; i += ngt) cdec[i] = -8.0f * log1pf(expf(-p.in[15][i]));
    {
        bf16_t* ws_s = (bf16_t*)(ws + W_S);
        for (int i = gt; i < 8 * 128 * 128; i += ngt) ws_s[i] = (bf16_t)f2bf(p.in[20][i]);
        bf16_t* wrt = (bf16_t*)(ws + W_RT);
        for (int i = gt; i < 2 * 1024 * 64; i += ngt) {
            const int l = i >> 16, k = (i >> 6) & 1023, e = i & 63;
            const float w = p.in[23][i];
            const unsigned hi = f2bf(w); const unsigned lo = f2bf(w - bf2f(hi));
            bf16_t* row = wrt + ((size_t)(l * 128 + e)) * 3072;
            row[k] = (bf16_t)hi; row[1024 + k] = (bf16_t)hi; row[2048 + k] = (bf16_t)lo;
        }
        unsigned* wz = (unsigned*)wrt;
        for (int i = gt; i < 2 * 64 * 1536; i += ngt) { const int l = i / (64 * 1536), r = i % (64 * 1536); wz[(size_t)(l * 128 + 64) * 1536 + r] = 0u; }
    }
    for (int it = bid; it < 192; it += nblk) {
        LAS float* sv = (LAS float*)lds;
        LAS float* red = (LAS float*)(lds + 20480);
        for (int i = tid; i < 5 * 1024; i += NTHR) { const float cv = i < 4096 ? p.in[1][i] : p.in[3][i - 4096]; sv[i] = silu(cv); }
        __syncthreads();
        const int l = it / 96, col0 = (it % 96) * 64;
        const float* w = p.in[4] + (size_t)l * 1024 * 6144 + col0 + lane;
        float a0 = 0.f, a1 = 0.f, a2 = 0.f, a3 = 0.f, a4 = 0.f;
        const int kb = wid * 128;
#pragma unroll 8
        for (int k = kb; k < kb + 128; ++k) {
            const float wv = w[(size_t)k * 6144];
            a0 += sv[k] * wv; a1 += sv[1024 + k] * wv; a2 += sv[2048 + k] * wv; a3 += sv[3072 + k] * wv; a4 += sv[4096 + k] * wv;
        }
        red[(wid * 5 + 0) * 64 + lane] = a0; red[(wid * 5 + 1) * 64 + lane] = a1; red[(wid * 5 + 2) * 64 + lane] = a2;
        red[(wid * 5 + 3) * 64 + lane] = a3; red[(wid * 5 + 4) * 64 + lane] = a4;
        __syncthreads();
        if (tid < 320) {
            const int v = tid >> 6, ln = tid & 63; float s = 0.f;
#pragma unroll
            for (int w8 = 0; w8 < 8; ++w8) s += red[(w8 * 5 + v) * 64 + ln];
            ((float*)(ws + OFF_MOD))[(size_t)(l * 5 + v) * 6144 + col0 + ln] = s + p.in[5][l * 6144 + col0 + ln];
        }
        __syncthreads();
    }
    LAS float* scr = (LAS float*)(lds + wid * 8448);
    const int gw = bid * 8 + wid, ngw = nblk * 8;
    constexpr int I_AIN = 16 * 80, I_AOUT = 20 * 32, I_GATE = 20 * 32, I_BIN = 16 * 128, I_BOUT = 32 * 32, I_GU = 2 * 65 * 256, I_DN = 2 * 65 * 128;
    constexpr int NITEMS = I_AIN + I_AOUT + I_GATE + I_BIN + I_BOUT + I_GU + I_DN;
    for (int it = gw; it < NITEMS; it += ngw) {
        int r = it;
        if (r < I_GU) {
            const int le = r >> 8, q = r & 255, l = le / 65, e = le % 65, kb = q >> 4, nb = q & 15;
            const float* src = e < 64 ? p.in[25] + (size_t)(l * 64 + e) * 1024 * 512 : p.in[27] + (size_t)l * 1024 * 512;
            tr_item(src, 512, kb * 64, nb * 32, (bf16_t*)(ws + W_GU) + (size_t)le * 512 * 1024, 1024, 1, 1, 0, scr, lane); continue; }
        r -= I_GU;
        if (r < I_DN) {
            const int le = r >> 7, q = r & 127, l = le / 65, e = le % 65, kb = q >> 5, nb = q & 31;
            const float* src = e < 64 ? p.in[26] + (size_t)(l * 64 + e) * 256 * 1024 : p.in[28] + (size_t)l * 256 * 1024;
            tr_item(src, 1024, kb * 64, nb * 32, (bf16_t*)(ws + W_DN) + (size_t)le * 1024 * 256, 256, 0, 1, 0, scr, lane); continue; }
        r -= I_DN;
        if (r < I_AIN) { const int kb = r / 80, nb = r % 80; tr_item(p.in[8], 2560, kb * 64, nb * 32, (bf16_t*)(ws + W_AIN), 1024, 0, 1, 0, scr, lane); continue; }
        r -= I_AIN;
        if (r < I_AOUT) { const int kb = r / 32, nb = r % 32; tr_item(p.in[16], 1024, kb * 64, nb * 32, (bf16_t*)(ws + W_AOUT), 1280, 0, 1, 0, scr, lane); continue; }
        r -= I_AOUT;
        if (r < I_GATE) {
            const int mi = r >> 5, q = r & 31, kb = q >> 3, nb = q & 7, h = mi % 5, dg = mi / 5, d = dg >> 1, g = dg & 1;
            const float* src = (g ? p.in[13] : p.in[11]) + (size_t)(d * 5 + h) * 65536;
            tr_item(src, 256, kb * 64, nb * 32, (bf16_t*)(ws + W_GATE) + (size_t)h * 1024 * 256, 256, 0, 4, d * 2 + g, scr, lane); continue; }
        r -= I_GATE;
        if (r < I_BIN) { const int kb = r / 128, nb = r % 128; tr_item(p.in[17], 4096, kb * 64, nb * 32, (bf16_t*)(ws + W_BIN), 1024, 0, 1, 0, scr, lane); continue; }
        r -= I_BIN;
        { const int kb = r / 32, nb = r % 32; tr_item(p.in[22], 1024, kb * 64, nb * 32, (bf16_t*)(ws + W_BOUT), 2048, 0, 1, 0, scr, lane); }
    }
}

template <int MODE, bool WRITE_LO, bool FINAL>
__device__ __forceinline__ void row_phase(const Params& p, int bid, int nblk, const float* gnorm, const float* modl  , int off_sh, int off_sc,
                                           const float* modprev  ) {
    const int tid = threadIdx.x, lane = tid & 63, wid = tid >> 6;
    unsigned char* ws = p.ws;
    float* xres = p.out;
    bf16_t* hx = (bf16_t*)(ws + OFF_HX);
    bf16_t* hlo = (bf16_t*)(ws + B_HLO);
    const float* pos = (const float*)(ws + OFF_POS);
    const int* slotof = (const int*)(ws + OFF_SLOTOF);
    const bf16_t* Y = (const bf16_t*)(ws + B_YY);
    const int nrows = MODE == 0 ? NROW : NTOK;
    for (int row = bid * 8 + wid; row < nrows; row += nblk * 8) {
        f32x4 v[4];
        int mv;
        if (MODE == 0) {
            if (row < NTOK) {
                mv = row >> 13; const int t = row & (SEQ - 1);
                const f32x4* xr = (const f32x4*)(p.in[0] + (size_t)row * D) + lane;
                const f32x4* pr = (const f32x4*)(pos + (size_t)(t >> 6) * 512) + lane;
                const f32x4* pc = (const f32x4*)(pos + (size_t)(t & 63) * 512) + lane;
                v[0] = xr[0] + pr[0]; v[1] = xr[64] + pr[64]; v[2] = xr[128] + pc[0]; v[3] = xr[192] + pc[64];
                f32x4* xo = (f32x4*)(xres + (size_t)row * D) + lane;
#pragma unroll
                for (int j = 0; j < 4; ++j) xo[64 * j] = v[j];
            } else {
                mv = 4;
                const f32x4* xr = (const f32x4*)(p.in[2] + (size_t)(row - NTOK) * D) + lane;
#pragma unroll
                for (int j = 0; j < 4; ++j) v[j] = xr[64 * j];
            }
        } else {
            mv = row >> 13;
            f32x4* xo = (f32x4*)(xres + (size_t)row * D) + lane;
#pragma unroll
            for (int j = 0; j < 4; ++j) v[j] = xo[64 * j];
            if (MODE == 2) {
                f32x4 s[4];
#pragma unroll
                for (int j = 0; j < 4; ++j) s[j] = (f32x4){0.f, 0.f, 0.f, 0.f};
#pragma unroll
                for (int k = 0; k < TOPK; ++k) {
                    const int slot = slotof[row * 8 + k];
                    const u32x2* yr = (const u32x2*)(Y + (size_t)slot * D) + lane;
#pragma unroll
                    for (int j = 0; j < 4; ++j) { const u32x2 w = yr[64 * j]; s[j].x += bflo(w.x); s[j].y += bfhi(w.x); s[j].z += bflo(w.y); s[j].w += bfhi(w.y); }
                }
                const f32x4* g2 = (const f32x4*)(modprev + (size_t)mv * 6144 + 5120) + lane;
#pragma unroll
                for (int j = 0; j < 4; ++j) { v[j] = v[j] + g2[64 * j] * s[j]; if (!FINAL) xo[64 * j] = v[j]; }
            }
        }
        float ss = 0.f;
#pragma unroll
        for (int j = 0; j < 4; ++j) ss += (v[j].x * v[j].x + v[j].y * v[j].y) + (v[j].z * v[j].z + v[j].w * v[j].w);
        ss = wave_sum(ss);
        const float rinv = 1.0f / sqrtf(ss * (1.0f / D) + 1e-6f);
        const f32x4* gn = (const f32x4*)gnorm + lane;
        if (FINAL) {
            f32x4* xo = (f32x4*)(xres + (size_t)row * D) + lane;
#pragma unroll
            for (int j = 0; j < 4; ++j) xo[64 * j] = v[j] * rinv * gn[64 * j];
        } else {
            const f32x4* sh = (const f32x4*)(modl + (size_t)mv * 6144 + off_sh) + lane;
            const f32x4* sc = (const f32x4*)(modl + (size_t)mv * 6144 + off_sc) + lane;
            u32x2* ho = (u32x2*)(hx + (size_t)row * D) + lane;
            u32x2* lo = (u32x2*)(hlo + (size_t)row * D) + lane;
#pragma unroll
            for (int j = 0; j < 4; ++j) {
                const f32x4 y = v[j] * rinv * gn[64 * j] * (sc[64 * j] + 1.0f) + sh[64 * j];
                u32x2 w; w.x = pk2(y.x, y.y); w.y = pk2(y.z, y.w);
                ho[64 * j] = w;
                if (WRITE_LO) { u32x2 q; q.x = pk2(y.x - bflo(w.x), y.y - bfhi(w.x)); q.y = pk2(y.z - bflo(w.y), y.w - bfhi(w.y)); lo[64 * j] = q; }
            }
        }
    }
}

__device__ __forceinline__ void phase_inproj0(const Params& p, LAS unsigned char* lds, int bid, int nblk) {
    unsigned char* ws = p.ws;
    const bf16_t* hx = (const bf16_t*)(ws + OFF_HX); const bf16_t* W = (const bf16_t*)(ws + W_AIN);
    bf16_t* gate0 = (bf16_t*)(ws + B_GATE0); bf16_t* upre = (bf16_t*)(ws + B_UPRE);
    const int tid = threadIdx.x, srow = tid >> 2, skc = (tid & 3) * 8;
    constexpr int NU = 256 * 20 + 8 * 10;
    for (int u = bid; u < NU; u += nblk) {
        int mt, nt;
        if (u < 5120) { mt = u / 20; nt = u % 20; } else { const int q = u - 5120; mt = 256 + q / 10; nt = 10 + q % 10; }
        const bf16_t* arow = hx + (size_t)(mt * 128 + srow) * D + skc;
        const bf16_t* brow = W + (size_t)(nt * 128 + srow) * D + skc;
        gemm_tile(arow, brow, 32, KDef(), [=](int r, int c, f32x4 v) {
            const int row = mt * 128 + r, col = nt * 128 + c;
            if (col < RW) { u32x2 w; w.x = pk2(gelu_t(v.x), gelu_t(v.y)); w.y = pk2(gelu_t(v.z), gelu_t(v.w)); *(u32x2*)(gate0 + (size_t)row * RW + col) = w; }
            else { u32x2 w; w.x = pk2(v.x, v.y); w.y = pk2(v.z, v.w); *(u32x2*)(upre + (size_t)row * RW + (col - RW)) = w; }
        }, lds);
    }
}

__device__ __forceinline__ void phase_conv(const Params& p, int bid, int nblk) {
    unsigned char* ws = p.ws;
    const bf16_t* upre = (const bf16_t*)(ws + B_UPRE); bf16_t* uu = (bf16_t*)(ws + B_UU);
    const float* cw = p.in[9]; const float* cb = p.in[10];
    const int gt = bid * NTHR + threadIdx.x, ngt = nblk * NTHR;
    for (int i = gt; i < NROW * 160; i += ngt) {
        const int R = i / 160, cg8 = (i % 160) * 8;
        int t, T;
        if (R < NTOK) { t = R & (SEQ - 1); T = SEQ; } else { t = (R - NTOK) & (CTXL - 1); T = CTXL; }
        float o[8];
#pragma unroll
        for (int j = 0; j < 8; ++j) o[j] = cb[cg8 + j];
#pragma unroll
        for (int k = 0; k < 4; ++k) {
            const int tt = t + k - 2;
            if (tt >= 0 && tt < T) {
                const u32x4 w = *(const u32x4*)(upre + (size_t)(R + k - 2) * RW + cg8);
                const float* wk = cw + k * RW + cg8;
                o[0] += wk[0] * bflo(w.x); o[1] += wk[1] * bfhi(w.x); o[2] += wk[2] * bflo(w.y); o[3] += wk[3] * bfhi(w.y);
                o[4] += wk[4] * bflo(w.z); o[5] += wk[5] * bfhi(w.z); o[6] += wk[6] * bflo(w.w); o[7] += wk[7] * bfhi(w.w);
            }
        }
        u32x4 r; r.x = pk2(o[0], o[1]); r.y = pk2(o[2], o[3]); r.z = pk2(o[4], o[5]); r.w = pk2(o[6], o[7]);
        *(u32x4*)(uu + (size_t)R * RW + cg8) = r;
    }
}

template <bool FULL>
__device__ __forceinline__ void phase_gates(const Params& p, LAS unsigned char* lds, int bid, int nblk) {
    unsigned char* ws = p.ws;
    const bf16_t* uu = (const bf16_t*)(ws + B_UU); const bf16_t* Wg = (const bf16_t*)(ws + W_GATE);
    const bf16_t* gate0 = (const bf16_t*)(ws + B_GATE0); bf16_t* z0 = (bf16_t*)(ws + B_Z0);
    const float* cdec = (const float*)(ws + OFF_CDEC);
    float* agg = (float*)(ws + OFF_AGG); const float* carry = (const float*)(ws + OFF_CARRY);
    const float* rbias = p.in[12]; const float* ibias = p.in[14];
    const int tid = threadIdx.x, lane = tid & 63, wid = tid >> 6, srow = tid >> 2, skc = (tid & 3) * 8;
    const int nunits = (FULL ? 256 : 264) * 40;
    LAS float* sagg = (LAS float*)(lds + 65536);
    LAS float* subc = (LAS float*)(lds + 65536 + 4096);
    for (int u = bid; u < nunits; u += nblk) {
        const int chunk = u / 40, rem = u % 40, h = rem >> 3, s = rem & 7, R0 = chunk * 128, chb = h * 256 + s * 32;
        const bf16_t* arow = uu + (size_t)(R0 + srow) * RW + h * 256 + skc;
        const bf16_t* brow = Wg + (size_t)(h * 1024 + s * 128 + srow) * 256 + skc;
        gemm_tile(arow, brow, 8, KDef(), [=](int r, int c, f32x4 v) {
            const int jj = c >> 2, ch = chb + jj;
            const float uval = bf2f(uu[(size_t)(R0 + r) * RW + ch]);
            const float r0 = sigm(v.x + rbias[ch]), i0 = sigm(v.y + ibias[ch]), r1 = sigm(v.z + rbias[RW + ch]), i1 = sigm(v.w + ibias[RW + ch]);
            const float la0 = r0 * cdec[ch], la1 = r1 * cdec[RW + ch];
            const float a0 = __expf(la0), a1 = __expf(la1);
            float m0 = sqrtf(-expm1f(2.0f * la0)), m1 = sqrtf(-expm1f(2.0f * la1));
            if (chunk >= 256) { const int ts = ((chunk - 256) & 1) * 128 + r; if (ts == 0) m0 = 1.0f; if (ts == CTXL - 1) m1 = 1.0f; }
            *(LAS f32x4*)(lds + (r * 32 + jj) * 16) = (f32x4){a0, m0 * i0 * uval, a1, m1 * i1 * uval};
        }, lds);
        __syncthreads();
        {
            const int d = lane >> 5, jj = lane & 31;
            float A = 1.0f, Hh = 0.0f;
#pragma unroll 4
            for (int i = 0; i < 16; ++i) {
                const int t = d == 0 ? wid * 16 + i : wid * 16 + 15 - i;
                LAS float* e = (LAS float*)(lds + (t * 32 + jj) * 16 + d * 8);
                const float a = e[0], b = e[1];
                Hh = a * Hh + b; A *= a;
                e[0] = A; e[1] = Hh;
            }
            sagg[((wid * 2 + d) * 32 + jj) * 2 + 0] = A; sagg[((wid * 2 + d) * 32 + jj) * 2 + 1] = Hh;
        }
        __syncthreads();
        if (wid == 0) {
            const int d = lane >> 5, jj = lane & 31, ch = chb + jj;
            if (!FULL) {
                float At = 1.0f, Ht = 0.0f;
#pragma unroll
                for (int i = 0; i < 8; ++i) { const int w = d == 0 ? i : 7 - i; const float A = sagg[((w * 2 + d) * 32 + jj) * 2], Hh = sagg[((w * 2 + d) * 32 + jj) * 2 + 1]; Ht = A * Ht + Hh; At *= A; }
                float* o = agg + ((size_t)(d * 264 + chunk) * RW + ch) * 2;
                o[0] = At; o[1] = Ht;
            } else {
                float c = carry[(size_t)(d * 256 + chunk) * RW + ch];
#pragma unroll
                for (int i = 0; i < 8; ++i) { const int w = d == 0 ? i : 7 - i; subc[(w * 2 + d) * 32 + jj] = c; const float A = sagg[((w * 2 + d) * 32 + jj) * 2], Hh = sagg[((w * 2 + d) * 32 + jj) * 2 + 1]; c = A * c + Hh; }
            }
        }
        if (FULL) {
            __syncthreads();
#pragma unroll
            for (int i = 0; i < 8; ++i) {
                const int e = tid + NTHR * i, t = e >> 5, jj = e & 31, w = t >> 4;
                const f32x4 q = *(LAS f32x4*)(lds + (t * 32 + jj) * 16);
                const float y = (q.y + q.x * subc[(w * 2 + 0) * 32 + jj]) + (q.w + q.z * subc[(w * 2 + 1) * 32 + jj]);
                const size_t gi = (size_t)(R0 + t) * RW + chb + jj;
                z0[gi] = (bf16_t)f2bf(bf2f(gate0[gi]) * y);
            }
        }
        __syncthreads();
    }
}

__device__ __forceinline__ void phase_carry(const Params& p, int bid, int nblk) {
    unsigned char* ws = p.ws;
    const float* agg = (const float*)(ws + OFF_AGG); float* carry = (float*)(ws + OFF_CARRY);
    const int gt = bid * NTHR + threadIdx.x, ngt = nblk * NTHR;
    for (int i = gt; i < 2 * NB * RW; i += ngt) {
        const int d = i / (NB * RW), b = (i / RW) % NB, ch = i % RW;
        float h = 0.0f;
        for (int j = 0; j < 2; ++j) { const int c = d == 0 ? j : 1 - j; const float* a = agg + ((size_t)(d * 264 + 256 + b * 2 + c) * RW + ch) * 2; h = a[0] * h + a[1]; }
        for (int j = 0; j < 64; ++j) {
            const int c = d == 0 ? j : 63 - j; const int chunk = b * 64 + c;
            carry[(size_t)(d * 256 + chunk) * RW + ch] = h;
            const float* a = agg + ((size_t)(d * 264 + chunk) * RW + ch) * 2; h = a[0] * h + a[1];
        }
    }
}

__device__ __forceinline__ void phase_outproj(const Params& p, LAS unsigned char* lds, int bid, int nblk, const bf16_t* Z, int K, const bf16_t* W, const float* modl) {
    float* xres = p.out;
    const int tid = threadIdx.x, srow = tid >> 2, skc = (tid & 3) * 8;
    for (int u = bid; u < 256 * 8; u += nblk) {
        const int mt = u >> 3, nt = u & 7;
        const bf16_t* arow = Z + (size_t)(mt * 128 + srow) * K + skc;
        const bf16_t* brow = W + (size_t)(nt * 128 + srow) * K + skc;
        gemm_tile(arow, brow, K / 32, KDef(), [=](int r, int c, f32x4 v) {
            const int row = mt * 128 + r, col = nt * 128 + c;
            const f32x4 g1 = *(const f32x4*)(modl + (size_t)(row >> 13) * 6144 + 2048 + col);
            f32x4* xo = (f32x4*)(xres + (size_t)row * D + col);
            *xo = *xo + g1 * v;
        }, lds);
    }
}

struct KRouter { __device__ __forceinline__ long operator()(int kt) const { return kt < 32 ? (long)kt * 32 : (kt < 64 ? LO_DELTA + (long)(kt - 32) * 32 : (long)(kt - 64) * 32); } };

__device__ __forceinline__ void phase_router(const Params& p, LAS unsigned char* lds, int bid, int nblk, int l) {
    unsigned char* ws = p.ws;
    const bf16_t* hx = (const bf16_t*)(ws + OFF_HX); const bf16_t* W = (const bf16_t*)(ws + W_RT) + (size_t)l * 128 * 3072;
    const float* rb = p.in[24] + l * 64;
    int* eidx = (int*)(ws + OFF_EIDX); float* gatew = (float*)(ws + OFF_GATEW); int* cnt = (int*)(ws + OFF_CNT);
    const int tid = threadIdx.x, srow = tid >> 2, skc = (tid & 3) * 8;
    LAS float* L = (LAS float*)lds;
    LAS float* S = (LAS float*)(lds + 33280);
    LAS int* LE = (LAS int*)(lds + 66560);
    for (int rt = bid; rt < 256; rt += nblk) {
        const bf16_t* arow = hx + (size_t)(rt * 128 + srow) * D + skc;
        const bf16_t* brow = W + (size_t)srow * 3072 + skc;
        gemm_tile(arow, brow, 96, KRouter(), [=](int r, int c, f32x4 v) {
            if (c < 64) { LAS float* o = L + r * 65 + c; o[0] = v.x; o[1] = v.y; o[2] = v.z; o[3] = v.w; }
        }, lds + 0);
        __syncthreads();
        if (tid < 128) {
            LAS float* Lr = L + tid * 65; LAS float* Sr = S + tid * 65;
            float gs[8];
#pragma unroll
            for (int g = 0; g < 8; ++g) {
                float m1 = -__builtin_inff(), m2 = -__builtin_inff();
#pragma unroll
                for (int i = 0; i < 8; ++i) {
                    const int e = g * 8 + i;
                    const float sc = sigm(Lr[e]); const float sl = sc + rb[e];
                    Sr[e] = sc; Lr[e] = sl;
                    if (sl > m1) { m2 = m1; m1 = sl; } else if (sl > m2) m2 = sl;
                }
                gs[g] = m1 + m2;
            }
            unsigned keep = 0u;
#pragma unroll
            for (int g = 0; g < 8; ++g) {
                int rank = 0;
#pragma unroll
                for (int g2 = 0; g2 < 8; ++g2) rank += (gs[g2] > gs[g] || (gs[g2] == gs[g] && g2 < g)) ? 1 : 0;
                if (rank < 4) keep |= 1u << g;
            }
            int ch[8]; float cs[8]; float ssum = 0.0f;
#pragma unroll
            for (int k = 0; k < 8; ++k) {
                float best = -__builtin_inff(); int be = 0;
                for (int e = 0; e < 64; ++e) {
                    const float v = Lr[e];
                    if (((keep >> (e >> 3)) & 1u) && v > best) { best = v; be = e; }
                }
                Lr[be] = -__builtin_inff();
                ch[k] = be; cs[k] = Sr[be]; ssum += cs[k];
            }
            const int tok = rt * 128 + tid;
            const float sc = 2.5f / ssum;
#pragma unroll
            for (int k = 0; k < 8; ++k) { eidx[tok * 8 + k] = ch[k]; gatew[tok * 8 + k] = cs[k] * sc; LE[tid * 8 + k] = ch[k]; }
        }
        __syncthreads();
        if (tid < 64) {
            int c = 0;
            for (int i = 0; i < 1024; ++i) c += (LE[i] == tid) ? 1 : 0;
            cnt[rt * 64 + tid] = c;
        }
        __syncthreads();
    }
}

__device__ __forceinline__ void phase_scatter(const Params& p, LAS unsigned char* lds, int bid, int nblk) {
    unsigned char* ws = p.ws;
    const int* eidx = (const int*)(ws + OFF_EIDX); const float* gatew = (const float*)(ws + OFF_GATEW); const int* cnt = (const int*)(ws + OFF_CNT);
    int* slotof = (int*)(ws + OFF_SLOTOF); int* tokof = (int*)(ws + OFF_TOKOF); float* wof = (float*)(ws + OFF_WOF); int* meta = (int*)(ws + OFF_META);
    const int tid = threadIdx.x;
    LAS int* te = (LAS int*)lds;
    LAS float* tw = (LAS float*)(lds + 4096);
    LAS int* tot = (LAS int*)(lds + 8192);
    LAS int* sst = (LAS int*)(lds + 8192 + 256);
    if (tid < 64) { int s = 0; for (int r = 0; r < 256; ++r) s += cnt[r * 64 + tid]; tot[tid] = s; }
    __syncthreads();
    if (tid == 0) { int a = 0; for (int e = 0; e < 64; ++e) { sst[e] = a; a += (tot[e] + TM - 1) / TM * TM; } sst[64] = a; sst[65] = a + NTOK; }
    __syncthreads();
    for (int rt = bid; rt < 256; rt += nblk) {
        for (int i = tid; i < 1024; i += NTHR) { te[i] = eidx[rt * 1024 + i]; tw[i] = gatew[rt * 1024 + i]; }
        __syncthreads();
        if (tid < 64) {
            int pos = sst[tid];
            for (int r = 0; r < rt; ++r) pos += cnt[r * 64 + tid];
            for (int i = 0; i < 1024; ++i) {
                if (te[i] == tid) { tokof[pos] = rt * 128 + (i >> 3); wof[pos] = tw[i]; slotof[rt * 1024 + i] = pos; ++pos; }
            }
            if (rt == 0) {
                for (int s = sst[tid] + tot[tid]; s < sst[tid + 1]; ++s) { tokof[s] = 0; wof[s] = 0.0f; }
            }
        }
        if (rt == 0 && tid < 66) meta[tid] = sst[tid];
        __syncthreads();
    }
}

__device__ __forceinline__ void moe_meta(const Params& p, LAS unsigned char* lds) {
    LAS int* ss = (LAS int*)(lds + 72704); LAS int* tp = (LAS int*)(lds + 72704 + 320);
    const int* meta = (const int*)(p.ws + OFF_META);
    if (threadIdx.x < 66) ss[threadIdx.x] = meta[threadIdx.x];
    __syncthreads();
    if (threadIdx.x == 0) { int a = 0; for (int e = 0; e < 65; ++e) { tp[e] = a; a += (ss[e + 1] - ss[e]) / TM; } tp[65] = a; }
    __syncthreads();
}

__device__ __forceinline__ void phase_moe_up(const Params& p, LAS unsigned char* lds, int bid, int nblk, int l) {
    unsigned char* ws = p.ws;
    const bf16_t* hx = (const bf16_t*)(ws + OFF_HX); const bf16_t* W = (const bf16_t*)(ws + W_GU) + (size_t)l * 65 * 512 * 1024;
    const int* tokof = (const int*)(ws + OFF_TOKOF); bf16_t* hh = (bf16_t*)(ws + B_HH);
    const int tid = threadIdx.x, srow = tid >> 2, skc = (tid & 3) * 8;
    LAS int* ss = (LAS int*)(lds + 72704); LAS int* tp = (LAS int*)(lds + 72704 + 320);
    moe_meta(p, lds);
    const int nunits = tp[65] * 4;
    for (int u = bid; u < nunits; u += nblk) {
        const int tile = u >> 2, nt = u & 3;
        int e = 0; while (e < 64 && tp[e + 1] <= tile) ++e;
        const int mt = tile - tp[e], slot0 = ss[e] + mt * TM;
        const int tok = e < 64 ? tokof[slot0 + srow] : mt * TM + srow;
        const bf16_t* arow = hx + (size_t)tok * D + skc;
        const bf16_t* brow = W + ((size_t)e * 512 + nt * 128 + srow) * 1024 + skc;
        gemm_tile(arow, brow, 32, KDef(), [=](int r, int c, f32x4 v) {
            const int j = (nt * 128 + c) >> 1;
            *(unsigned*)(hh + (size_t)(slot0 + r) * EFF + j) = pk2(silu(v.x) * v.y, silu(v.z) * v.w);
        }, lds);
    }
}

__device__ __forceinline__ void phase_moe_down(const Params& p, LAS unsigned char* lds, int bid, int nblk, int l, const float* modl) {
    unsigned char* ws = p.ws;
    const bf16_t* hh = (const bf16_t*)(ws + B_HH); const bf16_t* W = (const bf16_t*)(ws + W_DN) + (size_t)l * 65 * 1024 * 256;
    const float* wof = (const float*)(ws + OFF_WOF); bf16_t* Y = (bf16_t*)(ws + B_YY); float* xres = p.out;
    const int tid = threadIdx.x, srow = tid >> 2, skc = (tid & 3) * 8;
    LAS int* ss = (LAS int*)(lds + 72704); LAS int* tp = (LAS int*)(lds + 72704 + 320);
    moe_meta(p, lds);
    const int nunits = tp[65] * 8;
    for (int u = bid; u < nunits; u += nblk) {
        const int tile = u >> 3, nt = u & 7;
        int e = 0; while (e < 64 && tp[e + 1] <= tile) ++e;
        const int mt = tile - tp[e], slot0 = ss[e] + mt * TM;
        const bf16_t* arow = hh + (size_t)(slot0 + srow) * EFF + skc;
        const bf16_t* brow = W + ((size_t)e * 1024 + nt * 128 + srow) * 256 + skc;
        gemm_tile(arow, brow, 8, KDef(), [=](int r, int c, f32x4 v) {
            const int col = nt * 128 + c;
            if (e < 64) {
                const float w = wof[slot0 + r];
                u32x2 o; o.x = pk2(v.x * w, v.y * w); o.y = pk2(v.z * w, v.w * w);
                *(u32x2*)(Y + (size_t)(slot0 + r) * D + col) = o;
            } else {
                const int tok = mt * TM + r;
                const f32x4 g2 = *(const f32x4*)(modl + (size_t)(tok >> 13) * 6144 + 5120 + col);
                f32x4* xo = (f32x4*)(xres + (size_t)tok * D + col);
                *xo = *xo + g2 * v;
            }
        }, lds);
    }
}

__device__ __forceinline__ void phase_inproj1(const Params& p, LAS unsigned char* lds, int bid, int nblk) {
    unsigned char* ws = p.ws;
    const bf16_t* hx = (const bf16_t*)(ws + OFF_HX); const bf16_t* W = (const bf16_t*)(ws + W_BIN); bf16_t* uv = (bf16_t*)(ws + B_UV);
    const int tid = threadIdx.x, srow = tid >> 2, skc = (tid & 3) * 8;
    for (int u = bid; u < 256 * 32; u += nblk) {
        const int mt = u >> 5, nt = u & 31;
        const bf16_t* arow = hx + (size_t)(mt * 128 + srow) * D + skc;
        const bf16_t* brow = W + (size_t)(nt * 128 + srow) * D + skc;
        gemm_tile(arow, brow, 32, KDef(), [=](int r, int c, f32x4 v) {
            u32x2 w; w.x = pk2(gelu_t(v.x), gelu_t(v.y)); w.y = pk2(gelu_t(v.z), gelu_t(v.w));
            *(u32x2*)(uv + (size_t)(mt * 128 + r) * 4096 + nt * 128 + c) = w;
        }, lds);
    }
}

__device__ __forceinline__ void phase_lnT(const Params& p, LAS unsigned char* lds, int bid, int nblk) {
    unsigned char* ws = p.ws;
    const bf16_t* uv = (const bf16_t*)(ws + B_UV); bf16_t* vnt = (bf16_t*)(ws + B_VNT);
    const float* lng = p.in[18]; const float* lnb = p.in[19];
    const int tid = threadIdx.x, lane = tid & 63, wid = tid >> 6;
    LAS float* st = (LAS float*)lds;
    LAS bf16_t* T = (LAS bf16_t*)(lds + 1024);
    for (int chunk = bid; chunk < 256; chunk += nblk) {
        const int R0 = chunk * 128;
        for (int i = 0; i < 16; ++i) {
            const int r = wid * 16 + i;
            const u32x4* vr = (const u32x4*)(uv + (size_t)(R0 + r) * 4096 + 2048) + lane;
            float s = 0.f, q = 0.f;
#pragma unroll
            for (int j = 0; j < 4; ++j) {
                const u32x4 w = vr[64 * j];
                const float a0 = bflo(w.x), a1 = bfhi(w.x), a2 = bflo(w.y), a3 = bfhi(w.y), a4 = bflo(w.z), a5 = bfhi(w.z), a6 = bflo(w.w), a7 = bfhi(w.w);
                s += ((a0 + a1) + (a2 + a3)) + ((a4 + a5) + (a6 + a7));
                q += ((a0 * a0 + a1 * a1) + (a2 * a2 + a3 * a3)) + ((a4 * a4 + a5 * a5) + (a6 * a6 + a7 * a7));
            }
            s = wave_sum(s); q = wave_sum(q);
            const float mean = s * (1.0f / SW); const float var = fmaxf(q * (1.0f / SW) - mean * mean, 0.0f);
            if (lane == 0) { st[r * 2] = mean; st[r * 2 + 1] = 1.0f / sqrtf(var + 1e-6f); }
        }
        __syncthreads();
        for (int sl = 0; sl < 32; ++sl) {
#pragma unroll
            for (int i = 0; i < 2; ++i) {
                const int pc = tid + NTHR * i, tok = pc >> 3, c8 = (pc & 7) * 8, chg = sl * 64 + c8;
                const u32x4 w = *(const u32x4*)(uv + (size_t)(R0 + tok) * 4096 + 2048 + chg);
                const float mean = st[tok * 2], rstd = st[tok * 2 + 1];
                float a[8] = {bflo(w.x), bfhi(w.x), bflo(w.y), bfhi(w.y), bflo(w.z), bfhi(w.z), bflo(w.w), bfhi(w.w)};
#pragma unroll
                for (int j = 0; j < 8; ++j) T[(c8 + j) * 136 + tok] = (bf16_t)f2bf((a[j] - mean) * rstd * lng[chg + j] + lnb[chg + j]);
            }
            __syncthreads();
#pragma unroll
            for (int i = 0; i < 2; ++i) {
                const int pc = tid + NTHR * i, chl = pc >> 4, tg = (pc & 15) * 8;
                const u32x4 w = *(LAS u32x4*)((LAS unsigned char*)T + (chl * 136 + tg) * 2);
                *(u32x4*)(vnt + ((size_t)chunk * SW + sl * 64 + chl) * 128 + tg) = w;
            }
            __syncthreads();
        }
    }
}

__device__ __forceinline__ void phase_sgu(const Params& p, LAS unsigned char* lds, int bid, int nblk) {
    unsigned char* ws = p.ws;
    const bf16_t* Wsb = (const bf16_t*)(ws + W_S); const bf16_t* vnt = (const bf16_t*)(ws + B_VNT); const bf16_t* uv = (const bf16_t*)(ws + B_UV);
    bf16_t* z1 = (bf16_t*)(ws + B_Z1); const float* bs = p.in[21];
    const int tid = threadIdx.x, srow = tid >> 2, skc = (tid & 3) * 8;
    for (int u = bid; u < 256 * 16; u += nblk) {
        const int chunk = u >> 4, g = (u >> 1) & 7, nt = u & 1, R0 = chunk * 128;
        const bf16_t* arow = Wsb + (size_t)(g * 128 + srow) * 128 + skc;
        const bf16_t* brow = vnt + ((size_t)chunk * SW + g * 256 + nt * 128 + srow) * 128 + skc;
        gemm_tile(arow, brow, 4, KDef(), [=](int r, int c, f32x4 v) {
            const float b = bs[g * 128 + r];
            const int col = g * 256 + nt * 128 + c;
            const u32x2 uw = *(const u32x2*)(uv + (size_t)(R0 + r) * 4096 + col);
            u32x2 o; o.x = pk2(bflo(uw.x) * (v.x + b), bfhi(uw.x) * (v.y + b)); o.y = pk2(bflo(uw.y) * (v.z + b), bfhi(uw.y) * (v.w + b));
            *(u32x2*)(z1 + (size_t)(R0 + r) * SW + col) = o;
        }, lds);
    }
}

__global__ void __launch_bounds__(NTHR) mk_fwd(Params p) {
    __shared__ __attribute__((aligned(16))) unsigned char lds_raw[LDS_BYTES];
    LAS unsigned char* lds = (LAS unsigned char*)lds_raw;
    cg::grid_group grid = cg::this_grid();
    const int bid = blockIdx.x, nblk = gridDim.x;
    unsigned char* ws = p.ws;
    const float* mod0 = (const float*)(ws + OFF_MOD); const float* mod1 = mod0 + 5 * 6144;

    phase0(p, lds, bid, nblk);
    grid.sync();
    row_phase<0, false, false>(p, bid, nblk, p.in[6], mod0, 0, 1024, nullptr);
    grid.sync();
    phase_inproj0(p, lds, bid, nblk);
    grid.sync();
    phase_conv(p, bid, nblk);
    grid.sync();
    phase_gates<false>(p, lds, bid, nblk);
    grid.sync();
    phase_carry(p, bid, nblk);
    grid.sync();
    phase_gates<true>(p, lds, bid, nblk);
    grid.sync();
    phase_outproj(p, lds, bid, nblk, (const bf16_t*)(ws + B_Z0), RW, (const bf16_t*)(ws + W_AOUT), mod0);
    grid.sync();
    row_phase<1, true, false>(p, bid, nblk, p.in[7], mod0, 3072, 4096, nullptr);
    grid.sync();
    phase_router(p, lds, bid, nblk, 0);
    grid.sync();
    phase_scatter(p, lds, bid, nblk);
    grid.sync();
    phase_moe_up(p, lds, bid, nblk, 0);
    grid.sync();
    phase_moe_down(p, lds, bid, nblk, 0, mod0);
    grid.sync();
    row_phase<2, false, false>(p, bid, nblk, p.in[6] + D, mod1, 0, 1024, mod0);
    grid.sync();
    phase_inproj1(p, lds, bid, nblk);
    grid.sync();
    phase_lnT(p, lds, bid, nblk);
    grid.sync();
    phase_sgu(p, lds, bid, nblk);
    grid.sync();
    phase_outproj(p, lds, bid, nblk, (const bf16_t*)(ws + B_Z1), SW, (const bf16_t*)(ws + W_BOUT), mod1);
    grid.sync();
    row_phase<1, true, false>(p, bid, nblk, p.in[7] + D, mod1, 3072, 4096, nullptr);
    grid.sync();
    phase_router(p, lds, bid, nblk, 1);
    grid.sync();
    phase_scatter(p, lds, bid, nblk);
    grid.sync();
    phase_moe_up(p, lds, bid, nblk, 1);
    grid.sync();
    phase_moe_down(p, lds, bid, nblk, 1, mod1);
    grid.sync();
    row_phase<2, false, true>(p, bid, nblk, p.in[29], mod1, 0, 0, mod1);
}

extern "C" void kernel_launch(void* const* d_in, const int* in_sizes, int n_in, void* d_out, int out_size, void* d_ws, size_t ws_size, hipStream_t stream) {
    static int grid_blocks = 0;
    if (grid_blocks == 0) {
        if (n_in != 30 || out_size != NTOK * D || ws_size < WS_NEED) { fprintf(stderr, "kernel_launch: unexpected shapes (n_in %d out %d ws %zu need %zu)\n", n_in, out_size, ws_size, (size_t)WS_NEED); grid_blocks = -1; return; }
        int dev = 0, cus = 0, per_cu = 0;
        hipGetDevice(&dev);
        hipDeviceGetAttribute(&cus, hipDeviceAttributeMultiprocessorCount, dev);
        hipOccupancyMaxActiveBlocksPerMultiprocessor(&per_cu, mk_fwd, NTHR, 0);
        if (per_cu < 1) per_cu = 1;
        if (per_cu > 2) per_cu = 2;
        grid_blocks = cus * per_cu;
        fprintf(stderr, "kernel_launch: cus %d per_cu %d grid %d\n", cus, per_cu, grid_blocks);
    }
    if (grid_blocks < 0) return;
    Params p{};
    for (int i = 0; i < 30; ++i) p.in[i] = (const float*)d_in[i];
    p.out = (float*)d_out; p.ws = (unsigned char*)d_ws;
    void* args[] = {&p};
    hipError_t e = hipLaunchCooperativeKernel((void*)mk_fwd, dim3(grid_blocks), dim3(NTHR), args, 0, stream);
    if (e != hipSuccess) fprintf(stderr, "cooperative launch failed: %s (grid %d)\n", hipGetErrorString(e), grid_blocks);
}
```

```cpp
#include <hip/hip_runtime.h>
#include <hip/hip_cooperative_groups.h>
#include <cstdio>
#include <cstdint>
namespace cg = cooperative_groups;

#define LAS __attribute__((address_space(3)))
typedef unsigned short bf16_t;
typedef short bf16x8 __attribute__((ext_vector_type(8)));
typedef float f32x4 __attribute__((ext_vector_type(4)));
typedef unsigned u32x4 __attribute__((ext_vector_type(4)));
typedef unsigned u32x2 __attribute__((ext_vector_type(2)));

constexpr int D = 1024, NB = 4, SEQ = 8192, NTOK = NB * SEQ, CTXL = 256, NCTX = NB * CTXL, NROW = NTOK + NCTX;
constexpr int RW = 1280;
constexpr int SW = 2048;
constexpr int NE = 64, TOPK = 8, EFF = 256;
constexpr int TM = 256;
constexpr int NSLOT = 278528;
constexpr int NTHR = 512;
constexpr int LDS_BYTES = 139264;

constexpr size_t MiB = (size_t)1 << 20;
constexpr size_t OFF_MOD = 1 * MiB;
constexpr size_t OFF_POS = OFF_MOD + 262144;
constexpr size_t OFF_CDEC = OFF_POS + 262144;
constexpr size_t OFF_CNT = OFF_CDEC + 16384;
constexpr size_t OFF_META = OFF_CNT + 65536;
constexpr size_t OFF_IDENT = OFF_META + 4096 + 45056;
constexpr size_t OFF_AGG = 2 * MiB;
constexpr size_t OFF_CARRY = 8 * MiB;
constexpr size_t OFF_EIDX = 11 * MiB;
constexpr size_t OFF_GATEW = 12 * MiB;
constexpr size_t OFF_SLOTOF = 13 * MiB;
constexpr size_t OFF_TOKOF = 14 * MiB;
constexpr size_t OFF_WOF = 16 * MiB;
constexpr size_t OFF_W = 18 * MiB;
constexpr size_t W_AIN = OFF_W;
constexpr size_t W_AOUT = W_AIN + (size_t)2560 * 1024 * 2;
constexpr size_t W_GATE = W_AOUT + (size_t)1024 * 1280 * 2;
constexpr size_t W_BIN = W_GATE + (size_t)5 * 1024 * 256 * 2;
constexpr size_t W_BOUT = W_BIN + (size_t)4096 * 1024 * 2;
constexpr size_t W_S = W_BOUT + (size_t)1024 * 2048 * 2;
constexpr size_t W_RT = W_S + (size_t)8 * 128 * 128 * 2;
constexpr size_t W_GU = W_RT + (size_t)2 * 128 * 3072 * 2;
constexpr size_t W_DN = W_GU + (size_t)2 * 65 * 512 * 1024 * 2;
constexpr size_t W_END = W_DN + (size_t)2 * 65 * 1024 * 256 * 2;
constexpr size_t OFF_HX = 237 * MiB;
constexpr size_t OFF_BIG = OFF_HX + 66 * MiB;
constexpr size_t B_GATE0 = OFF_BIG;
constexpr size_t B_UPRE = OFF_BIG + 80 * MiB;
constexpr size_t B_UU = OFF_BIG + 163 * MiB;
constexpr size_t B_Z0 = OFF_BIG + 246 * MiB;
constexpr size_t B_UV = OFF_BIG;
constexpr size_t B_VNT = OFF_BIG + 256 * MiB;
constexpr size_t B_Z1 = OFF_BIG + 384 * MiB;
constexpr size_t B_HLO = OFF_BIG;
constexpr size_t B_HH = OFF_BIG;
constexpr size_t B_YY = OFF_BIG + 160 * MiB;
constexpr size_t WS_NEED = OFF_BIG + 704 * MiB;
static_assert(W_END <= OFF_HX, "weights overflow");
static_assert((size_t)(NSLOT + NTOK) * 256 * 2 <= 160 * MiB, "H overflow");
static_assert((size_t)NSLOT * 1024 * 2 <= 544 * MiB, "Y overflow");
static_assert(WS_NEED <= 1024 * MiB, "ws overflow");
constexpr long LO_DELTA = (long)((B_HLO - OFF_HX) / 2);

__device__ __forceinline__ unsigned f2bf(float f) { unsigned u = __builtin_bit_cast(unsigned, f); return (u + 0x7fffu + ((u >> 16) & 1u)) >> 16; }
__device__ __forceinline__ unsigned pk2(float lo, float hi) { unsigned r; asm volatile("v_cvt_pk_bf16_f32 %0, %1, %2" : "=v"(r) : "v"(lo), "v"(hi)); return r; }
__device__ __forceinline__ float bf2f(unsigned b) { return __builtin_bit_cast(float, b << 16); }
__device__ __forceinline__ float bflo(unsigned w) { return __builtin_bit_cast(float, w << 16); }
__device__ __forceinline__ float bfhi(unsigned w) { return __builtin_bit_cast(float, w & 0xffff0000u); }
__device__ __forceinline__ float sigm(float x) { return __builtin_amdgcn_rcpf(1.0f + __expf(-x)); }
__device__ __forceinline__ float silu(float x) { return x * __builtin_amdgcn_rcpf(1.0f + __expf(-x)); }
__device__ __forceinline__ float gelu_t(float x) { const float y = 1.5957691216057308f * (x + 0.044715f * x * x * x); return x * __builtin_amdgcn_rcpf(1.0f + __expf(-y)); }
__device__ __forceinline__ float wave_sum(float v) {
#pragma unroll
    for (int o = 1; o < 64; o <<= 1) v += __shfl_xor(v, o);
    return v;
}

__device__ __forceinline__ int opq_tid() { int t = threadIdx.x; asm volatile("" : "+v"(t)); return t; }
struct Params { const float* in[30]; float* out; unsigned char* ws; };

struct KDef { __device__ __forceinline__ long operator()(int kt) const { return (long)kt * 32; } };

template <class KOffA, class Epi>
__device__ __forceinline__ void gemm_tile(const bf16_t* arow, const bf16_t* brow, int nk, KOffA koffa, Epi epi, LAS unsigned char* lds) {
    const int tid = opq_tid(), lane = tid & 63, wid = tid >> 6, wr = wid >> 2, wc = wid & 3, fr = lane & 15, fq = lane >> 4;
    const int sw = (tid >> 2) * 80 + (tid & 3) * 16;
    f32x4 acc[4][2];
#pragma unroll
    for (int m = 0; m < 4; ++m)
#pragma unroll
        for (int n = 0; n < 2; ++n) acc[m][n] = (f32x4){0.f, 0.f, 0.f, 0.f};
    u32x4 ra = *(const u32x4*)(arow + koffa(0));
    u32x4 rb = *(const u32x4*)(brow);
    const int aoff = (wr * 64 + fr) * 80 + fq * 16, boff = 10240 + (wc * 32 + fr) * 80 + fq * 16;
    for (int kt = 0; kt < nk; ++kt) {
        LAS unsigned char* buf = lds + (kt & 1) * 20480;
        *(LAS u32x4*)(buf + sw) = ra;
        *(LAS u32x4*)(buf + 10240 + sw) = rb;
        __syncthreads();
        if (kt + 1 < nk) { ra = *(const u32x4*)(arow + koffa(kt + 1)); rb = *(const u32x4*)(brow + (long)(kt + 1) * 32); }
        bf16x8 af[4], bfv[2];
#pragma unroll
        for (int m = 0; m < 4; ++m) af[m] = *(LAS bf16x8*)(buf + aoff + m * 1280);
#pragma unroll
        for (int n = 0; n < 2; ++n) bfv[n] = *(LAS bf16x8*)(buf + boff + n * 1280);
#pragma unroll
        for (int m = 0; m < 4; ++m)
#pragma unroll
            for (int n = 0; n < 2; ++n) acc[m][n] = __builtin_amdgcn_mfma_f32_16x16x32_bf16(bfv[n], af[m], acc[m][n], 0, 0, 0);
    }
    __syncthreads();
#pragma unroll
    for (int m = 0; m < 4; ++m)
#pragma unroll
        for (int n = 0; n < 2; ++n) epi(wr * 64 + m * 16 + fr, wc * 32 + n * 16 + fq * 4, acc[m][n]);
}

namespace pg {
constexpr int BM = 256, BK = 64, HALF = 128, HTB = HALF * BK * 2, STAGE_BYTES = 8 * HTB;
__device__ __forceinline__ int lds_byte(int r, int c) { const int st = (r >> 4) * 2 + (c >> 5), rr = r & 15, cc = c & 31, ob = rr * 64 + cc * 2; return st * 1024 + (ob ^ (((ob >> 9) & 1) << 5)); }
__device__ __forceinline__ void stage_rc(int b, int& R, int& C) { const int st = b / 1024, sb = b % 1024, swz = sb ^ (((sb >> 9) & 1) << 5); R = (st >> 1) * 16 + swz / 64; C = (st & 1) * 32 + (swz % 64) / 2; }
__device__ __forceinline__ int perm32(int rho) { const int n = rho >> 4, i = rho & 15; return 8 * (i >> 2) + 4 * n + (i & 3); }
__device__ __forceinline__ int xcd_remap(int L, int nwg) { const int q = nwg / 8, r = nwg % 8, xcd = L % 8, off = L / 8; return (xcd < r ? xcd * (q + 1) : r * (q + 1) + (xcd - r) * q) + off; }

struct Unit { const char* a; const char* b; const int* rows; int pm, pn, e; };

template <bool GATHER, class Sched, class Epi>
__device__ __forceinline__ void gemm(LAS unsigned char* lds, const int K, const int lda, const int ldb, const Sched& S, const Epi& E) {
    const int tid = opq_tid(), wid = __builtin_amdgcn_readfirstlane(tid >> 6), lane = tid & 63, wr = wid >> 2, wc = wid & 3, fr = lane & 15, fq = lane >> 4;
    const int nt = K / BK;
    int RA[2]; unsigned ca2[2], voffB[2];
#pragma unroll
    for (int i = 0; i < 2; ++i) { int R, C; stage_rc(tid * 16 + i * 8192, R, C); const int Rb = Epi::PERM ? ((R & ~31) + perm32(R & 31)) : R;
        RA[i] = R; ca2[i] = (unsigned)C * 2u; voffB[i] = (unsigned)(Rb * ldb + C) * 2u; }
    const unsigned lda2 = (unsigned)lda * 2u;
    const size_t kstep = (size_t)(BK * 2);
    const size_t hstepB = (size_t)HALF * ldb * 2;
    const unsigned ldsw = (unsigned)wid * 1024u;
    const int aoff = lds_byte(wr * 64 + fr, fq * 8), boff = lds_byte(wc * 32 + fr, fq * 8);
    unsigned vc[2][2], vn[2][2];
#define PG_SA(b, h) (((b) * 2 + (h)) * HTB)
#define PG_SB(b, h) ((4 + (b) * 2 + (h)) * HTB)
#define PG_GL(bufoff, gp0, gp1) do { \
        __builtin_amdgcn_global_load_lds((const unsigned*)(gp0), (LAS unsigned*)(lds + (bufoff) + ldsw), 16, 0, 0); \
        __builtin_amdgcn_global_load_lds((const unsigned*)(gp1), (LAS unsigned*)(lds + (bufoff) + ldsw + 8192), 16, 0, 0); } while (0)
#define PG_STB(bufoff, gbase) PG_GL(bufoff, (const char*)(gbase) + voffB[0], (const char*)(gbase) + voffB[1])
#define PG_STA(bufoff, gbase, V, h) PG_GL(bufoff, (const char*)(gbase) + V[h][0], (const char*)(gbase) + V[h][1])
#define PG_LDA(dst, b, h) do { _Pragma("unroll") for (int m = 0; m < 4; ++m) _Pragma("unroll") for (int k = 0; k < 2; ++k) dst[m][k] = *(const LAS bf16x8*)(lds + PG_SA(b, h) + aoff + m * 2048 + k * 1024); } while (0)
#define PG_LDB(dst, b, h) do { _Pragma("unroll") for (int n = 0; n < 2; ++n) _Pragma("unroll") for (int k = 0; k < 2; ++k) dst[n][k] = *(const LAS bf16x8*)(lds + PG_SB(b, h) + boff + n * 2048 + k * 1024); } while (0)
#define PG_MMA(ai, bj, At, Bt) do { __builtin_amdgcn_s_setprio(1); _Pragma("unroll") for (int m = 0; m < 4; ++m) _Pragma("unroll") for (int n = 0; n < 2; ++n) _Pragma("unroll") for (int k = 0; k < 2; ++k) \
        acc[ai][bj][m][n] = __builtin_amdgcn_mfma_f32_16x16x32_bf16(Bt[n][k], At[m][k], acc[ai][bj][m][n], 0, 0, 0); __builtin_amdgcn_s_setprio(0); } while (0)
#define PG_WAIT_V(n) asm volatile("s_waitcnt vmcnt(" #n ")" ::: "memory")
#define PG_WAIT_L(n) asm volatile("s_waitcnt lgkmcnt(" #n ")" ::: "memory")
#define PG_BAR __builtin_amdgcn_s_barrier()
#define PG_SCHED __builtin_amdgcn_sched_barrier(0)
#define PG_SETOFF(V, U) do { _Pragma("unroll") for (int h = 0; h < 2; ++h) _Pragma("unroll") for (int i = 0; i < 2; ++i) \
        V[h][i] = (GATHER ? (unsigned)(U).rows[RA[i] + HALF * h] : (unsigned)(RA[i] + HALF * h)) * lda2 + ca2[i]; } while (0)
    Unit cur, nxt; int ui = 0;
    if (!S.next(0, cur)) return;
    PG_SETOFF(vc, cur);
    f32x4 acc[2][2][4][2];
#pragma unroll
    for (int a = 0; a < 2; ++a)
#pragma unroll
        for (int b = 0; b < 2; ++b)
#pragma unroll
            for (int m = 0; m < 4; ++m)
#pragma unroll
                for (int n = 0; n < 2; ++n) acc[a][b][m][n] = (f32x4){0.f, 0.f, 0.f, 0.f};
    bf16x8 At[4][2], B0[2][2], B1[2][2];
    const char* cA = cur.a; const char* cB = cur.b;
    PG_STB(PG_SB(0, 0), cB); PG_STB(PG_SB(0, 1), cB + hstepB); PG_STA(PG_SA(0, 0), cA, vc, 0); PG_STA(PG_SA(0, 1), cA, vc, 1);
    if (wr == 1) PG_BAR;
    PG_WAIT_V(2); PG_BAR;
    PG_STB(PG_SB(1, 0), cB + kstep); PG_STA(PG_SA(1, 0), cA + kstep, vc, 0); PG_STB(PG_SB(1, 1), cB + hstepB + kstep);
    PG_WAIT_V(6); PG_BAR;
#define PG_PAIR(a1, a2, b2, a3, b3, SWAP) do { \
        PG_LDB(B0, 0, 0); PG_LDB(B1, 0, 1); PG_SCHED; PG_LDA(At, 0, 0); PG_STA(PG_SA(1, 1), a1, vc, 1); \
        if (GATHER) { if (SWAP) { vc[0][0] = vn[0][0]; vc[0][1] = vn[0][1]; vc[1][0] = vn[1][0]; vc[1][1] = vn[1][1]; } } \
        PG_WAIT_V(8); PG_WAIT_L(0); PG_BAR; PG_MMA(0, 0, At, B0); PG_MMA(0, 1, At, B1); PG_BAR; PG_SCHED; \
        PG_LDA(At, 0, 1); PG_STB(PG_SB(0, 0), b2); PG_STB(PG_SB(0, 1), (b2) + hstepB); PG_STA(PG_SA(0, 0), a2, vc, 0); \
        PG_WAIT_V(8); PG_WAIT_L(0); PG_BAR; PG_MMA(1, 0, At, B0); PG_MMA(1, 1, At, B1); PG_BAR; PG_SCHED; \
        PG_LDB(B0, 1, 0); PG_LDB(B1, 1, 1); PG_SCHED; PG_LDA(At, 1, 0); PG_STA(PG_SA(0, 1), a2, vc, 1); \
        PG_WAIT_V(8); PG_WAIT_L(0); PG_BAR; PG_MMA(0, 0, At, B0); PG_MMA(0, 1, At, B1); PG_BAR; PG_SCHED; \
        PG_LDA(At, 1, 1); PG_STB(PG_SB(1, 0), b3); PG_STB(PG_SB(1, 1), (b3) + hstepB); PG_STA(PG_SA(1, 0), a3, vc, 0); \
        PG_WAIT_V(8); PG_WAIT_L(0); PG_BAR; PG_MMA(1, 0, At, B0); PG_MMA(1, 1, At, B1); PG_BAR; PG_SCHED; } while (0)
    for (;;) {
        const bool has_next = S.next(ui + 1, nxt);
        const char* nA = has_next ? nxt.a : cA; const char* nB = has_next ? nxt.b : cB;
        if (GATHER) { if (has_next) { PG_SETOFF(vn, nxt); } }
        for (int t = 0; t < nt; t += 2) {
            const bool last = (t == nt - 2);
            const char* a1 = cA + (size_t)(t + 1) * kstep;
            const char* a2 = last ? nA : cA + (size_t)(t + 2) * kstep; const char* b2 = last ? nB : cB + (size_t)(t + 2) * kstep;
            const char* a3 = a2 + kstep; const char* b3 = b2 + kstep;
            PG_PAIR(a1, a2, b2, a3, b3, (last && has_next));
        }
        if (wr == 0) PG_BAR;
        { int efr = fr, efq = fq; asm volatile("" : "+v"(efr), "+v"(efq)); E(acc, cur, wr, wc, efr, efq); }
        if (!has_next) break;
#pragma unroll
        for (int a = 0; a < 2; ++a)
#pragma unroll
            for (int b = 0; b < 2; ++b)
#pragma unroll
                for (int m = 0; m < 4; ++m)
#pragma unroll
                    for (int n = 0; n < 2; ++n) acc[a][b][m][n] = (f32x4){0.f, 0.f, 0.f, 0.f};
        cur = nxt; cA = nA; cB = nB; ++ui;
        if (wr == 1) PG_BAR;
    }
    PG_WAIT_V(0);
    PG_BAR;
#undef PG_SA
#undef PG_SB
#undef PG_GL
#undef PG_STB
#undef PG_STA
#undef PG_LDA
#undef PG_LDB
#undef PG_MMA
#undef PG_WAIT_V
#undef PG_WAIT_L
#undef PG_BAR
#undef PG_SCHED
#undef PG_SETOFF
#undef PG_PAIR
}

struct SchedPlain {
    const char* A; const char* B; int lda, ldb, nM, nN, nwg, G, c;
    __device__ __forceinline__ bool next(int i, Unit& u) const {
        const long L = (long)i * G + c; if (L >= nwg) return false;
        const int wgid = xcd_remap((int)L, nwg);
        const int nig = 8 * nN, gid = wgid / nig, fm = gid * 8, gsz = (nM - fm) < 8 ? (nM - fm) : 8;
        u.pm = fm + ((wgid % nig) % gsz); u.pn = (wgid % nig) / gsz; u.e = 0; u.rows = nullptr;
        u.a = A + (size_t)u.pm * BM * lda * 2; u.b = B + (size_t)u.pn * BM * ldb * 2; return true;
    }
};
}

__device__ __forceinline__ void tr_item(const float* W, int N, int k0, int n0, bf16_t* WT, int ldt, int mode, int rmul, int radd, LAS float* scr, int lane) {
#pragma unroll 8
    for (int i = 0; i < 32; ++i) { const int kk = 2 * i + (lane >> 5); scr[kk * 33 + (lane & 31)] = W[(size_t)(k0 + kk) * N + n0 + (lane & 31)]; }
    asm volatile("s_waitcnt lgkmcnt(0)" ::: "memory");
    const int c = lane & 7;
#pragma unroll
    for (int j = 0; j < 4; ++j) {
        const int n = (lane >> 3) + 8 * j; const LAS float* s = scr + (8 * c) * 33 + n;
        u32x4 o; o.x = pk2(s[0 * 33], s[1 * 33]); o.y = pk2(s[2 * 33], s[3 * 33]); o.z = pk2(s[4 * 33], s[5 * 33]); o.w = pk2(s[6 * 33], s[7 * 33]);
        const int ng = n0 + n;
        const int drow = mode == 1 ? (((ng & 255) >> 7) * 256 + (ng >> 8) * 128 + (ng & 127)) : ng * rmul + radd;
        *(u32x4*)(WT + (size_t)drow * ldt + k0 + 8 * c) = o;
    }
    asm volatile("s_waitcnt lgkmcnt(0)" ::: "memory");
}

__device__ __forceinline__ void phase0(const Params& p, LAS unsigned char* lds, int bid, int nblk) {
    const int tid = opq_tid(), lane = tid & 63, wid = tid >> 6;
    unsigned char* ws = p.ws;
    const int gt = bid * NTHR + tid, ngt = nblk * NTHR;
    float* pos = (float*)(ws + OFF_POS);
    for (int i = gt; i < 128 * 512; i += ngt) {
        const int r = i >> 9, c = i & 511, q = c & 255;
        const float omega = 1.0f / exp2f((float)q * (13.287712379549449f / 256.0f));
        const float ang = (float)r * omega;
        pos[i] = c < 256 ? __sinf(ang) : __cosf(ang);
    }
    float* cdec = (float*)(ws + OFF_CDEC);
    for (int i = gt; i < 2 * RW; i += ngt) cdec[i] = -8.0f * log1pf(expf(-p.in[15][i]));
    { int* ident = (int*)(ws + OFF_IDENT); for (int i = gt; i < NTOK; i += ngt) ident[i] = i; }
    {
        bf16_t* ws_s = (bf16_t*)(ws + W_S);
        for (int i = gt; i < 8 * 128 * 128; i += ngt) ws_s[i] = (bf16_t)f2bf(p.in[20][i]);
        bf16_t* wrt = (bf16_t*)(ws + W_RT);
        for (int i = gt; i < 2 * 1024 * 64; i += ngt) {
            const int l = i >> 16, k = (i >> 6) & 1023, e = i & 63;
            const float w = p.in[23][i];
            const unsigned hi = f2bf(w); const unsigned lo = f2bf(w - bf2f(hi));
            bf16_t* row = wrt + ((size_t)(l * 128 + e)) * 3072;
            row[k] = (bf16_t)hi; row[1024 + k] = (bf16_t)hi; row[2048 + k] = (bf16_t)lo;
        }
        unsigned* wz = (unsigned*)wrt;
        for (int i = gt; i < 2 * 64 * 1536; i += ngt) { const int l = i / (64 * 1536), r = i % (64 * 1536); wz[(size_t)(l * 128 + 64) * 1536 + r] = 0u; }
    }
    for (int it = bid; it < 192; it += nblk) {
        LAS float* sv = (LAS float*)lds;
        LAS float* red = (LAS float*)(lds + 20480);
        for (int i = tid; i < 5 * 1024; i += NTHR) { const float cv = i < 4096 ? p.in[1][i] : p.in[3][i - 4096]; sv[i] = silu(cv); }
        __syncthreads();
        const int l = it / 96, col0 = (it % 96) * 64;
        const float* w = p.in[4] + (size_t)l * 1024 * 6144 + col0 + lane;
        float a0 = 0.f, a1 = 0.f, a2 = 0.f, a3 = 0.f, a4 = 0.f;
        const int kb = wid * 128;
#pragma unroll 8
        for (int k = kb; k < kb + 128; ++k) {
            const float wv = w[(size_t)k * 6144];
            a0 += sv[k] * wv; a1 += sv[1024 + k] * wv; a2 += sv[2048 + k] * wv; a3 += sv[3072 + k] * wv; a4 += sv[4096 + k] * wv;
        }
        red[(wid * 5 + 0) * 64 + lane] = a0; red[(wid * 5 + 1) * 64 + lane] = a1; red[(wid * 5 + 2) * 64 + lane] = a2;
        red[(wid * 5 + 3) * 64 + lane] = a3; red[(wid * 5 + 4) * 64 + lane] = a4;
        __syncthreads();
        if (tid < 320) {
            const int v = tid >> 6, ln = tid & 63; float s = 0.f;
#pragma unroll
            for (int w8 = 0; w8 < 8; ++w8) s += red[(w8 * 5 + v) * 64 + ln];
            ((float*)(ws + OFF_MOD))[(size_t)(l * 5 + v) * 6144 + col0 + ln] = s + p.in[5][l * 6144 + col0 + ln];
        }
        __syncthreads();
    }
    LAS float* scr = (LAS float*)(lds + wid * 8448);
    const int gw = bid * 8 + wid, ngw = nblk * 8;
    constexpr int I_AIN = 16 * 80, I_AOUT = 20 * 32, I_GATE = 20 * 32, I_BIN = 16 * 128, I_BOUT = 32 * 32, I_GU = 2 * 65 * 256, I_DN = 2 * 65 * 128;
    constexpr int NITEMS = I_AIN + I_AOUT + I_GATE + I_BIN + I_BOUT + I_GU + I_DN;
    for (int it = gw; it < NITEMS; it += ngw) {
        int r = it;
        if (r < I_GU) {
            const int le = r >> 8, q = r & 255, l = le / 65, e = le % 65, kb = q >> 4, nb = q & 15;
            const float* src = e < 64 ? p.in[25] + (size_t)(l * 64 + e) * 1024 * 512 : p.in[27] + (size_t)l * 1024 * 512;
            tr_item(src, 512, kb * 64, nb * 32, (bf16_t*)(ws + W_GU) + (size_t)le * 512 * 1024, 1024, 1, 1, 0, scr, lane); continue; }
        r -= I_GU;
        if (r < I_DN) {
            const int le = r >> 7, q = r & 127, l = le / 65, e = le % 65, kb = q >> 5, nb = q & 31;
            const float* src = e < 64 ? p.in[26] + (size_t)(l * 64 + e) * 256 * 1024 : p.in[28] + (size_t)l * 256 * 1024;
            tr_item(src, 1024, kb * 64, nb * 32, (bf16_t*)(ws + W_DN) + (size_t)le * 1024 * 256, 256, 0, 1, 0, scr, lane); continue; }
        r -= I_DN;
        if (r < I_AIN) { const int kb = r / 80, nb = r % 80; tr_item(p.in[8], 2560, kb * 64, nb * 32, (bf16_t*)(ws + W_AIN), 1024, 0, 1, 0, scr, lane); continue; }
        r -= I_AIN;
        if (r < I_AOUT) { const int kb = r / 32, nb = r % 32; tr_item(p.in[16], 1024, kb * 64, nb * 32, (bf16_t*)(ws + W_AOUT), 1280, 0, 1, 0, scr, lane); continue; }
        r -= I_AOUT;
        if (r < I_GATE) {
            const int mi = r >> 5, q = r & 31, kb = q >> 3, nb = q & 7, h = mi % 5, dg = mi / 5, d = dg >> 1, g = dg & 1;
            const float* src = (g ? p.in[13] : p.in[11]) + (size_t)(d * 5 + h) * 65536;
            tr_item(src, 256, kb * 64, nb * 32, (bf16_t*)(ws + W_GATE) + (size_t)h * 1024 * 256, 256, 0, 4, d * 2 + g, scr, lane); continue; }
        r -= I_GATE;
        if (r < I_BIN) { const int kb = r / 128, nb = r % 128; tr_item(p.in[17], 4096, kb * 64, nb * 32, (bf16_t*)(ws + W_BIN), 1024, 0, 1, 0, scr, lane); continue; }
        r -= I_BIN;
        { const int kb = r / 32, nb = r % 32; tr_item(p.in[22], 1024, kb * 64, nb * 32, (bf16_t*)(ws + W_BOUT), 2048, 0, 1, 0, scr, lane); }
    }
}

template <int MODE, bool WRITE_LO, bool FINAL>
__device__ __forceinline__ void row_phase(const Params& p, int bid, int nblk, const float* gnorm, const float* modl  , int off_sh, int off_sc,
                                           const float* modprev  ) {
    const int tid = opq_tid(), lane = tid & 63, wid = tid >> 6;
    unsigned char* ws = p.ws;
    float* xres = p.out;
    bf16_t* hx = (bf16_t*)(ws + OFF_HX);
    bf16_t* hlo = (bf16_t*)(ws + B_HLO);
    const float* pos = (const float*)(ws + OFF_POS);
    const int* slotof = (const int*)(ws + OFF_SLOTOF);
    const bf16_t* Y = (const bf16_t*)(ws + B_YY);
    const int nrows = MODE == 0 ? NROW : NTOK;
    for (int row = bid * 8 + wid; row < nrows; row += nblk * 8) {
        f32x4 v[4];
        int mv;
        if (MODE == 0) {
            if (row < NTOK) {
                mv = row >> 13; const int t = row & (SEQ - 1);
                const f32x4* xr = (const f32x4*)(p.in[0] + (size_t)row * D) + lane;
                const f32x4* pr = (const f32x4*)(pos + (size_t)(t >> 6) * 512) + lane;
                const f32x4* pc = (const f32x4*)(pos + (size_t)(t & 63) * 512) + lane;
                v[0] = xr[0] + pr[0]; v[1] = xr[64] + pr[64]; v[2] = xr[128] + pc[0]; v[3] = xr[192] + pc[64];
                f32x4* xo = (f32x4*)(xres + (size_t)row * D) + lane;
#pragma unroll
                for (int j = 0; j < 4; ++j) xo[64 * j] = v[j];
            } else {
                mv = 4;
                const f32x4* xr = (const f32x4*)(p.in[2] + (size_t)(row - NTOK) * D) + lane;
#pragma unroll
                for (int j = 0; j < 4; ++j) v[j] = xr[64 * j];
            }
        } else {
            mv = row >> 13;
            f32x4* xo = (f32x4*)(xres + (size_t)row * D) + lane;
#pragma unroll
            for (int j = 0; j < 4; ++j) v[j] = xo[64 * j];
            if (MODE == 2) {
                f32x4 s[4];
#pragma unroll
                for (int j = 0; j < 4; ++j) s[j] = (f32x4){0.f, 0.f, 0.f, 0.f};
#pragma unroll
                for (int k = 0; k < TOPK; ++k) {
                    const int slot = slotof[row * 8 + k];
                    const u32x2* yr = (const u32x2*)(Y + (size_t)slot * D) + lane;
#pragma unroll
                    for (int j = 0; j < 4; ++j) { const u32x2 w = yr[64 * j]; s[j].x += bflo(w.x); s[j].y += bfhi(w.x); s[j].z += bflo(w.y); s[j].w += bfhi(w.y); }
                }
                const f32x4* g2 = (const f32x4*)(modprev + (size_t)mv * 6144 + 5120) + lane;
#pragma unroll
                for (int j = 0; j < 4; ++j) { v[j] = v[j] + g2[64 * j] * s[j]; if (!FINAL) xo[64 * j] = v[j]; }
            }
        }
        float ss = 0.f;
#pragma unroll
        for (int j = 0; j < 4; ++j) ss += (v[j].x * v[j].x + v[j].y * v[j].y) + (v[j].z * v[j].z + v[j].w * v[j].w);
        ss = wave_sum(ss);
        const float rinv = 1.0f / sqrtf(ss * (1.0f / D) + 1e-6f);
        const f32x4* gn = (const f32x4*)gnorm + lane;
        if (FINAL) {
            f32x4* xo = (f32x4*)(xres + (size_t)row * D) + lane;
#pragma unroll
            for (int j = 0; j < 4; ++j) xo[64 * j] = v[j] * rinv * gn[64 * j];
        } else {
            const f32x4* sh = (const f32x4*)(modl + (size_t)mv * 6144 + off_sh) + lane;
            const f32x4* sc = (const f32x4*)(modl + (size_t)mv * 6144 + off_sc) + lane;
            u32x2* ho = (u32x2*)(hx + (size_t)row * D) + lane;
            u32x2* lo = (u32x2*)(hlo + (size_t)row * D) + lane;
#pragma unroll
            for (int j = 0; j < 4; ++j) {
                const f32x4 y = v[j] * rinv * gn[64 * j] * (sc[64 * j] + 1.0f) + sh[64 * j];
                u32x2 w; w.x = pk2(y.x, y.y); w.y = pk2(y.z, y.w);
                ho[64 * j] = w;
                if (WRITE_LO) { u32x2 q; q.x = pk2(y.x - bflo(w.x), y.y - bfhi(w.x)); q.y = pk2(y.z - bflo(w.y), y.w - bfhi(w.y)); lo[64 * j] = q; }
            }
        }
    }
}

__device__ __forceinline__ void phase_inproj0(const Params& p, LAS unsigned char* lds, int bid, int nblk) {
    unsigned char* ws = p.ws;
    const bf16_t* hx = (const bf16_t*)(ws + OFF_HX); const bf16_t* W = (const bf16_t*)(ws + W_AIN);
    bf16_t* gate0 = (bf16_t*)(ws + B_GATE0); bf16_t* upre = (bf16_t*)(ws + B_UPRE);
    const int tid = opq_tid(), srow = tid >> 2, skc = (tid & 3) * 8;
    constexpr int NU = 256 * 20 + 8 * 10;
    for (int u = bid; u < NU; u += nblk) {
        int mt, nt;
        if (u < 5120) { mt = u / 20; nt = u % 20; } else { const int q = u - 5120; mt = 256 + q / 10; nt = 10 + q % 10; }
        const bf16_t* arow = hx + (size_t)(mt * 128 + srow) * D + skc;
        const bf16_t* brow = W + (size_t)(nt * 128 + srow) * D + skc;
        gemm_tile(arow, brow, 32, KDef(), [=](int r, int c, f32x4 v) {
            const int row = mt * 128 + r, col = nt * 128 + c;
            if (col < RW) { u32x2 w; w.x = pk2(gelu_t(v.x), gelu_t(v.y)); w.y = pk2(gelu_t(v.z), gelu_t(v.w)); *(u32x2*)(gate0 + (size_t)row * RW + col) = w; }
            else { u32x2 w; w.x = pk2(v.x, v.y); w.y = pk2(v.z, v.w); *(u32x2*)(upre + (size_t)row * RW + (col - RW)) = w; }
        }, lds);
    }
}

__device__ __forceinline__ void phase_conv(const Params& p, int bid, int nblk) {
    unsigned char* ws = p.ws;
    const bf16_t* upre = (const bf16_t*)(ws + B_UPRE); bf16_t* uu = (bf16_t*)(ws + B_UU);
    const float* cw = p.in[9]; const float* cb = p.in[10];
    const int gt = bid * NTHR + opq_tid(), ngt = nblk * NTHR;
    for (int i = gt; i < NROW * 160; i += ngt) {
        const int R = i / 160, cg8 = (i % 160) * 8;
        int t, T;
        if (R < NTOK) { t = R & (SEQ - 1); T = SEQ; } else { t = (R - NTOK) & (CTXL - 1); T = CTXL; }
        float o[8];
#pragma unroll
        for (int j = 0; j < 8; ++j) o[j] = cb[cg8 + j];
#pragma unroll
        for (int k = 0; k < 4; ++k) {
            const int tt = t + k - 2;
            if (tt >= 0 && tt < T) {
                const u32x4 w = *(const u32x4*)(upre + (size_t)(R + k - 2) * RW + cg8);
                const float* wk = cw + k * RW + cg8;
                o[0] += wk[0] * bflo(w.x); o[1] += wk[1] * bfhi(w.x); o[2] += wk[2] * bflo(w.y); o[3] += wk[3] * bfhi(w.y);
                o[4] += wk[4] * bflo(w.z); o[5] += wk[5] * bfhi(w.z); o[6] += wk[6] * bflo(w.w); o[7] += wk[7] * bfhi(w.w);
            }
        }
        u32x4 r; r.x = pk2(o[0], o[1]); r.y = pk2(o[2], o[3]); r.z = pk2(o[4], o[5]); r.w = pk2(o[6], o[7]);
        *(u32x4*)(uu + (size_t)R * RW + cg8) = r;
    }
}

template <bool FULL>
__device__ __forceinline__ void phase_gates(const Params& p, LAS unsigned char* lds, int bid, int nblk) {
    unsigned char* ws = p.ws;
    const bf16_t* uu = (const bf16_t*)(ws + B_UU); const bf16_t* Wg = (const bf16_t*)(ws + W_GATE);
    const bf16_t* gate0 = (const bf16_t*)(ws + B_GATE0); bf16_t* z0 = (bf16_t*)(ws + B_Z0);
    const float* cdec = (const float*)(ws + OFF_CDEC);
    float* agg = (float*)(ws + OFF_AGG); const float* carry = (const float*)(ws + OFF_CARRY);
    const float* rbias = p.in[12]; const float* ibias = p.in[14];
    const int tid = opq_tid(), lane = tid & 63, wid = tid >> 6, srow = tid >> 2, skc = (tid & 3) * 8;
    const int nunits = (FULL ? 256 : 264) * 40;
    LAS float* sagg = (LAS float*)(lds + 65536);
    LAS float* subc = (LAS float*)(lds + 65536 + 4096);
    for (int u = bid; u < nunits; u += nblk) {
        const int chunk = u / 40, rem = u % 40, h = rem >> 3, s = rem & 7, R0 = chunk * 128, chb = h * 256 + s * 32;
        const bf16_t* arow = uu + (size_t)(R0 + srow) * RW + h * 256 + skc;
        const bf16_t* brow = Wg + (size_t)(h * 1024 + s * 128 + srow) * 256 + skc;
        gemm_tile(arow, brow, 8, KDef(), [=](int r, int c, f32x4 v) {
            const int jj = c >> 2, ch = chb + jj;
            const float uval = bf2f(uu[(size_t)(R0 + r) * RW + ch]);
            const float r0 = sigm(v.x + rbias[ch]), i0 = sigm(v.y + ibias[ch]), r1 = sigm(v.z + rbias[RW + ch]), i1 = sigm(v.w + ibias[RW + ch]);
            const float la0 = r0 * cdec[ch], la1 = r1 * cdec[RW + ch];
            const float a0 = __expf(la0), a1 = __expf(la1);
            float m0 = sqrtf(-expm1f(2.0f * la0)), m1 = sqrtf(-expm1f(2.0f * la1));
            if (chunk >= 256) { const int ts = ((chunk - 256) & 1) * 128 + r; if (ts == 0) m0 = 1.0f; if (ts == CTXL - 1) m1 = 1.0f; }
            *(LAS f32x4*)(lds + (r * 32 + jj) * 16) = (f32x4){a0, m0 * i0 * uval, a1, m1 * i1 * uval};
        }, lds);
        __syncthreads();
        {
            const int d = lane >> 5, jj = lane & 31;
            float A = 1.0f, Hh = 0.0f;
#pragma unroll 4
            for (int i = 0; i < 16; ++i) {
                const int t = d == 0 ? wid * 16 + i : wid * 16 + 15 - i;
                LAS float* e = (LAS float*)(lds + (t * 32 + jj) * 16 + d * 8);
                const float a = e[0], b = e[1];
                Hh = a * Hh + b; A *= a;
                e[0] = A; e[1] = Hh;
            }
            sagg[((wid * 2 + d) * 32 + jj) * 2 + 0] = A; sagg[((wid * 2 + d) * 32 + jj) * 2 + 1] = Hh;
        }
        __syncthreads();
        if (wid == 0) {
            const int d = lane >> 5, jj = lane & 31, ch = chb + jj;
            if (!FULL) {
                float At = 1.0f, Ht = 0.0f;
#pragma unroll
                for (int i = 0; i < 8; ++i) { const int w = d == 0 ? i : 7 - i; const float A = sagg[((w * 2 + d) * 32 + jj) * 2], Hh = sagg[((w * 2 + d) * 32 + jj) * 2 + 1]; Ht = A * Ht + Hh; At *= A; }
                float* o = agg + ((size_t)(d * 264 + chunk) * RW + ch) * 2;
                o[0] = At; o[1] = Ht;
            } else {
                float c = carry[(size_t)(d * 256 + chunk) * RW + ch];
#pragma unroll
                for (int i = 0; i < 8; ++i) { const int w = d == 0 ? i : 7 - i; subc[(w * 2 + d) * 32 + jj] = c; const float A = sagg[((w * 2 + d) * 32 + jj) * 2], Hh = sagg[((w * 2 + d) * 32 + jj) * 2 + 1]; c = A * c + Hh; }
            }
        }
        if (FULL) {
            __syncthreads();
#pragma unroll
            for (int i = 0; i < 8; ++i) {
                const int e = tid + NTHR * i, t = e >> 5, jj = e & 31, w = t >> 4;
                const f32x4 q = *(LAS f32x4*)(lds + (t * 32 + jj) * 16);
                const float y = (q.y + q.x * subc[(w * 2 + 0) * 32 + jj]) + (q.w + q.z * subc[(w * 2 + 1) * 32 + jj]);
                const size_t gi = (size_t)(R0 + t) * RW + chb + jj;
                z0[gi] = (bf16_t)f2bf(bf2f(gate0[gi]) * y);
            }
        }
        __syncthreads();
    }
}

__device__ __forceinline__ void phase_carry(const Params& p, int bid, int nblk) {
    unsigned char* ws = p.ws;
    const float* agg = (const float*)(ws + OFF_AGG); float* carry = (float*)(ws + OFF_CARRY);
    const int gt = bid * NTHR + opq_tid(), ngt = nblk * NTHR;
    for (int i = gt; i < 2 * NB * RW; i += ngt) {
        const int d = i / (NB * RW), b = (i / RW) % NB, ch = i % RW;
        float h = 0.0f;
        for (int j = 0; j < 2; ++j) { const int c = d == 0 ? j : 1 - j; const float* a = agg + ((size_t)(d * 264 + 256 + b * 2 + c) * RW + ch) * 2; h = a[0] * h + a[1]; }
        for (int j = 0; j < 64; ++j) {
            const int c = d == 0 ? j : 63 - j; const int chunk = b * 64 + c;
            carry[(size_t)(d * 256 + chunk) * RW + ch] = h;
            const float* a = agg + ((size_t)(d * 264 + chunk) * RW + ch) * 2; h = a[0] * h + a[1];
        }
    }
}

__device__ __forceinline__ void phase_outproj(const Params& p, LAS unsigned char* lds, int bid, int nblk, const bf16_t* Z, int K, const bf16_t* W, const float* modl) {
    float* xres = p.out;
    const int tid = opq_tid(), srow = tid >> 2, skc = (tid & 3) * 8;
    for (int u = bid; u < 256 * 8; u += nblk) {
        const int mt = u >> 3, nt = u & 7;
        const bf16_t* arow = Z + (size_t)(mt * 128 + srow) * K + skc;
        const bf16_t* brow = W + (size_t)(nt * 128 + srow) * K + skc;
        gemm_tile(arow, brow, K / 32, KDef(), [=](int r, int c, f32x4 v) {
            const int row = mt * 128 + r, col = nt * 128 + c;
            const f32x4 g1 = *(const f32x4*)(modl + (size_t)(row >> 13) * 6144 + 2048 + col);
            f32x4* xo = (f32x4*)(xres + (size_t)row * D + col);
            *xo = *xo + g1 * v;
        }, lds);
    }
}

struct KRouter { __device__ __forceinline__ long operator()(int kt) const { return kt < 32 ? (long)kt * 32 : (kt < 64 ? LO_DELTA + (long)(kt - 32) * 32 : (long)(kt - 64) * 32); } };

__device__ __forceinline__ void phase_router(const Params& p, LAS unsigned char* lds, int bid, int nblk, int l) {
    unsigned char* ws = p.ws;
    const bf16_t* hx = (const bf16_t*)(ws + OFF_HX); const bf16_t* W = (const bf16_t*)(ws + W_RT) + (size_t)l * 128 * 3072;
    const float* rb = p.in[24] + l * 64;
    int* eidx = (int*)(ws + OFF_EIDX); float* gatew = (float*)(ws + OFF_GATEW); int* cnt = (int*)(ws + OFF_CNT);
    const int tid = opq_tid(), srow = tid >> 2, skc = (tid & 3) * 8;
    LAS float* L = (LAS float*)lds;
    LAS float* S = (LAS float*)(lds + 33280);
    LAS int* LE = (LAS int*)(lds + 66560);
    for (int rt = bid; rt < 256; rt += nblk) {
        const bf16_t* arow = hx + (size_t)(rt * 128 + srow) * D + skc;
        const bf16_t* brow = W + (size_t)srow * 3072 + skc;
        gemm_tile(arow, brow, 96, KRouter(), [=](int r, int c, f32x4 v) {
            if (c < 64) { LAS float* o = L + r * 65 + c; o[0] = v.x; o[1] = v.y; o[2] = v.z; o[3] = v.w; }
        }, lds + 0);
        __syncthreads();
        if (tid < 128) {
            LAS float* Lr = L + tid * 65; LAS float* Sr = S + tid * 65;
            float gs[8];
#pragma unroll
            for (int g = 0; g < 8; ++g) {
                float m1 = -__builtin_inff(), m2 = -__builtin_inff();
#pragma unroll
                for (int i = 0; i < 8; ++i) {
                    const int e = g * 8 + i;
                    const float sc = sigm(Lr[e]); const float sl = sc + rb[e];
                    Sr[e] = sc; Lr[e] = sl;
                    if (sl > m1) { m2 = m1; m1 = sl; } else if (sl > m2) m2 = sl;
                }
                gs[g] = m1 + m2;
            }
            unsigned keep = 0u;
#pragma unroll
            for (int g = 0; g < 8; ++g) {
                int rank = 0;
#pragma unroll
                for (int g2 = 0; g2 < 8; ++g2) rank += (gs[g2] > gs[g] || (gs[g2] == gs[g] && g2 < g)) ? 1 : 0;
                if (rank < 4) keep |= 1u << g;
            }
            int ch[8]; float cs[8]; float ssum = 0.0f;
#pragma unroll
            for (int k = 0; k < 8; ++k) {
                float best = -__builtin_inff(); int be = 0;
                for (int e = 0; e < 64; ++e) {
                    const float v = Lr[e];
                    if (((keep >> (e >> 3)) & 1u) && v > best) { best = v; be = e; }
                }
                Lr[be] = -__builtin_inff();
                ch[k] = be; cs[k] = Sr[be]; ssum += cs[k];
            }
            const int tok = rt * 128 + tid;
            const float sc = 2.5f / ssum;
#pragma unroll
            for (int k = 0; k < 8; ++k) { eidx[tok * 8 + k] = ch[k]; gatew[tok * 8 + k] = cs[k] * sc; LE[tid * 8 + k] = ch[k]; }
        }
        __syncthreads();
        if (tid < 64) {
            int c = 0;
            for (int i = 0; i < 1024; ++i) c += (LE[i] == tid) ? 1 : 0;
            cnt[rt * 64 + tid] = c;
        }
        __syncthreads();
    }
}

__device__ __forceinline__ void phase_scatter(const Params& p, LAS unsigned char* lds, int bid, int nblk) {
    unsigned char* ws = p.ws;
    const int* eidx = (const int*)(ws + OFF_EIDX); const float* gatew = (const float*)(ws + OFF_GATEW); const int* cnt = (const int*)(ws + OFF_CNT);
    int* slotof = (int*)(ws + OFF_SLOTOF); int* tokof = (int*)(ws + OFF_TOKOF); float* wof = (float*)(ws + OFF_WOF); int* meta = (int*)(ws + OFF_META);
    const int tid = opq_tid();
    LAS int* te = (LAS int*)lds;
    LAS float* tw = (LAS float*)(lds + 4096);
    LAS int* tot = (LAS int*)(lds + 8192);
    LAS int* sst = (LAS int*)(lds + 8192 + 256);
    if (tid < 64) { int s = 0; for (int r = 0; r < 256; ++r) s += cnt[r * 64 + tid]; tot[tid] = s; }
    __syncthreads();
    if (tid == 0) { int a = 0; for (int e = 0; e < 64; ++e) { sst[e] = a; a += (tot[e] + TM - 1) / TM * TM; } sst[64] = a; sst[65] = a + NTOK; }
    __syncthreads();
    for (int rt = bid; rt < 256; rt += nblk) {
        for (int i = tid; i < 1024; i += NTHR) { te[i] = eidx[rt * 1024 + i]; tw[i] = gatew[rt * 1024 + i]; }
        __syncthreads();
        if (tid < 64) {
            int pos = sst[tid];
            for (int r = 0; r < rt; ++r) pos += cnt[r * 64 + tid];
            for (int i = 0; i < 1024; ++i) {
                if (te[i] == tid) { tokof[pos] = rt * 128 + (i >> 3); wof[pos] = tw[i]; slotof[rt * 1024 + i] = pos; ++pos; }
            }
            if (rt == 0) {
                for (int s = sst[tid] + tot[tid]; s < sst[tid + 1]; ++s) { tokof[s] = 0; wof[s] = 0.0f; }
            }
        }
        if (rt == 0 && tid < 66) meta[tid] = sst[tid];
        __syncthreads();
    }
}

__device__ __forceinline__ void phase_inproj1(const Params& p, LAS unsigned char* lds, int bid, int nblk) {
    unsigned char* ws = p.ws;
    const bf16_t* hx = (const bf16_t*)(ws + OFF_HX); const bf16_t* W = (const bf16_t*)(ws + W_BIN); bf16_t* uv = (bf16_t*)(ws + B_UV);
    const int tid = opq_tid(), srow = tid >> 2, skc = (tid & 3) * 8;
    for (int u = bid; u < 256 * 32; u += nblk) {
        const int mt = u >> 5, nt = u & 31;
        const bf16_t* arow = hx + (size_t)(mt * 128 + srow) * D + skc;
        const bf16_t* brow = W + (size_t)(nt * 128 + srow) * D + skc;
        gemm_tile(arow, brow, 32, KDef(), [=](int r, int c, f32x4 v) {
            u32x2 w; w.x = pk2(gelu_t(v.x), gelu_t(v.y)); w.y = pk2(gelu_t(v.z), gelu_t(v.w));
            *(u32x2*)(uv + (size_t)(mt * 128 + r) * 4096 + nt * 128 + c) = w;
        }, lds);
    }
}

__device__ __forceinline__ void phase_lnT(const Params& p, LAS unsigned char* lds, int bid, int nblk) {
    unsigned char* ws = p.ws;
    const bf16_t* uv = (const bf16_t*)(ws + B_UV); bf16_t* vnt = (bf16_t*)(ws + B_VNT);
    const float* lng = p.in[18]; const float* lnb = p.in[19];
    const int tid = opq_tid(), lane = tid & 63, wid = tid >> 6;
    LAS float* st = (LAS float*)lds;
    LAS bf16_t* T = (LAS bf16_t*)(lds + 1024);
    for (int chunk = bid; chunk < 256; chunk += nblk) {
        const int R0 = chunk * 128;
        for (int i = 0; i < 16; ++i) {
            const int r = wid * 16 + i;
            const u32x4* vr = (const u32x4*)(uv + (size_t)(R0 + r) * 4096 + 2048) + lane;
            float s = 0.f, q = 0.f;
#pragma unroll
            for (int j = 0; j < 4; ++j) {
                const u32x4 w = vr[64 * j];
                const float a0 = bflo(w.x), a1 = bfhi(w.x), a2 = bflo(w.y), a3 = bfhi(w.y), a4 = bflo(w.z), a5 = bfhi(w.z), a6 = bflo(w.w), a7 = bfhi(w.w);
                s += ((a0 + a1) + (a2 + a3)) + ((a4 + a5) + (a6 + a7));
                q += ((a0 * a0 + a1 * a1) + (a2 * a2 + a3 * a3)) + ((a4 * a4 + a5 * a5) + (a6 * a6 + a7 * a7));
            }
            s = wave_sum(s); q = wave_sum(q);
            const float mean = s * (1.0f / SW); const float var = fmaxf(q * (1.0f / SW) - mean * mean, 0.0f);
            if (lane == 0) { st[r * 2] = mean; st[r * 2 + 1] = 1.0f / sqrtf(var + 1e-6f); }
        }
        __syncthreads();
        for (int sl = 0; sl < 32; ++sl) {
#pragma unroll
            for (int i = 0; i < 2; ++i) {
                const int pc = tid + NTHR * i, tok = pc >> 3, c8 = (pc & 7) * 8, chg = sl * 64 + c8;
                const u32x4 w = *(const u32x4*)(uv + (size_t)(R0 + tok) * 4096 + 2048 + chg);
                const float mean = st[tok * 2], rstd = st[tok * 2 + 1];
                float a[8] = {bflo(w.x), bfhi(w.x), bflo(w.y), bfhi(w.y), bflo(w.z), bfhi(w.z), bflo(w.w), bfhi(w.w)};
#pragma unroll
                for (int j = 0; j < 8; ++j) T[(c8 + j) * 136 + tok] = (bf16_t)f2bf((a[j] - mean) * rstd * lng[chg + j] + lnb[chg + j]);
            }
            __syncthreads();
#pragma unroll
            for (int i = 0; i < 2; ++i) {
                const int pc = tid + NTHR * i, chl = pc >> 4, tg = (pc & 15) * 8;
                const u32x4 w = *(LAS u32x4*)((LAS unsigned char*)T + (chl * 136 + tg) * 2);
                *(u32x4*)(vnt + ((size_t)chunk * SW + sl * 64 + chl) * 128 + tg) = w;
            }
            __syncthreads();
        }
    }
}

__device__ __forceinline__ void phase_sgu(const Params& p, LAS unsigned char* lds, int bid, int nblk) {
    unsigned char* ws = p.ws;
    const bf16_t* Wsb = (const bf16_t*)(ws + W_S); const bf16_t* vnt = (const bf16_t*)(ws + B_VNT); const bf16_t* uv = (const bf16_t*)(ws + B_UV);
    bf16_t* z1 = (bf16_t*)(ws + B_Z1); const float* bs = p.in[21];
    const int tid = opq_tid(), srow = tid >> 2, skc = (tid & 3) * 8;
    for (int u = bid; u < 256 * 16; u += nblk) {
        const int chunk = u >> 4, g = (u >> 1) & 7, nt = u & 1, R0 = chunk * 128;
        const bf16_t* arow = Wsb + (size_t)(g * 128 + srow) * 128 + skc;
        const bf16_t* brow = vnt + ((size_t)chunk * SW + g * 256 + nt * 128 + srow) * 128 + skc;
        gemm_tile(arow, brow, 4, KDef(), [=](int r, int c, f32x4 v) {
            const float b = bs[g * 128 + r];
            const int col = g * 256 + nt * 128 + c;
            const u32x2 uw = *(const u32x2*)(uv + (size_t)(R0 + r) * 4096 + col);
            u32x2 o; o.x = pk2(bflo(uw.x) * (v.x + b), bfhi(uw.x) * (v.y + b)); o.y = pk2(bflo(uw.y) * (v.z + b), bfhi(uw.y) * (v.w + b));
            *(u32x2*)(z1 + (size_t)(R0 + r) * SW + col) = o;
        }, lds);
    }
}

template <class F> struct EpiP8 {
    static constexpr bool PERM = true; F f;
    __device__ __forceinline__ void operator()(const f32x4 (&acc)[2][2][4][2], const pg::Unit& u, int wr, int wc, int fr, int fq) const {
#pragma unroll
        for (int ai = 0; ai < 2; ++ai)
#pragma unroll
            for (int m = 0; m < 4; ++m)
#pragma unroll
                for (int bj = 0; bj < 2; ++bj) f(u, ai * 128 + wr * 64 + m * 16 + fr, bj * 128 + wc * 32 + 8 * fq, acc[ai][bj][m][0], acc[ai][bj][m][1]);
    }
};
template <class F> struct EpiP4 {
    static constexpr bool PERM = false; F f;
    __device__ __forceinline__ void operator()(const f32x4 (&acc)[2][2][4][2], const pg::Unit& u, int wr, int wc, int fr, int fq) const {
#pragma unroll
        for (int ai = 0; ai < 2; ++ai)
#pragma unroll
            for (int m = 0; m < 4; ++m)
#pragma unroll
                for (int bj = 0; bj < 2; ++bj)
#pragma unroll
                    for (int n = 0; n < 2; ++n) f(u, ai * 128 + wr * 64 + m * 16 + fr, bj * 128 + wc * 32 + 16 * n + 4 * fq, acc[ai][bj][m][n]);
    }
};
template <class F> __device__ __forceinline__ EpiP8<F> make_p8(F f) { return EpiP8<F>{f}; }
template <class F> __device__ __forceinline__ EpiP4<F> make_p4(F f) { return EpiP4<F>{f}; }
__device__ __forceinline__ u32x4 pack8(f32x4 a, f32x4 b) { u32x4 w; w.x = pk2(a.x, a.y); w.y = pk2(a.z, a.w); w.z = pk2(b.x, b.y); w.w = pk2(b.z, b.w); return w; }
__device__ __forceinline__ f32x4 gelu4(f32x4 v) { return (f32x4){gelu_t(v.x), gelu_t(v.y), gelu_t(v.z), gelu_t(v.w)}; }

struct SchedIn0 {
    const char* A; const char* B; int G, c;
    __device__ __forceinline__ bool next(int i, pg::Unit& u) const {
        const int L = i * G + c; if (L >= 1300) return false;
        if (L < 1280) { const int wgid = pg::xcd_remap(L, 1280); u.pm = (wgid / 80) * 8 + (wgid % 80) % 8; u.pn = (wgid % 80) / 8; }
        else { const int q = L - 1280; u.pm = 128 + q / 5; u.pn = 5 + q % 5; }
        u.e = 0; u.rows = nullptr; u.a = A + (size_t)u.pm * 256 * D * 2; u.b = B + (size_t)u.pn * 256 * D * 2; return true;
    }
};
__device__ __forceinline__ void phase_inproj0_pg(const Params& p, LAS unsigned char* lds, int bid, int nblk) {
    unsigned char* ws = p.ws;
    bf16_t* gate0 = (bf16_t*)(ws + B_GATE0); bf16_t* upre = (bf16_t*)(ws + B_UPRE);
    SchedIn0 S{(const char*)(ws + OFF_HX), (const char*)(ws + W_AIN), nblk, bid};
    auto E = make_p8([=](const pg::Unit& u, int r, int c, f32x4 v0, f32x4 v1) {
        const int row = u.pm * 256 + r, col = u.pn * 256 + c;
        if (u.pn < 5) *(u32x4*)(gate0 + (size_t)row * RW + col) = pack8(gelu4(v0), gelu4(v1));
        else *(u32x4*)(upre + (size_t)row * RW + (col - RW)) = pack8(v0, v1);
    });
    pg::gemm<false>(lds, D, D, D, S, E);
}
__device__ __forceinline__ void phase_outproj_pg(const Params& p, LAS unsigned char* lds, int bid, int nblk, const bf16_t* Z, int K, const bf16_t* W, const float* modl) {
    float* xres = p.out;
    pg::SchedPlain S{(const char*)Z, (const char*)W, K, K, 128, 4, 512, nblk, bid};
    auto E = make_p4([=](const pg::Unit& u, int r, int c, f32x4 v) {
        const int row = u.pm * 256 + r, col = u.pn * 256 + c;
        const f32x4 g1 = *(const f32x4*)(modl + (size_t)(row >> 13) * 6144 + 2048 + col);
        f32x4* xo = (f32x4*)(xres + (size_t)row * D + col);
        *xo = *xo + g1 * v;
        if ((c & 16) != 0) asm volatile("" ::: "memory");
    });
    pg::gemm<false>(lds, K, K, K, S, E);
}
__device__ __forceinline__ void phase_inproj1_pg(const Params& p, LAS unsigned char* lds, int bid, int nblk) {
    unsigned char* ws = p.ws;
    bf16_t* uv = (bf16_t*)(ws + B_UV);
    pg::SchedPlain S{(const char*)(ws + OFF_HX), (const char*)(ws + W_BIN), D, D, 128, 16, 2048, nblk, bid};
    auto E = make_p8([=](const pg::Unit& u, int r, int c, f32x4 v0, f32x4 v1) {
        *(u32x4*)(uv + (size_t)(u.pm * 256 + r) * 4096 + u.pn * 256 + c) = pack8(gelu4(v0), gelu4(v1));
    });
    pg::gemm<false>(lds, D, D, D, S, E);
}

constexpr int MOE_T_SS = 131072, MOE_T_S0 = 131072 + 512, MOE_T_E = 131072 + 512 + 4864;
__device__ __forceinline__ int moe_meta(const Params& p, LAS unsigned char* lds) {
    LAS int* ss = (LAS int*)(lds + MOE_T_SS); LAS int* ts0 = (LAS int*)(lds + MOE_T_S0); LAS unsigned char* te = lds + MOE_T_E;
    const int* meta = (const int*)(p.ws + OFF_META);
    const int tid = opq_tid();
    if (tid < 66) ss[tid] = meta[tid];
    __syncthreads();
    const int ntile = ss[65] / TM;
    for (int t = tid; t < ntile; t += NTHR) {
        const int slot0 = t * TM; int e = 0;
        for (int q = 1; q < 65; ++q) e = (ss[q] <= slot0) ? q : e;
        ts0[t] = slot0; te[t] = (unsigned char)e;
    }
    __syncthreads();
    return ntile;
}
template <int NPN, bool GATHER>
struct SchedMoe {
    const char* A; const char* W; const int* tokof; const int* ident; LAS unsigned char* lds; int lda, wrows, wk, nunits, G, c;
    __device__ __forceinline__ bool next(int i, pg::Unit& u) const {
        const int L = i * G + c; if (L >= nunits) return false;
        const int wgid = pg::xcd_remap(L, nunits), tile = wgid / NPN;
        const int slot0 = __builtin_amdgcn_readfirstlane(((LAS int*)(lds + MOE_T_S0))[tile]);
        const int e = __builtin_amdgcn_readfirstlane((int)(lds + MOE_T_E)[tile]);
        const int ss64 = __builtin_amdgcn_readfirstlane(((LAS int*)(lds + MOE_T_SS))[64]);
        u.pm = slot0; u.pn = wgid % NPN; u.e = e;
        u.rows = e < 64 ? tokof + slot0 : ident + (slot0 - ss64);
        u.a = GATHER ? A : A + (size_t)slot0 * lda * 2;
        u.b = W + ((size_t)e * wrows + (size_t)u.pn * 256) * wk * 2;
        return true;
    }
};
__device__ __forceinline__ f32x4 silu4(f32x4 v) { return (f32x4){silu(v.x), silu(v.y), silu(v.z), silu(v.w)}; }
struct EpiUp {
    static constexpr bool PERM = true; bf16_t* hh;
    __device__ __forceinline__ void operator()(const f32x4 (&acc)[2][2][4][2], const pg::Unit& u, int wr, int wc, int fr, int fq) const {
#pragma unroll
        for (int ai = 0; ai < 2; ++ai)
#pragma unroll
            for (int m = 0; m < 4; ++m) {
                const int row = u.pm + ai * 128 + wr * 64 + m * 16 + fr, j = u.pn * 128 + wc * 32 + 8 * fq;
                *(u32x4*)(hh + (size_t)row * EFF + j) = pack8(silu4(acc[ai][0][m][0]) * acc[ai][1][m][0], silu4(acc[ai][0][m][1]) * acc[ai][1][m][1]);
            }
    }
};
__device__ __forceinline__ void phase_moe_up(const Params& p, LAS unsigned char* lds, int bid, int nblk, int l) {
    unsigned char* ws = p.ws;
    const int ntile = moe_meta(p, lds);
    SchedMoe<2, true> S{(const char*)(ws + OFF_HX), (const char*)(ws + W_GU) + (size_t)l * 65 * 512 * 1024 * 2, (const int*)(ws + OFF_TOKOF), (const int*)(ws + OFF_IDENT), lds, D, 512, D, ntile * 2, nblk, bid};
    EpiUp E{(bf16_t*)(ws + B_HH)};
    pg::gemm<true>(lds, D, D, D, S, E);
}
struct EpiDown {
    static constexpr bool PERM = true; const float* wof; bf16_t* Y; float* xres; const float* modl; int ss64;
    __device__ __forceinline__ void operator()(const f32x4 (&acc)[2][2][4][2], const pg::Unit& u, int wr, int wc, int fr, int fq) const {
        const int col0 = u.pn * 256 + wc * 32 + 8 * fq;
        if (u.e < 64) {
#pragma unroll
            for (int ai = 0; ai < 2; ++ai)
#pragma unroll
                for (int m = 0; m < 4; ++m) {
                    const int slot = u.pm + ai * 128 + wr * 64 + m * 16 + fr;
                    const float w = wof[slot];
                    bf16_t* yr = Y + (size_t)slot * D + col0;
                    *(u32x4*)(yr) = pack8(acc[ai][0][m][0] * w, acc[ai][0][m][1] * w);
                    *(u32x4*)(yr + 128) = pack8(acc[ai][1][m][0] * w, acc[ai][1][m][1] * w);
                    if (m & 1) asm volatile("" ::: "memory");
                }
        } else {
#pragma unroll
            for (int ai = 0; ai < 2; ++ai)
#pragma unroll
                for (int m = 0; m < 4; ++m) {
                    const int tok = u.pm - ss64 + ai * 128 + wr * 64 + m * 16 + fr;
                    const float* g2 = modl + (size_t)(tok >> 13) * 6144 + 5120 + col0;
                    float* xr = xres + (size_t)tok * D + col0;
#pragma unroll
                    for (int bj = 0; bj < 2; ++bj) {
                        f32x4* xo = (f32x4*)(xr + bj * 128);
                        xo[0] = xo[0] + *(const f32x4*)(g2 + bj * 128) * acc[ai][bj][m][0];
                        xo[1] = xo[1] + *(const f32x4*)(g2 + bj * 128 + 4) * acc[ai][bj][m][1];
                        asm volatile("" ::: "memory");
                    }
                }
        }
    }
};
__device__ __forceinline__ void phase_moe_down(const Params& p, LAS unsigned char* lds, int bid, int nblk, int l, const float* modl) {
    unsigned char* ws = p.ws;
    const int ntile = moe_meta(p, lds);
    const int ss64 = ((LAS int*)(lds + MOE_T_SS))[64];
    SchedMoe<4, false> S{(const char*)(ws + B_HH), (const char*)(ws + W_DN) + (size_t)l * 65 * 1024 * 256 * 2, nullptr, nullptr, lds, EFF, 1024, EFF, ntile * 4, nblk, bid};
    const float* wof = (const float*)(ws + OFF_WOF); bf16_t* Y = (bf16_t*)(ws + B_YY); float* xres = p.out;
    EpiDown E{wof, Y, xres, modl, ss64};
    pg::gemm<false>(lds, EFF, EFF, EFF, S, E);
}

#define XB_TMO      128
#define XB_XCNT(j)  (256  + 64 * (j))
#define XB_XSUB(j)  (1280 + 64 * (j))
#define XB_XGEN(j)  (2304 + 64 * (j))
#define XB_TOP      3328
#define XB_TOPGEN   3392
#define XCD_BAR_WORDS 3456
#define XB_SPIN_CAP (1u << 18)
__device__ __forceinline__ unsigned xb_ld(unsigned* p)              { return __hip_atomic_load(p, __ATOMIC_RELAXED, __HIP_MEMORY_SCOPE_AGENT); }
__device__ __forceinline__ unsigned xb_add(unsigned* p, unsigned v) { return __hip_atomic_fetch_add(p, v, __ATOMIC_RELAXED, __HIP_MEMORY_SCOPE_AGENT); }
__device__ __forceinline__ unsigned xb_xcc_id() { return (unsigned)__builtin_amdgcn_s_getreg((3 << 11) | 20) & 0xFu; }
#define XB_SPIN(cond, bar) do { unsigned _sp = 0; while (cond) { __builtin_amdgcn_s_sleep(1); \
    if ((++_sp & 255u) == 0u) { if (xb_ld(&(bar)[XB_TMO])) break; if (_sp > XB_SPIN_CAP) { atomicAdd(&(bar)[XB_TMO], 1u); break; } } } } while (0)
struct XcdBarrier { unsigned* bar; unsigned x; volatile LAS unsigned* st; };
__device__ __forceinline__ XcdBarrier xcd_barrier_post(unsigned* bar, volatile LAS unsigned* st) {
    XcdBarrier b; b.bar = bar; b.x = xb_xcc_id(); b.st = st;
    if (threadIdx.x == 0) (void)xb_add(&bar[XB_XCNT(b.x)], 1u);
    return b;
}
__device__ __forceinline__ void xcd_barrier_complete(unsigned* bar, unsigned x, unsigned& nloc, unsigned& nx) {
    const unsigned G = gridDim.x * gridDim.y * gridDim.z;
    unsigned sum, cnt, mine, sp = 0u;
    for (;;) {
        sum = 0u; cnt = 0u; mine = 0u;
#pragma unroll
        for (unsigned j = 0; j < 16; ++j) { const unsigned c = xb_ld(&bar[XB_XCNT(j)]); sum += c; cnt += (c > 0u) ? 1u : 0u; mine = (j == x) ? c : mine; }
        if (sum == G) break;
        __builtin_amdgcn_s_sleep(1);
        if ((++sp & 255u) == 0u) { if (xb_ld(&bar[XB_TMO])) break; if (sp > XB_SPIN_CAP) { atomicAdd(&bar[XB_TMO], 1u); break; } }
    }
    nloc = mine > 0u ? mine : 1u; nx = cnt > 0u ? cnt : 1u;
}
__device__ __forceinline__ void xcd_barrier(const XcdBarrier& b) {
    asm volatile("s_waitcnt vmcnt(0)" ::: "memory");
    __syncthreads();
    if (threadIdx.x == 0) {
        unsigned* bar = b.bar;
        __builtin_amdgcn_s_waitcnt(0);
        unsigned nloc = b.st[0], nx = b.st[1];
        if (nloc == 0u) { xcd_barrier_complete(bar, b.x, nloc, nx); b.st[0] = nloc; b.st[1] = nx; }
        const unsigned old = xb_add(&bar[XB_XSUB(b.x)], 1u);
        const unsigned gen = old / nloc;
        if (old + 1u == (gen + 1u) * nloc) {
            __builtin_amdgcn_fence(__ATOMIC_RELEASE, "agent");
            asm volatile("s_waitcnt vmcnt(0)" ::: "memory");
            const unsigned og = xb_add(&bar[XB_TOP], 1u);
            const unsigned tg = og / nx;
            if (og + 1u == (tg + 1u) * nx) xb_add(&bar[XB_TOPGEN], 1u);
            else XB_SPIN(xb_ld(&bar[XB_TOPGEN]) == tg, bar);
            __builtin_amdgcn_fence(__ATOMIC_ACQUIRE, "agent");
            xb_add(&bar[XB_XGEN(b.x)], 1u);
            asm volatile("s_waitcnt vmcnt(0)" ::: "memory");
        } else {
            XB_SPIN(xb_ld(&bar[XB_XGEN(b.x)]) == gen, bar);
            __builtin_amdgcn_fence(__ATOMIC_ACQUIRE, "agent");
            asm volatile("s_waitcnt vmcnt(0)" ::: "memory");
        }
    }
    __syncthreads();
}

__global__ void __launch_bounds__(NTHR) mk_fwd(Params p) {
    extern __shared__ __attribute__((aligned(16))) unsigned char lds_raw[];
    LAS unsigned char* lds = (LAS unsigned char*)lds_raw;
    cg::grid_group grid = cg::this_grid();
    const int bid = blockIdx.x, nblk = gridDim.x;
    unsigned char* ws = p.ws;
    const float* mod0 = (const float*)(ws + OFF_MOD); const float* mod1 = mod0 + 5 * 6144;

    { volatile LAS unsigned* st0 = (volatile LAS unsigned*)(lds + LDS_BYTES - 16); if (threadIdx.x < 4) st0[threadIdx.x] = 0u; }
    __syncthreads();
    XcdBarrier xb = xcd_barrier_post((unsigned*)ws, (volatile LAS unsigned*)(lds + LDS_BYTES - 16));
    phase0(p, lds, bid, nblk);
    grid.sync();
    row_phase<0, false, false>(p, bid, nblk, p.in[6], mod0, 0, 1024, nullptr);
    xcd_barrier(xb);
    phase_inproj0_pg(p, lds, bid, nblk);
    xcd_barrier(xb);
    phase_conv(p, bid, nblk);
    xcd_barrier(xb);
    phase_gates<false>(p, lds, bid, nblk);
    xcd_barrier(xb);
    phase_carry(p, bid, nblk);
    xcd_barrier(xb);
    phase_gates<true>(p, lds, bid, nblk);
    xcd_barrier(xb);
    phase_outproj_pg(p, lds, bid, nblk, (const bf16_t*)(ws + B_Z0), RW, (const bf16_t*)(ws + W_AOUT), mod0);
    xcd_barrier(xb);
    row_phase<1, true, false>(p, bid, nblk, p.in[7], mod0, 3072, 4096, nullptr);
    xcd_barrier(xb);
    phase_router(p, lds, bid, nblk, 0);
    xcd_barrier(xb);
    phase_scatter(p, lds, bid, nblk);
    xcd_barrier(xb);
    phase_moe_up(p, lds, bid, nblk, 0);
    xcd_barrier(xb);
    phase_moe_down(p, lds, bid, nblk, 0, mod0);
    xcd_barrier(xb);
    row_phase<2, false, false>(p, bid, nblk, p.in[6] + D, mod1, 0, 1024, mod0);
    xcd_barrier(xb);
    phase_inproj1_pg(p, lds, bid, nblk);
    xcd_barrier(xb);
    phase_lnT(p, lds, bid, nblk);
    xcd_barrier(xb);
    phase_sgu(p, lds, bid, nblk);
    xcd_barrier(xb);
    phase_outproj_pg(p, lds, bid, nblk, (const bf16_t*)(ws + B_Z1), SW, (const bf16_t*)(ws + W_BOUT), mod1);
    xcd_barrier(xb);
    row_phase<1, true, false>(p, bid, nblk, p.in[7] + D, mod1, 3072, 4096, nullptr);
    xcd_barrier(xb);
    phase_router(p, lds, bid, nblk, 1);
    xcd_barrier(xb);
    phase_scatter(p, lds, bid, nblk);
    xcd_barrier(xb);
    phase_moe_up(p, lds, bid, nblk, 1);
    xcd_barrier(xb);
    phase_moe_down(p, lds, bid, nblk, 1, mod1);
    xcd_barrier(xb);
    row_phase<2, false, true>(p, bid, nblk, p.in[29], mod1, 0, 0, mod1);
}

extern "C" void kernel_launch(void* const* d_in, const int* in_sizes, int n_in, void* d_out, int out_size, void* d_ws, size_t ws_size, hipStream_t stream) {
    static int grid_blocks = 0;
    if (grid_blocks == 0) {
        if (n_in != 30 || out_size != NTOK * D || ws_size < WS_NEED) { fprintf(stderr, "kernel_launch: unexpected shapes (n_in %d out %d ws %zu need %zu)\n", n_in, out_size, ws_size, (size_t)WS_NEED); grid_blocks = -1; return; }
        int dev = 0, cus = 0, per_cu = 0;
        (void)hipGetDevice(&dev);
        (void)hipDeviceGetAttribute(&cus, hipDeviceAttributeMultiprocessorCount, dev);
        if (hipFuncSetAttribute((const void*)mk_fwd, hipFuncAttributeMaxDynamicSharedMemorySize, LDS_BYTES) != hipSuccess) { fprintf(stderr, "kernel_launch: hipFuncSetAttribute failed\n"); grid_blocks = -1; return; }
        (void)hipOccupancyMaxActiveBlocksPerMultiprocessor(&per_cu, mk_fwd, NTHR, LDS_BYTES);
        if (per_cu < 1) per_cu = 1;
        if (per_cu > 2) per_cu = 2;
        grid_blocks = cus * per_cu;
        fprintf(stderr, "kernel_launch: cus %d per_cu %d grid %d\n", cus, per_cu, grid_blocks);
    }
    if (grid_blocks < 0) return;
    if (hipMemsetAsync(d_ws, 0, 65536, stream) != hipSuccess) { fprintf(stderr, "kernel_launch: memset failed\n"); return; }
    Params p{};
    for (int i = 0; i < 30; ++i) p.in[i] = (const float*)d_in[i];
    p.out = (float*)d_out; p.ws = (unsigned char*)d_ws;
    void* args[] = {&p};
    hipError_t e = hipLaunchCooperativeKernel((void*)mk_fwd, dim3(grid_blocks), dim3(NTHR), args, LDS_BYTES, stream);
    if (e != hipSuccess) fprintf(stderr, "cooperative launch failed: %s (grid %d)\n", hipGetErrorString(e), grid_blocks);
}
```

```cpp
#include <hip/hip_runtime.h>
#include <hip/hip_cooperative_groups.h>
#include <cstdio>
#include <cstdint>
namespace cg = cooperative_groups;

#define LAS __attribute__((address_space(3)))
typedef unsigned short bf16_t;
typedef short bf16x8 __attribute__((ext_vector_type(8)));
typedef float f32x4 __attribute__((ext_vector_type(4)));
typedef unsigned u32x4 __attribute__((ext_vector_type(4)));
typedef unsigned u32x2 __attribute__((ext_vector_type(2)));

constexpr int D = 1024, NB = 4, SEQ = 8192, NTOK = NB * SEQ, CTXL = 256, NCTX = NB * CTXL, NROW = NTOK + NCTX;
constexpr int RW = 1280;
constexpr int SW = 2048;
constexpr int NE = 64, TOPK = 8, EFF = 256;
constexpr int TM = 256;
constexpr int NSLOT = 278528;
constexpr int NTHR = 512;
constexpr int STG_OFF = 139264;
constexpr int LDS_BYTES = 157248;

constexpr size_t MiB = (size_t)1 << 20;
constexpr size_t OFF_MOD = 1 * MiB;
constexpr size_t OFF_POS = OFF_MOD + 262144;
constexpr size_t OFF_CDEC = OFF_POS + 262144;
constexpr size_t OFF_CNT = OFF_CDEC + 16384;
constexpr size_t OFF_META = OFF_CNT + 65536;
constexpr size_t OFF_IDENT = OFF_META + 4096 + 45056;
constexpr size_t OFF_AGG = 2 * MiB;
constexpr size_t OFF_CARRY = 8 * MiB;
constexpr size_t OFF_EIDX = 11 * MiB;
constexpr size_t OFF_GATEW = 12 * MiB;
constexpr size_t OFF_SLOTOF = 13 * MiB;
constexpr size_t OFF_TOKOF = 14 * MiB;
constexpr size_t OFF_WOF = 16 * MiB;
constexpr size_t OFF_CNTW2 = 17 * MiB + 512 * 1024;
constexpr size_t OFF_W = 18 * MiB;
constexpr size_t W_AIN = OFF_W;
constexpr size_t W_AOUT = W_AIN + (size_t)2560 * 1024 * 2;
constexpr size_t W_GATE = W_AOUT + (size_t)1024 * 1280 * 2;
constexpr size_t W_BIN = W_GATE + (size_t)5 * 1024 * 256 * 2;
constexpr size_t W_BOUT = W_BIN + (size_t)4096 * 1024 * 2;
constexpr size_t W_S = W_BOUT + (size_t)1024 * 2048 * 2;
constexpr size_t W_RT = W_S + (size_t)8 * 128 * 128 * 2;
constexpr size_t W_GU = W_RT + (size_t)2 * 128 * 3072 * 2;
constexpr size_t W_DN = W_GU + (size_t)2 * 65 * 512 * 1024 * 2;
constexpr size_t W_END = W_DN + (size_t)2 * 65 * 1024 * 256 * 2;
constexpr size_t OFF_HX = 237 * MiB;
constexpr size_t OFF_BIG = OFF_HX + 66 * MiB;
constexpr size_t OFF_STATP = OFF_BIG + 320 * MiB;
constexpr size_t B_GATE0 = OFF_BIG;
constexpr size_t B_UPRE = OFF_BIG + 80 * MiB;
constexpr size_t B_UU = OFF_BIG + 163 * MiB;
constexpr size_t B_Z0 = OFF_BIG + 246 * MiB;
constexpr size_t B_AB = OFF_BIG + 326 * MiB;
constexpr size_t B_CAR = OFF_BIG + 80 * MiB;
constexpr size_t B_DX0 = OFF_BIG + 326 * MiB;
constexpr size_t B_DX1 = OFF_BIG + 256 * MiB;
constexpr size_t B_UV = OFF_BIG;
constexpr size_t B_VNT = OFF_BIG + 256 * MiB;
constexpr size_t B_Z1 = OFF_BIG + 384 * MiB;
constexpr size_t B_HLO = OFF_BIG;
constexpr size_t B_HH = OFF_BIG;
constexpr size_t B_YY = OFF_BIG + 160 * MiB;
constexpr size_t B_YS = OFF_BIG + 448 * MiB;
constexpr size_t B_XR = OFF_BIG + 656 * MiB;
constexpr size_t WS_NEED = OFF_BIG + 720 * MiB;
static_assert(W_END <= OFF_HX, "weights overflow");
static_assert((size_t)(NSLOT + NTOK) * 256 * 2 <= 160 * MiB, "H overflow");
static_assert((size_t)NSLOT * 1024 * 2 <= 544 * MiB, "Y overflow");
static_assert(WS_NEED <= 1024 * MiB, "ws overflow");
constexpr long LO_DELTA = (long)((B_HLO - OFF_HX) / 2);

__device__ __forceinline__ unsigned f2bf(float f) { unsigned u = __builtin_bit_cast(unsigned, f); return (u + 0x7fffu + ((u >> 16) & 1u)) >> 16; }
__device__ __forceinline__ unsigned pk2(float lo, float hi) { unsigned r; asm volatile("v_cvt_pk_bf16_f32 %0, %1, %2" : "=v"(r) : "v"(lo), "v"(hi)); return r; }
__device__ __forceinline__ float bf2f(unsigned b) { return __builtin_bit_cast(float, b << 16); }
__device__ __forceinline__ float bflo(unsigned w) { return __builtin_bit_cast(float, w << 16); }
__device__ __forceinline__ float bfhi(unsigned w) { return __builtin_bit_cast(float, w & 0xffff0000u); }
__device__ __forceinline__ float sigm(float x) { return __builtin_amdgcn_rcpf(1.0f + __expf(-x)); }
__device__ __forceinline__ float silu(float x) { return x * __builtin_amdgcn_rcpf(1.0f + __expf(-x)); }
__device__ __forceinline__ float gelu_t(float x) { const float y = 1.5957691216057308f * (x + 0.044715f * x * x * x); return x * __builtin_amdgcn_rcpf(1.0f + __expf(-y)); }
template <int CTRL> __device__ __forceinline__ float dpp_mv(float v) { return __builtin_bit_cast(float, __builtin_amdgcn_update_dpp(__builtin_bit_cast(int, v), __builtin_bit_cast(int, v), CTRL, 0xf, 0xf, false)); }
template <int CTRL> __device__ __forceinline__ int dpp_mvi(int v) { return __builtin_amdgcn_update_dpp(v, v, CTRL, 0xf, 0xf, false); }
__device__ __forceinline__ float wave_sum(float v) {
    v += dpp_mv<0xB1>(v); v += dpp_mv<0x4E>(v); v += dpp_mv<0x141>(v); v += dpp_mv<0x140>(v);
    const int b = __builtin_bit_cast(int, v);
    return (__builtin_bit_cast(float, __builtin_amdgcn_readlane(b, 0)) + __builtin_bit_cast(float, __builtin_amdgcn_readlane(b, 16)))
         + (__builtin_bit_cast(float, __builtin_amdgcn_readlane(b, 32)) + __builtin_bit_cast(float, __builtin_amdgcn_readlane(b, 48)));
}
__device__ __forceinline__ float max8(float v) { v = fmaxf(v, dpp_mv<0xB1>(v)); v = fmaxf(v, dpp_mv<0x4E>(v)); return fmaxf(v, dpp_mv<0x141>(v)); }
__device__ __forceinline__ int min8(int v) { v = min(v, dpp_mvi<0xB1>(v)); v = min(v, dpp_mvi<0x4E>(v)); return min(v, dpp_mvi<0x141>(v)); }

__device__ __forceinline__ int opq_tid() { int t = threadIdx.x; asm volatile("" : "+v"(t)); return t; }
__device__ __forceinline__ u32x4 pack8(f32x4 a, f32x4 b) { u32x4 w; w.x = pk2(a.x, a.y); w.y = pk2(a.z, a.w); w.z = pk2(b.x, b.y); w.w = pk2(b.z, b.w); return w; }
__device__ __forceinline__ unsigned pk4_fp8(f32x4 v) { int w = 0; w = __builtin_amdgcn_cvt_pk_fp8_f32(v.x, v.y, w, false); w = __builtin_amdgcn_cvt_pk_fp8_f32(v.z, v.w, w, true); return (unsigned)w; }
__device__ __forceinline__ f32x4 up4_fp8(unsigned w) { return (f32x4){__builtin_amdgcn_cvt_f32_fp8((int)w, 0), __builtin_amdgcn_cvt_f32_fp8((int)w, 1), __builtin_amdgcn_cvt_f32_fp8((int)w, 2), __builtin_amdgcn_cvt_f32_fp8((int)w, 3)}; }
struct Params { const float* in[30]; float* out; unsigned char* ws; };

struct KDef { __device__ __forceinline__ long operator()(int kt) const { return (long)kt * 32; } };

template <class KOffA, class Epi>
__device__ __forceinline__ void gemm_tile(const bf16_t* arow, const bf16_t* brow, int nk, KOffA koffa, Epi epi, LAS unsigned char* lds) {
    const int tid = opq_tid(), lane = tid & 63, wid = tid >> 6, wr = wid >> 2, wc = wid & 3, fr = lane & 15, fq = lane >> 4;
    const int sw = (tid >> 2) * 80 + (tid & 3) * 16;
    f32x4 acc[4][2];
#pragma unroll
    for (int m = 0; m < 4; ++m)
#pragma unroll
        for (int n = 0; n < 2; ++n) acc[m][n] = (f32x4){0.f, 0.f, 0.f, 0.f};
    u32x4 ra = *(const u32x4*)(arow + koffa(0));
    u32x4 rb = *(const u32x4*)(brow);
    const int aoff = (wr * 64 + fr) * 80 + fq * 16, boff = 10240 + (wc * 32 + fr) * 80 + fq * 16;
    for (int kt = 0; kt < nk; ++kt) {
        LAS unsigned char* buf = lds + (kt & 1) * 20480;
        *(LAS u32x4*)(buf + sw) = ra;
        *(LAS u32x4*)(buf + 10240 + sw) = rb;
        __syncthreads();
        if (kt + 1 < nk) { ra = *(const u32x4*)(arow + koffa(kt + 1)); rb = *(const u32x4*)(brow + (long)(kt + 1) * 32); }
        bf16x8 af[4], bfv[2];
#pragma unroll
        for (int m = 0; m < 4; ++m) af[m] = *(LAS bf16x8*)(buf + aoff + m * 1280);
#pragma unroll
        for (int n = 0; n < 2; ++n) bfv[n] = *(LAS bf16x8*)(buf + boff + n * 1280);
#pragma unroll
        for (int m = 0; m < 4; ++m)
#pragma unroll
            for (int n = 0; n < 2; ++n) acc[m][n] = __builtin_amdgcn_mfma_f32_16x16x32_bf16(bfv[n], af[m], acc[m][n], 0, 0, 0);
    }
    __syncthreads();
#pragma unroll
    for (int m = 0; m < 4; ++m)
#pragma unroll
        for (int n = 0; n < 2; ++n) epi(wr * 64 + m * 16 + fr, wc * 32 + n * 16 + fq * 4, acc[m][n]);
}

namespace pg {
constexpr int BM = 256, BK = 64, HALF = 128, HTB = HALF * BK * 2, STAGE_BYTES = 8 * HTB;
__device__ __forceinline__ int lds_byte(int r, int c) { const int st = (r >> 4) * 2 + (c >> 5), rr = r & 15, cc = c & 31, ob = rr * 64 + cc * 2; return st * 1024 + (ob ^ (((ob >> 9) & 1) << 5)); }
__device__ __forceinline__ void stage_rc(int b, int& R, int& C) { const int st = b / 1024, sb = b % 1024, swz = sb ^ (((sb >> 9) & 1) << 5); R = (st >> 1) * 16 + swz / 64; C = (st & 1) * 32 + (swz % 64) / 2; }
__device__ __forceinline__ int perm32(int rho) { const int n = rho >> 4, i = rho & 15; return 8 * (i >> 2) + 4 * n + (i & 3); }
__device__ __forceinline__ int xcd_remap(int L, int nwg) { const int q = nwg / 8, r = nwg % 8, xcd = L % 8, off = L / 8; return (xcd < r ? xcd * (q + 1) : r * (q + 1) + (xcd - r) * q) + off; }

struct Unit { const char* a; const char* b; const int* rows; int pm, pn, e; };

template <bool GATHER, class Sched, class Epi>
__device__ __forceinline__ void gemm(LAS unsigned char* lds, const int K, const int lda, const int ldb, const Sched& S, const Epi& E) {
    const int tid = opq_tid(), wid = __builtin_amdgcn_readfirstlane(tid >> 6), lane = tid & 63, wr = wid >> 2, wc = wid & 3, fr = lane & 15, fq = lane >> 4;
    const int nt = K / BK;
    int RA[2]; unsigned ca2[2], voffB[2][2];
#pragma unroll
    for (int i = 0; i < 2; ++i) { int R, C; stage_rc(tid * 16 + i * 8192, R, C);
        RA[i] = R; ca2[i] = (unsigned)C * 2u;
#pragma unroll
        for (int h = 0; h < 2; ++h) {
            const int Rb = (int)Epi::PERM == 2 ? 64 * (R >> 5) + 32 * h + perm32(R & 31) : HALF * h + ((int)Epi::PERM == 1 ? ((R & ~31) + perm32(R & 31)) : R);
            voffB[h][i] = (unsigned)(Rb * ldb + C) * 2u; } }
    const unsigned lda2 = (unsigned)lda * 2u;
    const size_t kstep = (size_t)(BK * 2);
    const unsigned ldsw = (unsigned)wid * 1024u;
    const int aoff = lds_byte(wr * 64 + fr, fq * 8), boff = lds_byte(wc * 32 + fr, fq * 8);
    unsigned vc[2][2], vn[2][2];
#define PG_SA(b, h) (((b) * 2 + (h)) * HTB)
#define PG_SB(b, h) ((4 + (b) * 2 + (h)) * HTB)
#define PG_GL(bufoff, gp0, gp1) do { \
        __builtin_amdgcn_global_load_lds((const unsigned*)(gp0), (LAS unsigned*)(lds + (bufoff) + ldsw), 16, 0, 0); \
        __builtin_amdgcn_global_load_lds((const unsigned*)(gp1), (LAS unsigned*)(lds + (bufoff) + ldsw + 8192), 16, 0, 0); } while (0)
#define PG_STB(bufoff, gbase, h) PG_GL(bufoff, (const char*)(gbase) + voffB[h][0], (const char*)(gbase) + voffB[h][1])
#define PG_STA(bufoff, gbase, V, h) PG_GL(bufoff, (const char*)(gbase) + V[h][0], (const char*)(gbase) + V[h][1])
#define PG_LDA(dst, b, h) do { _Pragma("unroll") for (int m = 0; m < 4; ++m) _Pragma("unroll") for (int k = 0; k < 2; ++k) dst[m][k] = *(const LAS bf16x8*)(lds + PG_SA(b, h) + aoff + m * 2048 + k * 1024); } while (0)
#define PG_LDB(dst, b, h) do { _Pragma("unroll") for (int n = 0; n < 2; ++n) _Pragma("unroll") for (int k = 0; k < 2; ++k) dst[n][k] = *(const LAS bf16x8*)(lds + PG_SB(b, h) + boff + n * 2048 + k * 1024); } while (0)
#define PG_MMA(ai, bj, At, Bt) do { __builtin_amdgcn_s_setprio(1); _Pragma("unroll") for (int m = 0; m < 4; ++m) _Pragma("unroll") for (int n = 0; n < 2; ++n) _Pragma("unroll") for (int k = 0; k < 2; ++k) \
        acc[ai][bj][m][n] = __builtin_amdgcn_mfma_f32_16x16x32_bf16(Bt[n][k], At[m][k], acc[ai][bj][m][n], 0, 0, 0); __builtin_amdgcn_s_setprio(0); } while (0)
#define PG_WAIT_V(n) asm volatile("s_waitcnt vmcnt(" #n ")" ::: "memory")
#define PG_WAIT_L(n) asm volatile("s_waitcnt lgkmcnt(" #n ")" ::: "memory")
#define PG_BAR __builtin_amdgcn_s_barrier()
#define PG_SCHED __builtin_amdgcn_sched_barrier(0)
#define PG_SETOFF(V, U) do { _Pragma("unroll") for (int h = 0; h < 2; ++h) _Pragma("unroll") for (int i = 0; i < 2; ++i) \
        V[h][i] = (GATHER ? (unsigned)(U).rows[RA[i] + HALF * h] : (unsigned)(RA[i] + HALF * h)) * lda2 + ca2[i]; } while (0)
    Unit cur, nxt; int ui = 0;
    if (!S.next(0, cur)) return;
    PG_SETOFF(vc, cur);
    f32x4 acc[2][2][4][2];
#pragma unroll
    for (int a = 0; a < 2; ++a)
#pragma unroll
        for (int b = 0; b < 2; ++b)
#pragma unroll
            for (int m = 0; m < 4; ++m)
#pragma unroll
                for (int n = 0; n < 2; ++n) acc[a][b][m][n] = (f32x4){0.f, 0.f, 0.f, 0.f};
    bf16x8 At[4][2], B0[2][2], B1[2][2];
    const char* cA = cur.a; const char* cB = cur.b;
    PG_STB(PG_SB(0, 0), cB, 0); PG_STB(PG_SB(0, 1), cB, 1); PG_STA(PG_SA(0, 0), cA, vc, 0); PG_STA(PG_SA(0, 1), cA, vc, 1);
    if (wr == 1) PG_BAR;
    PG_WAIT_V(2); PG_BAR;
    PG_STB(PG_SB(1, 0), cB + kstep, 0); PG_STA(PG_SA(1, 0), cA + kstep, vc, 0); PG_STB(PG_SB(1, 1), cB + kstep, 1);
    PG_WAIT_V(6); PG_BAR;
#define PG_PAIR(a1, a2, b2, a3, b3, SWAP) do { \
        PG_LDB(B0, 0, 0); PG_LDB(B1, 0, 1); PG_SCHED; PG_LDA(At, 0, 0); PG_STA(PG_SA(1, 1), a1, vc, 1); \
        if (GATHER) { if (SWAP) { vc[0][0] = vn[0][0]; vc[0][1] = vn[0][1]; vc[1][0] = vn[1][0]; vc[1][1] = vn[1][1]; } } \
        PG_WAIT_V(8); PG_WAIT_L(0); PG_BAR; PG_MMA(0, 0, At, B0); PG_MMA(0, 1, At, B1); PG_BAR; PG_SCHED; \
        PG_LDA(At, 0, 1); PG_STB(PG_SB(0, 0), b2, 0); PG_STB(PG_SB(0, 1), b2, 1); PG_STA(PG_SA(0, 0), a2, vc, 0); \
        PG_WAIT_V(8); PG_WAIT_L(0); PG_BAR; PG_MMA(1, 0, At, B0); PG_MMA(1, 1, At, B1); PG_BAR; PG_SCHED; \
        PG_LDB(B0, 1, 0); PG_LDB(B1, 1, 1); PG_SCHED; PG_LDA(At, 1, 0); PG_STA(PG_SA(0, 1), a2, vc, 1); \
        PG_WAIT_V(8); PG_WAIT_L(0); PG_BAR; PG_MMA(0, 0, At, B0); PG_MMA(0, 1, At, B1); PG_BAR; PG_SCHED; \
        PG_LDA(At, 1, 1); PG_STB(PG_SB(1, 0), b3, 0); PG_STB(PG_SB(1, 1), b3, 1); PG_STA(PG_SA(1, 0), a3, vc, 0); \
        PG_WAIT_V(8); PG_WAIT_L(0); PG_BAR; PG_MMA(1, 0, At, B0); PG_MMA(1, 1, At, B1); PG_BAR; PG_SCHED; } while (0)
    for (;;) {
        const bool has_next = S.next(ui + 1, nxt);
        const char* nA = has_next ? nxt.a : cA; const char* nB = has_next ? nxt.b : cB;
        if (GATHER) { if (has_next) { PG_SETOFF(vn, nxt); } }
#pragma nounroll
        for (int t = 0; t < nt; t += 2) {
            const bool last = (t == nt - 2);
            const char* a1 = cA + (size_t)(t + 1) * kstep;
            const char* a2 = last ? nA : cA + (size_t)(t + 2) * kstep; const char* b2 = last ? nB : cB + (size_t)(t + 2) * kstep;
            const char* a3 = a2 + kstep; const char* b3 = b2 + kstep;
            PG_PAIR(a1, a2, b2, a3, b3, (last && has_next));
        }
        if (wr == 0) PG_BAR;
        { int efr = fr, efq = fq; asm volatile("" : "+v"(efr), "+v"(efq)); E(acc, cur, wr, wc, efr, efq); }
        if (!has_next) break;
#pragma unroll
        for (int a = 0; a < 2; ++a)
#pragma unroll
            for (int b = 0; b < 2; ++b)
#pragma unroll
                for (int m = 0; m < 4; ++m)
#pragma unroll
                    for (int n = 0; n < 2; ++n) acc[a][b][m][n] = (f32x4){0.f, 0.f, 0.f, 0.f};
        cur = nxt; cA = nA; cB = nB; ++ui;
        if (wr == 1) PG_BAR;
    }
    PG_WAIT_V(0);
    PG_BAR;
#undef PG_SA
#undef PG_SB
#undef PG_GL
#undef PG_STB
#undef PG_STA
#undef PG_LDA
#undef PG_LDB
#undef PG_MMA
#undef PG_WAIT_V
#undef PG_WAIT_L
#undef PG_BAR
#undef PG_SCHED
#undef PG_SETOFF
#undef PG_PAIR
}

struct SchedPlain {
    const char* A; const char* B; int lda, ldb, nM, nN, nwg, G, c;
    __device__ __forceinline__ bool next(int i, Unit& u) const {
        const long L = (long)i * G + c; if (L >= nwg) return false;
        const int wgid = xcd_remap((int)L, nwg);
        const int nig = 8 * nN, gid = wgid / nig, fm = gid * 8, gsz = (nM - fm) < 8 ? (nM - fm) : 8;
        u.pm = fm + ((wgid % nig) % gsz); u.pn = (wgid % nig) / gsz; u.e = 0; u.rows = nullptr;
        u.a = A + (size_t)u.pm * BM * lda * 2; u.b = B + (size_t)u.pn * BM * ldb * 2; return true;
    }
};
}

__device__ __forceinline__ void tr_item(const float* W, int N, int k0, int n0, bf16_t* WT, int ldt, int mode, int rmul, int radd, LAS float* scr, int lane) {
    f32x4 t[16];
#pragma unroll
    for (int i = 0; i < 16; ++i) t[i] = *(const f32x4*)(W + (size_t)(k0 + (lane >> 4) + 4 * i) * N + n0 + (lane & 15) * 4);
#pragma unroll
    for (int i = 0; i < 16; ++i) { LAS float* d = scr + ((lane >> 4) + 4 * i) * 65 + (lane & 15) * 4; d[0] = t[i].x; d[1] = t[i].y; d[2] = t[i].z; d[3] = t[i].w; }
    asm volatile("s_waitcnt lgkmcnt(0)" ::: "memory");
    const int c = lane & 7;
#pragma unroll
    for (int j = 0; j < 8; ++j) {
        const int n = (lane >> 3) + 8 * j; const LAS float* s = scr + (8 * c) * 65 + n;
        u32x4 o; o.x = pk2(s[0 * 65], s[1 * 65]); o.y = pk2(s[2 * 65], s[3 * 65]); o.z = pk2(s[4 * 65], s[5 * 65]); o.w = pk2(s[6 * 65], s[7 * 65]);
        const int ng = n0 + n;
        const int drow = mode == 1 ? (((ng & 255) >> 7) * 256 + (ng >> 8) * 128 + (ng & 127))
                       : mode == 2 ? ((ng >> 6) * 256 + ((ng >> 1) & 1) * 128 + ((ng >> 4) & 3) * 32 + (ng & 1) * 16 + ((ng >> 2) & 3) * 4 + radd) : ng * rmul + radd;
        *(u32x4*)(WT + (size_t)drow * ldt + k0 + 8 * c) = o;
    }
    asm volatile("s_waitcnt lgkmcnt(0)" ::: "memory");
}

__device__ __forceinline__ void phase0(const Params& p, LAS unsigned char* lds, int bid, int nblk) {
    const int tid = opq_tid(), lane = tid & 63, wid = tid >> 6;
    unsigned char* ws = p.ws;
    const int gt = bid * NTHR + tid, ngt = nblk * NTHR;
    float* pos = (float*)(ws + OFF_POS);
    for (int i = gt; i < 128 * 512; i += ngt) {
        const int r = i >> 9, c = i & 511, q = c & 255;
        const float omega = 1.0f / exp2f((float)q * (13.287712379549449f / 256.0f));
        const float ang = (float)r * omega;
        pos[i] = c < 256 ? __sinf(ang) : __cosf(ang);
    }
    float* cdec = (float*)(ws + OFF_CDEC);
    for (int i = gt; i < 2 * RW; i += ngt) cdec[i] = -8.0f * log1pf(expf(-p.in[15][i]));
    { int* ident = (int*)(ws + OFF_IDENT); for (int i = gt; i < NTOK; i += ngt) ident[i] = i; }
    {
        bf16_t* ws_s = (bf16_t*)(ws + W_S);
        for (int i = gt; i < 8 * 128 * 128; i += ngt) ws_s[i] = (bf16_t)f2bf(p.in[20][i]);
        bf16_t* wrt = (bf16_t*)(ws + W_RT);
        for (int i = gt; i < 2 * 1024 * 64; i += ngt) {
            const int l = i >> 16, k = (i >> 6) & 1023, e = i & 63;
            const float w = p.in[23][i];
            const unsigned hi = f2bf(w); const unsigned lo = f2bf(w - bf2f(hi));
            bf16_t* row = wrt + ((size_t)(l * 128 + e)) * 3072;
            row[k] = (bf16_t)hi; row[1024 + k] = (bf16_t)hi; row[2048 + k] = (bf16_t)lo;
        }
        unsigned* wz = (unsigned*)wrt;
        for (int i = gt; i < 2 * 64 * 1536; i += ngt) { const int l = i / (64 * 1536), r = i % (64 * 1536); wz[(size_t)(l * 128 + 64) * 1536 + r] = 0u; }
    }
    for (int it = bid; it < 192; it += nblk) {
        LAS float* sv = (LAS float*)lds;
        LAS float* red = (LAS float*)(lds + 20480);
        for (int i = tid; i < 5 * 1024; i += NTHR) { const float cv = i < 4096 ? p.in[1][i] : p.in[3][i - 4096]; sv[i] = silu(cv); }
        __syncthreads();
        const int l = it / 96, col0 = (it % 96) * 64;
        const float* w = p.in[4] + (size_t)l * 1024 * 6144 + col0 + lane;
        float a0 = 0.f, a1 = 0.f, a2 = 0.f, a3 = 0.f, a4 = 0.f;
        const int kb = wid * 128;
#pragma unroll 8
        for (int k = kb; k < kb + 128; ++k) {
            const float wv = w[(size_t)k * 6144];
            a0 += sv[k] * wv; a1 += sv[1024 + k] * wv; a2 += sv[2048 + k] * wv; a3 += sv[3072 + k] * wv; a4 += sv[4096 + k] * wv;
        }
        red[(wid * 5 + 0) * 64 + lane] = a0; red[(wid * 5 + 1) * 64 + lane] = a1; red[(wid * 5 + 2) * 64 + lane] = a2;
        red[(wid * 5 + 3) * 64 + lane] = a3; red[(wid * 5 + 4) * 64 + lane] = a4;
        __syncthreads();
        if (tid < 320) {
            const int v = tid >> 6, ln = tid & 63; float s = 0.f;
#pragma unroll
            for (int w8 = 0; w8 < 8; ++w8) s += red[(w8 * 5 + v) * 64 + ln];
            ((float*)(ws + OFF_MOD))[(size_t)(l * 5 + v) * 6144 + col0 + ln] = s + p.in[5][l * 6144 + col0 + ln];
        }
        __syncthreads();
    }
    LAS float* scr = (LAS float*)(lds + wid * 16640);
    const int gw = bid * 8 + wid, ngw = nblk * 8;
    constexpr int I_AIN = 16 * 40, I_AOUT = 20 * 16, I_GATE = 20 * 16, I_BIN = 16 * 64, I_BOUT = 32 * 16;
    constexpr int NITEMS = I_AIN + I_AOUT + I_GATE + I_BIN + I_BOUT;
    for (int it = gw; it < NITEMS; it += ngw) {
        int r = it;
        if (r < I_AIN) { const int kb = r / 40, nb = r % 40; tr_item(p.in[8], 2560, kb * 64, nb * 64, (bf16_t*)(ws + W_AIN), 1024, 0, 1, 0, scr, lane); continue; }
        r -= I_AIN;
        if (r < I_AOUT) { const int kb = r / 16, nb = r % 16; tr_item(p.in[16], 1024, kb * 64, nb * 64, (bf16_t*)(ws + W_AOUT), 1280, 0, 1, 0, scr, lane); continue; }
        r -= I_AOUT;
        if (r < I_GATE) {
            const int mi = r >> 4, q = r & 15, kb = q >> 2, nb = q & 3, h = mi % 5, dg = mi / 5, d = dg >> 1, g = dg & 1;
            const float* src = (g ? p.in[13] : p.in[11]) + (size_t)(d * 5 + h) * 65536;
            tr_item(src, 256, kb * 64, nb * 64, (bf16_t*)(ws + W_GATE) + (size_t)h * 1024 * 256, 256, 2, 4, d * 2 + g, scr, lane); continue; }
        r -= I_GATE;
        if (r < I_BIN) { const int kb = r / 64, nb = r % 64; tr_item(p.in[17], 4096, kb * 64, nb * 64, (bf16_t*)(ws + W_BIN), 1024, 0, 1, 0, scr, lane); continue; }
        r -= I_BIN;
        { const int kb = r / 16, nb = r % 16; tr_item(p.in[22], 1024, kb * 64, nb * 64, (bf16_t*)(ws + W_BOUT), 2048, 0, 1, 0, scr, lane); }
    }
}

constexpr int BG_TILES = 65 * 128 + 65 * 64, BG_CHUNKS = BG_TILES / 8;
__device__ __forceinline__ void bg_tile(const Params& p, int l, int t, LAS float* scr, int lane) {
    unsigned char* ws = p.ws;
    if (t < 65 * 128) { const int e = t >> 7, q = t & 127, kb = q >> 3, nb = q & 7, le = l * 65 + e;
        const float* src = e < 64 ? p.in[25] + (size_t)(l * 64 + e) * 1024 * 512 : p.in[27] + (size_t)l * 1024 * 512;
        tr_item(src, 512, kb * 64, nb * 64, (bf16_t*)(ws + W_GU) + (size_t)le * 512 * 1024, 1024, 1, 1, 0, scr, lane);
    } else { const int r = t - 65 * 128, e = r >> 6, q = r & 63, kb = q >> 4, nb = q & 15, le = l * 65 + e;
        const float* src = e < 64 ? p.in[26] + (size_t)(l * 64 + e) * 256 * 1024 : p.in[28] + (size_t)l * 256 * 1024;
        tr_item(src, 1024, kb * 64, nb * 64, (bf16_t*)(ws + W_DN) + (size_t)le * 1024 * 256, 256, 0, 1, 0, scr, lane); }
}
__device__ __forceinline__ void bg_convert(const Params& p, LAS unsigned char* lds, int l, int maxchunks) {
    const int tid = opq_tid(), lane = tid & 63, wid = tid >> 6;
    unsigned* q = (unsigned*)(p.ws + 32768) + l * 64;
    LAS int* slot = (LAS int*)(lds + LDS_BYTES - 64);
    LAS float* scr = (LAS float*)(lds + wid * 16640);
    for (int n = 0; n < maxchunks; ++n) {
        if (tid == 0) *slot = (int)atomicAdd(q, 1u);
        __syncthreads();
        const int c = *slot;
        __syncthreads();
        if (c >= BG_CHUNKS) break;
        bg_tile(p, l, c * 8 + wid, scr, lane);
    }
    __syncthreads();
}
__device__ __forceinline__ bool bg_idle(int nunits, int G, int c) { return (nunits - c + G - 1) / G < (nunits + G - 1) / G; }

template <int MODE, bool WRITE_LO, bool FINAL>
__device__ __forceinline__ void row_phase(const Params& p, int bid, int nblk, const float* gnorm, const float* modl  , int off_sh, int off_sc,
                                           const float* modprev  , const bf16_t* dx  ) {
    const int tid = opq_tid(), lane = tid & 63, wid = tid >> 6;
    unsigned char* ws = p.ws;
    float* xout = p.out;
    bf16_t* xres = (bf16_t*)(ws + B_XR);
    bf16_t* hx = (bf16_t*)(ws + OFF_HX);
    bf16_t* hlo = (bf16_t*)(ws + B_HLO);
    const float* pos = (const float*)(ws + OFF_POS);
    const int* slotof = (const int*)(ws + OFF_SLOTOF);
    const bf16_t* Y = (const bf16_t*)(ws + B_YY);
    const int nrows = MODE == 0 ? NROW : NTOK;
    for (int row = bid * 8 + wid; row < nrows; row += nblk * 8) {
        f32x4 v[4];
        int mv;
        if (MODE == 0) {
            if (row < NTOK) {
                mv = row >> 13; const int t = row & (SEQ - 1);
                const f32x4* xr = (const f32x4*)(p.in[0] + (size_t)row * D) + lane;
                const f32x4* pr = (const f32x4*)(pos + (size_t)(t >> 6) * 512) + lane;
                const f32x4* pc = (const f32x4*)(pos + (size_t)(t & 63) * 512) + lane;
                v[0] = xr[0] + pr[0]; v[1] = xr[64] + pr[64]; v[2] = xr[128] + pc[0]; v[3] = xr[192] + pc[64];
                u32x2* xo = (u32x2*)(xres + (size_t)row * D) + lane;
#pragma unroll
                for (int j = 0; j < 4; ++j) xo[64 * j] = (u32x2){pk2(v[j].x, v[j].y), pk2(v[j].z, v[j].w)};
            } else {
                mv = 4;
                const f32x4* xr = (const f32x4*)(p.in[2] + (size_t)(row - NTOK) * D) + lane;
#pragma unroll
                for (int j = 0; j < 4; ++j) v[j] = xr[64 * j];
            }
        } else {
            mv = row >> 13;
            u32x2* xo = (u32x2*)(xres + (size_t)row * D) + lane;
#pragma unroll
            for (int j = 0; j < 4; ++j) { const u32x2 w = xo[64 * j]; v[j] = (f32x4){bflo(w.x), bfhi(w.x), bflo(w.y), bfhi(w.y)}; }
            if (MODE == 1) {
                const u32x2* dr = (const u32x2*)(dx + (size_t)row * D) + lane;
#pragma unroll
                for (int j = 0; j < 4; ++j) { const u32x2 w = dr[64 * j]; v[j].x += bflo(w.x); v[j].y += bfhi(w.x); v[j].z += bflo(w.y); v[j].w += bfhi(w.y); xo[64 * j] = (u32x2){pk2(v[j].x, v[j].y), pk2(v[j].z, v[j].w)}; }
            }
            if (MODE == 2) {
                f32x4 s[4];
                {
                    const unsigned* yr = (const unsigned*)(ws + B_YS + (size_t)row * D) + lane;
#pragma unroll
                    for (int j = 0; j < 4; ++j) s[j] = up4_fp8(yr[64 * j]);
                }
#pragma unroll
                for (int k = 0; k < TOPK; ++k) {
                    const int slot = slotof[row * 8 + k];
                    const unsigned* yr = (const unsigned*)(ws + B_YY + (size_t)slot * D) + lane;
#pragma unroll
                    for (int j = 0; j < 4; ++j) s[j] = s[j] + up4_fp8(yr[64 * j]);
                }
                const f32x4* g2 = (const f32x4*)(modprev + (size_t)mv * 6144 + 5120) + lane;
#pragma unroll
                for (int j = 0; j < 4; ++j) { v[j] = v[j] + g2[64 * j] * s[j]; if (!FINAL) xo[64 * j] = (u32x2){pk2(v[j].x, v[j].y), pk2(v[j].z, v[j].w)}; }
            }
        }
        float ss = 0.f;
#pragma unroll
        for (int j = 0; j < 4; ++j) ss += (v[j].x * v[j].x + v[j].y * v[j].y) + (v[j].z * v[j].z + v[j].w * v[j].w);
        ss = wave_sum(ss);
        const float rinv = 1.0f / sqrtf(ss * (1.0f / D) + 1e-6f);
        const f32x4* gn = (const f32x4*)gnorm + lane;
        if (FINAL) {
            f32x4* xo = (f32x4*)(xout + (size_t)row * D) + lane;
#pragma unroll
            for (int j = 0; j < 4; ++j) xo[64 * j] = v[j] * rinv * gn[64 * j];
        } else {
            const f32x4* sh = (const f32x4*)(modl + (size_t)mv * 6144 + off_sh) + lane;
            const f32x4* sc = (const f32x4*)(modl + (size_t)mv * 6144 + off_sc) + lane;
            u32x2* ho = (u32x2*)(hx + (size_t)row * D) + lane;
            u32x2* lo = (u32x2*)(hlo + (size_t)row * D) + lane;
#pragma unroll
            for (int j = 0; j < 4; ++j) {
                const f32x4 y = v[j] * rinv * gn[64 * j] * (sc[64 * j] + 1.0f) + sh[64 * j];
                u32x2 w; w.x = pk2(y.x, y.y); w.y = pk2(y.z, y.w);
                ho[64 * j] = w;
                if (WRITE_LO) { u32x2 q; q.x = pk2(y.x - bflo(w.x), y.y - bfhi(w.x)); q.y = pk2(y.z - bflo(w.y), y.w - bfhi(w.y)); lo[64 * j] = q; }
            }
        }
    }
}

__device__ __forceinline__ void phase_inproj0(const Params& p, LAS unsigned char* lds, int bid, int nblk) {
    unsigned char* ws = p.ws;
    const bf16_t* hx = (const bf16_t*)(ws + OFF_HX); const bf16_t* W = (const bf16_t*)(ws + W_AIN);
    bf16_t* gate0 = (bf16_t*)(ws + B_GATE0); bf16_t* upre = (bf16_t*)(ws + B_UPRE);
    const int tid = opq_tid(), srow = tid >> 2, skc = (tid & 3) * 8;
    constexpr int NU = 256 * 20 + 8 * 10;
    for (int u = bid; u < NU; u += nblk) {
        int mt, nt;
        if (u < 5120) { mt = u / 20; nt = u % 20; } else { const int q = u - 5120; mt = 256 + q / 10; nt = 10 + q % 10; }
        const bf16_t* arow = hx + (size_t)(mt * 128 + srow) * D + skc;
        const bf16_t* brow = W + (size_t)(nt * 128 + srow) * D + skc;
        gemm_tile(arow, brow, 32, KDef(), [=](int r, int c, f32x4 v) {
            const int row = mt * 128 + r, col = nt * 128 + c;
            if (col < RW) { u32x2 w; w.x = pk2(gelu_t(v.x), gelu_t(v.y)); w.y = pk2(gelu_t(v.z), gelu_t(v.w)); *(u32x2*)(gate0 + (size_t)row * RW + col) = w; }
            else { u32x2 w; w.x = pk2(v.x, v.y); w.y = pk2(v.z, v.w); *(u32x2*)(upre + (size_t)row * RW + (col - RW)) = w; }
        }, lds);
    }
}

__device__ __forceinline__ void phase_conv(const Params& p, int bid, int nblk) {
    unsigned char* ws = p.ws;
    const bf16_t* upre = (const bf16_t*)(ws + B_UPRE); bf16_t* uu = (bf16_t*)(ws + B_UU);
    const float* cw = p.in[9]; const float* cb = p.in[10];
    const int gt = bid * NTHR + opq_tid(), ngt = nblk * NTHR;
    for (int item = gt; item < (NROW / 16) * 160; item += ngt) {
        const int rb = item / 160, cg8 = (item % 160) * 8, R0 = rb * 16;
        int t0, T;
        if (R0 < NTOK) { t0 = R0 & (SEQ - 1); T = SEQ; } else { t0 = (R0 - NTOK) & (CTXL - 1); T = CTXL; }
        f32x4 wa[4], wb[4];
#pragma unroll
        for (int k = 0; k < 4; ++k) { wa[k] = *(const f32x4*)(cw + k * RW + cg8); wb[k] = *(const f32x4*)(cw + k * RW + cg8 + 4); }
        const f32x4 ba = *(const f32x4*)(cb + cg8), bb = *(const f32x4*)(cb + cg8 + 4);
        u32x4 raw[19];
#pragma unroll
        for (int j = 0; j < 19; ++j) { const int tt = t0 + j - 2; raw[j] = (tt >= 0 && tt < T) ? *(const u32x4*)(upre + (size_t)(R0 + j - 2) * RW + cg8) : (u32x4){0u, 0u, 0u, 0u}; }
#pragma unroll
        for (int r = 0; r < 16; ++r) {
            f32x4 oa = ba, ob = bb;
#pragma unroll
            for (int k = 0; k < 4; ++k) { const u32x4 w = raw[r + k];
                oa = oa + wa[k] * (f32x4){bflo(w.x), bfhi(w.x), bflo(w.y), bfhi(w.y)}; ob = ob + wb[k] * (f32x4){bflo(w.z), bfhi(w.z), bflo(w.w), bfhi(w.w)}; }
            *(u32x4*)(uu + (size_t)(R0 + r) * RW + cg8) = pack8(oa, ob);
        }
    }
}

__device__ __forceinline__ void phase_outproj(const Params& p, LAS unsigned char* lds, int bid, int nblk, const bf16_t* Z, int K, const bf16_t* W, const float* modl) {
    float* xres = p.out;
    const int tid = opq_tid(), srow = tid >> 2, skc = (tid & 3) * 8;
    for (int u = bid; u < 256 * 8; u += nblk) {
        const int mt = u >> 3, nt = u & 7;
        const bf16_t* arow = Z + (size_t)(mt * 128 + srow) * K + skc;
        const bf16_t* brow = W + (size_t)(nt * 128 + srow) * K + skc;
        gemm_tile(arow, brow, K / 32, KDef(), [=](int r, int c, f32x4 v) {
            const int row = mt * 128 + r, col = nt * 128 + c;
            const f32x4 g1 = *(const f32x4*)(modl + (size_t)(row >> 13) * 6144 + 2048 + col);
            f32x4* xo = (f32x4*)(xres + (size_t)row * D + col);
            *xo = *xo + g1 * v;
        }, lds);
    }
}

__device__ __forceinline__ float rdlane(float v, int l) { return __builtin_bit_cast(float, __builtin_amdgcn_readlane(__builtin_bit_cast(int, v), l)); }
__device__ __forceinline__ float xmax(float v, int m) { return fmaxf(v, __shfl_xor(v, m)); }
__device__ __forceinline__ void phase_router(const Params& p, LAS unsigned char* lds, int bid, int nblk, int l) {
    unsigned char* ws = p.ws;
    const bf16_t* hx = (const bf16_t*)(ws + OFF_HX); const bf16_t* W = (const bf16_t*)(ws + W_RT) + (size_t)l * 128 * 3072;
    int* eidx = (int*)(ws + OFF_EIDX); float* gatew = (float*)(ws + OFF_GATEW); int* cnt = (int*)(ws + OFF_CNT); int* cntw = (int*)(ws + OFF_CNTW2);
    const int tid = opq_tid(), lane = tid & 63, wid = tid >> 6, fr = lane & 15, fq = lane >> 4;
    const float rbl = p.in[24][l * 64 + lane];
    LAS float* part = (LAS float*)lds;
    LAS float* L = (LAS float*)(lds + 69632);
    LAS int* cw = (LAS int*)(lds + 69632 + 8320);
    bf16x8 Bh[4][4], Bl[4][4];
#pragma unroll
    for (int s = 0; s < 4; ++s)
#pragma unroll
        for (int nb = 0; nb < 4; ++nb) { const bf16_t* wp = W + (size_t)(16 * nb + fr) * 3072 + 128 * wid + 32 * s + 8 * fq; Bh[s][nb] = *(const bf16x8*)wp; Bl[s][nb] = *(const bf16x8*)(wp + 2048); }
    bf16x8 Ah[2][4], Al[2][4];
#define RT_LOADA(ROW0) do { _Pragma("unroll") for (int g = 0; g < 2; ++g) _Pragma("unroll") for (int s = 0; s < 4; ++s) { \
        const bf16_t* ap = hx + (size_t)((ROW0) + 16 * g + fr) * D + 128 * wid + 32 * s + 8 * fq; Ah[g][s] = *(const bf16x8*)ap; Al[g][s] = *(const bf16x8*)(ap + LO_DELTA); } } while (0)
    if (bid < 256) RT_LOADA(bid * 128);
    for (int tile = bid; tile < 256; tile += nblk) {
        int cnt_e = 0;
        for (int it = 0; it < 4; ++it) {
            const int row0 = tile * 128 + it * 32;
            f32x4 acc[2][4];
#pragma unroll
            for (int g = 0; g < 2; ++g)
#pragma unroll
                for (int nb = 0; nb < 4; ++nb) acc[g][nb] = (f32x4){0.f, 0.f, 0.f, 0.f};
#pragma unroll
            for (int g = 0; g < 2; ++g)
#pragma unroll
                for (int s = 0; s < 4; ++s)
#pragma unroll
                    for (int nb = 0; nb < 4; ++nb) {
                        acc[g][nb] = __builtin_amdgcn_mfma_f32_16x16x32_bf16(Bh[s][nb], Ah[g][s], acc[g][nb], 0, 0, 0);
                        acc[g][nb] = __builtin_amdgcn_mfma_f32_16x16x32_bf16(Bh[s][nb], Al[g][s], acc[g][nb], 0, 0, 0);
                        acc[g][nb] = __builtin_amdgcn_mfma_f32_16x16x32_bf16(Bl[s][nb], Ah[g][s], acc[g][nb], 0, 0, 0);
                    }
            {
                const int nrow0 = it < 3 ? row0 + 32 : (tile + nblk) * 128;
                if (nrow0 < NTOK) RT_LOADA(nrow0);
            }
#pragma unroll
            for (int g = 0; g < 2; ++g)
#pragma unroll
                for (int nb = 0; nb < 4; ++nb) *(LAS f32x4*)(part + ((wid * 32 + 16 * g + fr) * 68 + 16 * nb + 4 * fq)) = acc[g][nb];
            __syncthreads();
            {
                const int r = tid >> 4, e0 = (tid & 15) * 4;
                f32x4 s = (f32x4){0.f, 0.f, 0.f, 0.f};
#pragma unroll
                for (int w = 0; w < 8; ++w) s = s + *(LAS f32x4*)(part + ((w * 32 + r) * 68 + e0));
                LAS float* o = L + r * 65 + e0; o[0] = s.x; o[1] = s.y; o[2] = s.z; o[3] = s.w;
            }
            __syncthreads();
#pragma unroll 1
            for (int j = 0; j < 4; ++j) {
                const int r = 4 * wid + j, tok = row0 + r;
                const float sc = sigm(L[r * 65 + lane]), sel = sc + rbl;
                const float m1 = xmax(xmax(xmax(sel, 1), 2), 4);
                int cand = sel == m1 ? lane : 64; cand = min(cand, __shfl_xor(cand, 1)); cand = min(cand, __shfl_xor(cand, 2)); cand = min(cand, __shfl_xor(cand, 4));
                const float s2 = lane == cand ? -__builtin_inff() : sel;
                const float gs = m1 + xmax(xmax(xmax(s2, 1), 2), 4);
                const int g = lane >> 3; int rank = 0;
#pragma unroll
                for (int gp = 0; gp < 8; ++gp) { const float o = rdlane(gs, gp * 8); rank += (o > gs || (o == gs && gp < g)) ? 1 : 0; }
                const bool keep = rank < 4;
                const unsigned bits = __builtin_bit_cast(unsigned, sel), srt = (bits & 0x80000000u) ? ~bits : (bits | 0x80000000u);
                const unsigned key = keep ? ((srt & ~63u) | (unsigned)(63 - lane)) : 0u;
                LAS unsigned* kb = (LAS unsigned*)(lds + 80000) + wid * 64;
                kb[lane] = key;
                int er = 0;
#pragma unroll
                for (int q4 = 0; q4 < 16; ++q4) { const u32x4 k4 = *(LAS u32x4*)(kb + 4 * q4); er += (k4.x > key ? 1 : 0) + (k4.y > key ? 1 : 0) + (k4.z > key ? 1 : 0) + (k4.w > key ? 1 : 0); }
                const bool chosen = keep && er < 8;
                const float ssum = wave_sum(chosen ? sc : 0.0f);
                if (chosen) { eidx[tok * 8 + er] = lane | (cnt_e << 8); gatew[tok * 8 + er] = sc * (2.5f / ssum); }
                cnt_e += chosen ? 1 : 0;
            }
        }
        cntw[(tile * 8 + wid) * 64 + lane] = cnt_e;
        cw[wid * 64 + lane] = cnt_e;
        __syncthreads();
        if (tid < 64) { int c = 0;
#pragma unroll
            for (int w = 0; w < 8; ++w) c += cw[w * 64 + tid];
            cnt[tile * 64 + tid] = c; }
        __syncthreads();
    }
}

__device__ __forceinline__ void phase_normroute(const Params& p, LAS unsigned char* lds, int bid, int nblk, int l, const float* gnorm, const float* modl, const bf16_t* dx) {
    unsigned char* ws = p.ws;
    bf16_t* xres = (bf16_t*)(ws + B_XR); bf16_t* hx = (bf16_t*)(ws + OFF_HX);
    const bf16_t* W = (const bf16_t*)(ws + W_RT) + (size_t)l * 128 * 3072;
    int* eidx = (int*)(ws + OFF_EIDX); float* gatew = (float*)(ws + OFF_GATEW); int* cnt = (int*)(ws + OFF_CNT); int* cntw = (int*)(ws + OFF_CNTW2);
    const int tid = opq_tid(), lane = tid & 63, wid = tid >> 6, fr = lane & 15, fq = lane >> 4;
    const float rbl = p.in[24][l * 64 + lane];
    LAS unsigned char* ahi = lds;
    LAS unsigned char* alo = lds + 33024;
    LAS float* part = (LAS float*)(lds + 66048);
    LAS float* L = (LAS float*)(lds + 66048 + 34816);
    LAS unsigned* kbase = (LAS unsigned*)(lds + 66048 + 34816 + 4224);
    LAS int* cw = (LAS int*)(lds + 66048 + 34816 + 4224 + 2048);
    bf16x8 Bh[4][4], Bl[4][4];
#pragma unroll
    for (int s = 0; s < 4; ++s)
#pragma unroll
        for (int nb = 0; nb < 4; ++nb) { const bf16_t* wp = W + (size_t)(16 * nb + fr) * 3072 + 128 * wid + 32 * s + 8 * fq; Bh[s][nb] = *(const bf16x8*)wp; Bl[s][nb] = *(const bf16x8*)(wp + 2048); }
    const f32x4* gn = (const f32x4*)gnorm + lane;
    u32x2 xa[2][4], da[2][4];
#define NR_LOAD(ROW0) do { _Pragma("unroll") for (int q = 0; q < 2; ++q) { const size_t r_ = (size_t)(ROW0) + 2 * wid + q; _Pragma("unroll") for (int j = 0; j < 4; ++j) { \
        xa[q][j] = ((const u32x2*)(xres + r_ * D) + lane)[64 * j]; da[q][j] = ((const u32x2*)(dx + r_ * D) + lane)[64 * j]; } } } while (0)
    if (bid < 256) NR_LOAD(bid * 128);
    for (int tile = bid; tile < 256; tile += nblk) {
        int cnt_e = 0;
        const int mv = tile >> 6;
        f32x4 ca[4];
#pragma unroll
        for (int j = 0; j < 4; ++j) ca[j] = gn[64 * j] * (((const f32x4*)(modl + (size_t)mv * 6144 + 4096) + lane)[64 * j] + 1.0f);
        const f32x4* sh = (const f32x4*)(modl + (size_t)mv * 6144 + 3072) + lane;
        for (int grp = 0; grp < 8; ++grp) {
            const int row0 = tile * 128 + grp * 16;
#pragma unroll
            for (int q = 0; q < 2; ++q) {
                const int rl = 2 * wid + q; const size_t row = (size_t)row0 + rl;
                f32x4 v[4]; float ss = 0.f;
#pragma unroll
                for (int j = 0; j < 4; ++j) { const u32x2 a = xa[q][j], b = da[q][j];
                    v[j] = (f32x4){bflo(a.x) + bflo(b.x), bfhi(a.x) + bfhi(b.x), bflo(a.y) + bflo(b.y), bfhi(a.y) + bfhi(b.y)};
                    ((u32x2*)(xres + row * D) + lane)[64 * j] = (u32x2){pk2(v[j].x, v[j].y), pk2(v[j].z, v[j].w)};
                    ss += (v[j].x * v[j].x + v[j].y * v[j].y) + (v[j].z * v[j].z + v[j].w * v[j].w); }
                ss = wave_sum(ss);
                const float rinv = 1.0f / sqrtf(ss * (1.0f / D) + 1e-6f);
#pragma unroll
                for (int j = 0; j < 4; ++j) {
                    const f32x4 y = v[j] * rinv * ca[j] + sh[64 * j];
                    u32x2 w; w.x = pk2(y.x, y.y); w.y = pk2(y.z, y.w);
                    ((u32x2*)(hx + row * D) + lane)[64 * j] = w;
                    u32x2 ql; ql.x = pk2(y.x - bflo(w.x), y.y - bfhi(w.x)); ql.y = pk2(y.z - bflo(w.y), y.w - bfhi(w.y));
                    *(LAS u32x2*)(ahi + rl * 2064 + (lane + 64 * j) * 8) = w; *(LAS u32x2*)(alo + rl * 2064 + (lane + 64 * j) * 8) = ql;
                }
            }
            __syncthreads();
            {
                const int nrow0 = grp < 7 ? row0 + 16 : (tile + nblk) * 128;
                if (nrow0 < NTOK) NR_LOAD(nrow0);
            }
            f32x4 acc[4];
#pragma unroll
            for (int nb = 0; nb < 4; ++nb) acc[nb] = (f32x4){0.f, 0.f, 0.f, 0.f};
#pragma unroll
            for (int s = 0; s < 4; ++s) {
                const int ko = fr * 2064 + (128 * wid + 32 * s + 8 * fq) * 2;
                const bf16x8 Ah = *(LAS bf16x8*)(ahi + ko), Al = *(LAS bf16x8*)(alo + ko);
#pragma unroll
                for (int nb = 0; nb < 4; ++nb) {
                    acc[nb] = __builtin_amdgcn_mfma_f32_16x16x32_bf16(Bh[s][nb], Ah, acc[nb], 0, 0, 0);
                    acc[nb] = __builtin_amdgcn_mfma_f32_16x16x32_bf16(Bh[s][nb], Al, acc[nb], 0, 0, 0);
                    acc[nb] = __builtin_amdgcn_mfma_f32_16x16x32_bf16(Bl[s][nb], Ah, acc[nb], 0, 0, 0);
                }
            }
#pragma unroll
            for (int nb = 0; nb < 4; ++nb) *(LAS f32x4*)(part + ((wid * 16 + fr) * 68 + 16 * nb + 4 * fq)) = acc[nb];
            __syncthreads();
#pragma unroll 1
            for (int j = 0; j < 2; ++j) {
                const int r = 2 * wid + j, tok = row0 + r;
                float lg = 0.f;
#pragma unroll
                for (int w = 0; w < 8; ++w) lg += part[(w * 16 + r) * 68 + lane];
                const float scv = sigm(lg), sel = scv + rbl;
                const float m1 = max8(sel);
                const int cand = min8(sel == m1 ? lane : 64);
                const float s2 = lane == cand ? -__builtin_inff() : sel;
                const float gs = m1 + max8(s2);
                const int g = lane >> 3; int rank = 0;
#pragma unroll
                for (int gp = 0; gp < 8; ++gp) { const float o = rdlane(gs, gp * 8); rank += (o > gs || (o == gs && gp < g)) ? 1 : 0; }
                const bool keep = rank < 4;
                const unsigned bits = __builtin_bit_cast(unsigned, sel), srt = (bits & 0x80000000u) ? ~bits : (bits | 0x80000000u);
                const unsigned key = keep ? ((srt & ~63u) | (unsigned)(63 - lane)) : 0u;
                LAS unsigned* kb = kbase + wid * 64;
                kb[lane] = key;
                int er = 0;
#pragma unroll
                for (int q4 = 0; q4 < 16; ++q4) { const u32x4 k4 = *(LAS u32x4*)(kb + 4 * q4); er += (k4.x > key ? 1 : 0) + (k4.y > key ? 1 : 0) + (k4.z > key ? 1 : 0) + (k4.w > key ? 1 : 0); }
                const bool chosen = keep && er < 8;
                const float ssum = wave_sum(chosen ? scv : 0.0f);
                if (chosen) { eidx[tok * 8 + er] = lane | (cnt_e << 8); gatew[tok * 8 + er] = scv * (2.5f / ssum); }
                cnt_e += chosen ? 1 : 0;
            }
        }
        cntw[(tile * 8 + wid) * 64 + lane] = cnt_e;
        cw[wid * 64 + lane] = cnt_e;
        __syncthreads();
        if (tid < 64) { int c = 0;
#pragma unroll
            for (int w = 0; w < 8; ++w) c += cw[w * 64 + tid];
            cnt[tile * 64 + tid] = c; }
        __syncthreads();
    }
#undef NR_LOAD
}

__device__ __forceinline__ void phase_scatter(const Params& p, LAS unsigned char* lds, int bid, int nblk, int l) {
    unsigned char* ws = p.ws;
    const int* eidx = (const int*)(ws + OFF_EIDX); const float* gatew = (const float*)(ws + OFF_GATEW); const int* cnt = (const int*)(ws + OFF_CNT); const int* cntw = (const int*)(ws + OFF_CNTW2);
    int* slotof = (int*)(ws + OFF_SLOTOF); int* tokof = (int*)(ws + OFF_TOKOF); float* wof = (float*)(ws + OFF_WOF); int* meta = (int*)(ws + OFF_META);
    const int tid = opq_tid();
    LAS int* ps = (LAS int*)lds;
    LAS int* tot = (LAS int*)(lds + 2048);
    LAS int* sst = (LAS int*)(lds + 2048 + 256);
    LAS int* base = (LAS int*)(lds + 4096);
    LAS int* cl = (LAS int*)(lds + 8192);
    for (int i = tid; i < 256 * 64; i += NTHR) cl[i] = cnt[i];
    __syncthreads();
    {
        const int e = tid & 63, part = tid >> 6; int s = 0;
#pragma unroll 8
        for (int r = part * 32; r < part * 32 + 32; ++r) s += cl[r * 64 + e];
        ps[part * 64 + e] = s;
    }
    __syncthreads();
    if (tid < 64) { int s = 0; for (int q = 0; q < 8; ++q) s += ps[q * 64 + tid]; tot[tid] = s; }
    __syncthreads();
    if (tid == 0) { int a = 0; for (int e = 0; e < 64; ++e) { sst[e] = a; a += (tot[e] + TM - 1) / TM * TM; } sst[64] = a; sst[65] = a + NTOK; }
    __syncthreads();
    for (int tile = bid; tile < 256; tile += nblk) {
        {
            const int e = tid & 63, part = tid >> 6; int s = 0;
#pragma unroll 8
            for (int r = part * 32; r < part * 32 + 32; ++r) s += r < tile ? cl[r * 64 + e] : 0;
            ps[part * 64 + e] = s;
        }
        __syncthreads();
        {
            const int e = tid & 63, w = tid >> 6; int b = sst[e];
#pragma unroll
            for (int q = 0; q < 8; ++q) b += ps[q * 64 + e];
#pragma unroll
            for (int q = 0; q < 8; ++q) b += q < w ? cntw[(tile * 8 + q) * 64 + e] : 0;
            base[w * 64 + e] = b;
        }
        __syncthreads();
#pragma unroll
        for (int i = 0; i < 2; ++i) {
            const int a = tid + NTHR * i, r = a >> 3, tok = tile * 128 + r, w = (r & 15) >> 1;
            const int code = eidx[tile * 1024 + a], e = code & 63, lr = code >> 8;
            const int slot = base[w * 64 + e] + lr;
            tokof[slot] = tok; wof[slot] = gatew[tile * 1024 + a]; slotof[tile * 1024 + a] = slot;
        }
        if (tile == 0) {
            if (tid < 64) for (int s = sst[tid] + tot[tid]; s < sst[tid + 1]; ++s) { tokof[s] = 0; wof[s] = 0.0f; }
            if (tid < 66) meta[tid] = sst[tid];
        }
        __syncthreads();
    }
    bg_convert(p, lds, l, 1 << 30);
}

__device__ __forceinline__ void phase_inproj1(const Params& p, LAS unsigned char* lds, int bid, int nblk) {
    unsigned char* ws = p.ws;
    const bf16_t* hx = (const bf16_t*)(ws + OFF_HX); const bf16_t* W = (const bf16_t*)(ws + W_BIN); bf16_t* uv = (bf16_t*)(ws + B_UV);
    const int tid = opq_tid(), srow = tid >> 2, skc = (tid & 3) * 8;
    for (int u = bid; u < 256 * 32; u += nblk) {
        const int mt = u >> 5, nt = u & 31;
        const bf16_t* arow = hx + (size_t)(mt * 128 + srow) * D + skc;
        const bf16_t* brow = W + (size_t)(nt * 128 + srow) * D + skc;
        gemm_tile(arow, brow, 32, KDef(), [=](int r, int c, f32x4 v) {
            u32x2 w; w.x = pk2(gelu_t(v.x), gelu_t(v.y)); w.y = pk2(gelu_t(v.z), gelu_t(v.w));
            *(u32x2*)(uv + (size_t)(mt * 128 + r) * 4096 + nt * 128 + c) = w;
        }, lds);
    }
}

__device__ __forceinline__ void phase_sgu(const Params& p, LAS unsigned char* lds, int bid, int nblk) {
    unsigned char* ws = p.ws;
    const bf16_t* Wsb = (const bf16_t*)(ws + W_S); const bf16_t* uv = (const bf16_t*)(ws + B_UV); const float* statp = (const float*)(ws + OFF_STATP);
    bf16_t* z1 = (bf16_t*)(ws + B_Z1); const float* bs = p.in[21]; const float* lng = p.in[18]; const float* lnb = p.in[19];
    const int tid = opq_tid(), lane = tid & 63, wid = tid >> 6, wr = wid >> 2, wc = wid & 3, fr = lane & 15, fq = lane >> 4;
    LAS unsigned char* sa = lds;
    LAS unsigned char* sb = lds + 34816;
    LAS float* st = (LAS float*)(lds + 69632);
    u32x4 ra[4], rb[4], ru[4]; f32x4 rg[2], rbb[2]; float rm = 0.f, rr = 0.f;
#define SG_LOAD(U) do { const int chunk_ = (U) >> 4, g_ = ((U) >> 1) & 7, nt_ = (U) & 1; _Pragma("unroll") for (int k = 0; k < 4; ++k) { const int idx = k * NTHR + tid, r = idx >> 4, c8 = (idx & 15) * 8; \
        ra[k] = *(const u32x4*)(Wsb + (size_t)(g_ * 128 + r) * 128 + c8); rb[k] = *(const u32x4*)(uv + (size_t)(chunk_ * 128 + r) * 4096 + 2048 + g_ * 256 + nt_ * 128 + c8); \
        ru[k] = *(const u32x4*)(uv + (size_t)(chunk_ * 128 + r) * 4096 + g_ * 256 + nt_ * 128 + c8); } \
        { const int ch_ = g_ * 256 + nt_ * 128 + (tid & 15) * 8; rg[0] = *(const f32x4*)(lng + ch_); rg[1] = *(const f32x4*)(lng + ch_ + 4); rbb[0] = *(const f32x4*)(lnb + ch_); rbb[1] = *(const f32x4*)(lnb + ch_ + 4); } \
        if (tid < 128) { const f32x4* sp = (const f32x4*)(statp + (size_t)(chunk_ * 128 + tid) * 64); float S_ = 0.f, Q_ = 0.f; \
            _Pragma("unroll") for (int k = 0; k < 16; ++k) { const f32x4 t_ = sp[k]; S_ += t_.x + t_.z; Q_ += t_.y + t_.w; } \
            rm = S_ * (1.0f / SW); rr = 1.0f / sqrtf(fmaxf(Q_ * (1.0f / SW) - rm * rm, 0.0f) + 1e-6f); } } while (0)
    if (bid < 4096) SG_LOAD(bid);
    for (int u = bid; u < 256 * 16; u += nblk) {
        const int chunk = u >> 4, g = (u >> 1) & 7, nt = u & 1, R0 = chunk * 128;
        if (tid < 128) { st[tid * 2] = rm; st[tid * 2 + 1] = rr; }
        __syncthreads();
#pragma unroll
        for (int k = 0; k < 4; ++k) {
            const int idx = k * NTHR + tid, r = idx >> 4, c16 = (idx & 15) * 16;
            *(LAS u32x4*)(sa + r * 272 + c16) = ra[k];
            const float mean = st[r * 2], rstd = st[r * 2 + 1]; const u32x4 w = rb[k];
            const f32x4 x0 = ((f32x4){bflo(w.x), bfhi(w.x), bflo(w.y), bfhi(w.y)} - mean) * rstd * rg[0] + rbb[0];
            const f32x4 x1 = ((f32x4){bflo(w.z), bfhi(w.z), bflo(w.w), bfhi(w.w)} - mean) * rstd * rg[1] + rbb[1];
            *(LAS u32x4*)(sb + r * 272 + c16) = pack8(x0, x1);
        }
        u32x4 uc[4];
#pragma unroll
        for (int k = 0; k < 4; ++k) uc[k] = ru[k];
        float bsv[4];
#pragma unroll
        for (int m = 0; m < 4; ++m) bsv[m] = bs[g * 128 + wr * 64 + m * 16 + fr];
        __syncthreads();
        if (u + nblk < 4096) SG_LOAD(u + nblk);
        f32x4 acc[4][2];
#pragma unroll
        for (int m = 0; m < 4; ++m)
#pragma unroll
            for (int n = 0; n < 2; ++n) acc[m][n] = (f32x4){0.f, 0.f, 0.f, 0.f};
#pragma unroll
        for (int ks = 0; ks < 4; ++ks) {
            bf16x8 af[4], bfv[2];
#pragma unroll
            for (int m = 0; m < 4; ++m) af[m] = *(LAS bf16x8*)(sa + (wr * 64 + m * 16 + fr) * 272 + ks * 64 + fq * 16);
#pragma unroll
            for (int n = 0; n < 2; ++n) {
                const LAS unsigned short* bp = (const LAS unsigned short*)(sb + (ks * 32 + fq * 8) * 272 + (wc * 32 + n * 16 + fr) * 2);
#pragma unroll
                for (int j = 0; j < 8; ++j) bfv[n][j] = (short)bp[j * 136];
            }
#pragma unroll
            for (int m = 0; m < 4; ++m)
#pragma unroll
                for (int n = 0; n < 2; ++n) acc[m][n] = __builtin_amdgcn_mfma_f32_16x16x32_bf16(bfv[n], af[m], acc[m][n], 0, 0, 0);
        }
        __syncthreads();
#pragma unroll
        for (int m = 0; m < 4; ++m) { const int r = wr * 64 + m * 16 + fr; const float b = bsv[m];
#pragma unroll
            for (int n = 0; n < 2; ++n) { const f32x4 v = acc[m][n]; u32x2 o; o.x = pk2(v.x + b, v.y + b); o.y = pk2(v.z + b, v.w + b); *(LAS u32x2*)(sa + r * 272 + (wc * 32 + n * 16 + fq * 4) * 2) = o; } }
        __syncthreads();
#pragma unroll
        for (int k = 0; k < 4; ++k) {
            const int idx = k * NTHR + tid, r = idx >> 4, c8 = (idx & 15) * 8;
            const u32x4 ov = *(LAS u32x4*)(sa + r * 272 + c8 * 2), uw = uc[k];
            u32x4 z; z.x = pk2(bflo(uw.x) * bflo(ov.x), bfhi(uw.x) * bfhi(ov.x)); z.y = pk2(bflo(uw.y) * bflo(ov.y), bfhi(uw.y) * bfhi(ov.y));
            z.z = pk2(bflo(uw.z) * bflo(ov.z), bfhi(uw.z) * bfhi(ov.z)); z.w = pk2(bflo(uw.w) * bflo(ov.w), bfhi(uw.w) * bfhi(ov.w));
            *(u32x4*)(z1 + (size_t)(R0 + r) * SW + g * 256 + nt * 128 + c8) = z;
        }
        __syncthreads();
    }
#undef SG_LOAD
}

template <class F> struct EpiP8 {
    static constexpr int PERM = 1; F f;
    __device__ __forceinline__ void operator()(const f32x4 (&acc)[2][2][4][2], const pg::Unit& u, int wr, int wc, int fr, int fq) const {
#pragma unroll
        for (int ai = 0; ai < 2; ++ai)
#pragma unroll
            for (int m = 0; m < 4; ++m)
#pragma unroll
                for (int bj = 0; bj < 2; ++bj) f(u, ai * 128 + wr * 64 + m * 16 + fr, bj * 128 + wc * 32 + 8 * fq, acc[ai][bj][m][0], acc[ai][bj][m][1]);
    }
};
template <class F> struct EpiP4 {
    static constexpr int PERM = 0; F f;
    __device__ __forceinline__ void operator()(const f32x4 (&acc)[2][2][4][2], const pg::Unit& u, int wr, int wc, int fr, int fq) const {
#pragma unroll
        for (int ai = 0; ai < 2; ++ai)
#pragma unroll
            for (int m = 0; m < 4; ++m)
#pragma unroll
                for (int bj = 0; bj < 2; ++bj)
#pragma unroll
                    for (int n = 0; n < 2; ++n) f(u, ai * 128 + wr * 64 + m * 16 + fr, bj * 128 + wc * 32 + 16 * n + 4 * fq, acc[ai][bj][m][n]);
    }
};
template <class F> __device__ __forceinline__ EpiP8<F> make_p8(F f) { return EpiP8<F>{f}; }
template <class F> __device__ __forceinline__ EpiP4<F> make_p4(F f) { return EpiP4<F>{f}; }
__device__ __forceinline__ f32x4 gelu4(f32x4 v) { return (f32x4){gelu_t(v.x), gelu_t(v.y), gelu_t(v.z), gelu_t(v.w)}; }

__device__ __forceinline__ void stg_sync() { asm volatile("s_waitcnt lgkmcnt(0)" ::: "memory"); __builtin_amdgcn_s_barrier(); asm volatile("" ::: "memory"); }
template <class RowPtr>
__device__ __forceinline__ void stg_step512(LAS unsigned char* stg, int wr, int wc, int fr, int fq, int o0, int o1, u32x4 p0, u32x4 p1, RowPtr rp) {
    LAS unsigned char* w = stg + (wr * 16 + fr) * 528;
    *(LAS u32x4*)(w + o0) = p0; *(LAS u32x4*)(w + o1) = p1;
    stg_sync();
    const int tid = (wr * 4 + wc) * 64 + fq * 16 + fr;
#pragma unroll
    for (int k = 0; k < 2; ++k) { const int idx = k * 512 + tid, rl = idx >> 5, c = idx & 31; const u32x4 v = *(LAS u32x4*)(stg + rl * 528 + c * 16); *(u32x4*)(rp(rl) + c * 16) = v; }
    stg_sync();
}
template <class RowPtr>
__device__ __forceinline__ void stg_step256(LAS unsigned char* stg, int wr, int wc, int fr, int fq, u32x4 p0, RowPtr rp) {
    *(LAS u32x4*)(stg + (wr * 16 + fr) * 272 + wc * 64 + fq * 16) = p0;
    stg_sync();
    const int tid = (wr * 4 + wc) * 64 + fq * 16 + fr, rl = tid >> 4, c = tid & 15;
    const u32x4 v = *(LAS u32x4*)(stg + rl * 272 + c * 16); *(u32x4*)(rp(rl) + c * 16) = v;
    stg_sync();
}
template <class Xf, class RowPtr> struct EpiStage {
    static constexpr int PERM = 1; LAS unsigned char* stg; Xf xf; RowPtr rowptr;
    __device__ __forceinline__ void operator()(const f32x4 (&acc)[2][2][4][2], const pg::Unit& u, int wr, int wc, int fr, int fq) const {
#pragma unroll
        for (int ai = 0; ai < 2; ++ai)
#pragma unroll
            for (int m = 0; m < 4; ++m) {
                const u32x4 p0 = xf(u, 0, wc, fq, acc[ai][0][m][0], acc[ai][0][m][1]), p1 = xf(u, 1, wc, fq, acc[ai][1][m][0], acc[ai][1][m][1]);
                stg_step512(stg, wr, wc, fr, fq, wc * 64 + fq * 16, 256 + wc * 64 + fq * 16, p0, p1,
                            [&](int rl) { return rowptr(u, ai * 128 + (rl >> 4) * 64 + m * 16 + (rl & 15)); });
            }
    }
};
template <class Xf, class RowPtr> __device__ __forceinline__ EpiStage<Xf, RowPtr> make_stage(LAS unsigned char* stg, Xf xf, RowPtr rp) { return EpiStage<Xf, RowPtr>{stg, xf, rp}; }
template <class Xf, class RowPtr> struct EpiDirect {
    static constexpr int PERM = 2; Xf xf; RowPtr rowptr;
    __device__ __forceinline__ void operator()(const f32x4 (&acc)[2][2][4][2], const pg::Unit& u, int wr, int wc, int fr, int fq) const {
#pragma unroll
        for (int ai = 0; ai < 2; ++ai)
#pragma unroll
            for (int m = 0; m < 4; ++m) {
                unsigned char* rp = rowptr(u, ai * 128 + wr * 64 + m * 16 + fr) + (64 * wc + 8 * fq) * 2;
                *(u32x4*)rp = xf(u, 0, wc, fq, acc[ai][0][m][0], acc[ai][0][m][1]);
                *(u32x4*)(rp + 64) = xf(u, 1, wc, fq, acc[ai][1][m][0], acc[ai][1][m][1]);
            }
    }
};
template <class Xf, class RowPtr> __device__ __forceinline__ EpiDirect<Xf, RowPtr> make_direct(Xf xf, RowPtr rp) { return EpiDirect<Xf, RowPtr>{xf, rp}; }

struct SchedIn0 {
    const char* A; const char* B; int G, c;
    __device__ __forceinline__ bool next(int i, pg::Unit& u) const {
        const int L = i * G + c; if (L >= 1300) return false;
        if (L < 1280) { const int wgid = pg::xcd_remap(L, 1280); u.pm = (wgid / 80) * 8 + (wgid % 80) % 8; u.pn = (wgid % 80) / 8; }
        else { const int q = L - 1280; u.pm = 128 + q / 5; u.pn = 5 + q % 5; }
        u.e = 0; u.rows = nullptr; u.a = A + (size_t)u.pm * 256 * D * 2; u.b = B + (size_t)u.pn * 256 * D * 2; return true;
    }
};
__device__ __forceinline__ void phase_inproj0_pg(const Params& p, LAS unsigned char* lds, int bid, int nblk) {
    unsigned char* ws = p.ws;
    unsigned char* gate0 = ws + B_GATE0; unsigned char* upre = ws + B_UPRE;
    SchedIn0 S{(const char*)(ws + OFF_HX), (const char*)(ws + W_AIN), nblk, bid};
    auto E = make_direct(
        [=](const pg::Unit& u, int bj, int wc, int fq, f32x4 v0, f32x4 v1) { return u.pn < 5 ? pack8(gelu4(v0), gelu4(v1)) : pack8(v0, v1); },
        [=](const pg::Unit& u, int r) { const size_t row = (size_t)u.pm * 256 + r; return u.pn < 5 ? gate0 + (row * RW + u.pn * 256) * 2 : upre + (row * RW + (u.pn - 5) * 256) * 2; });
    pg::gemm<false>(lds, D, D, D, S, E);
    if (bg_idle(1300, nblk, bid)) bg_convert(p, lds, 0, 4);
}
__device__ __forceinline__ void phase_outproj_pg(const Params& p, LAS unsigned char* lds, int bid, int nblk, const bf16_t* Z, int K, const bf16_t* W, const float* modl, unsigned char* dx) {
    pg::SchedPlain S{(const char*)Z, (const char*)W, K, K, 128, 4, 512, nblk, bid};
    auto E = make_direct(
        [=](const pg::Unit& u, int bj, int wc, int fq, f32x4 v0, f32x4 v1) {
            const float* g1 = modl + (size_t)(u.pm >> 5) * 6144 + 2048 + u.pn * 256 + wc * 64 + bj * 32 + 8 * fq;
            return pack8(v0 * *(const f32x4*)g1, v1 * *(const f32x4*)(g1 + 4)); },
        [=](const pg::Unit& u, int r) { return dx + (((size_t)u.pm * 256 + r) * D + u.pn * 256) * 2; });
    pg::gemm<false>(lds, K, K, K, S, E);
}
struct EpiIn1 {
    static constexpr int PERM = 2; unsigned char* uv; float* statp;
    __device__ __forceinline__ void operator()(const f32x4 (&acc)[2][2][4][2], const pg::Unit& u, int wr, int wc, int fr, int fq) const {
#pragma unroll
        for (int ai = 0; ai < 2; ++ai)
#pragma unroll
            for (int m = 0; m < 4; ++m) {
                const size_t row = (size_t)u.pm * 256 + ai * 128 + wr * 64 + m * 16 + fr;
                const u32x4 p0 = pack8(gelu4(acc[ai][0][m][0]), gelu4(acc[ai][0][m][1])), p1 = pack8(gelu4(acc[ai][1][m][0]), gelu4(acc[ai][1][m][1]));
                unsigned char* rp = uv + (row * 4096 + u.pn * 256 + 64 * wc + 8 * fq) * 2;
                *(u32x4*)rp = p0; *(u32x4*)(rp + 64) = p1;
                if (u.pn >= 8) {
                    float s = 0.f, q = 0.f;
#pragma unroll
                    for (int k = 0; k < 8; ++k) { const unsigned w = k < 4 ? p0[k] : p1[k - 4]; const float a = bflo(w), b = bfhi(w); s += a + b; q += a * a + b * b; }
                    s += __shfl_xor(s, 16); q += __shfl_xor(q, 16); s += __shfl_xor(s, 32); q += __shfl_xor(q, 32);
                    if (fq == 0) { float* sp = statp + (row * 32 + (u.pn - 8) * 4 + wc) * 2; sp[0] = s; sp[1] = q; }
                }
            }
    }
};
__device__ __forceinline__ void phase_inproj1_pg(const Params& p, LAS unsigned char* lds, int bid, int nblk) {
    unsigned char* ws = p.ws;
    pg::SchedPlain S{(const char*)(ws + OFF_HX), (const char*)(ws + W_BIN), D, D, 128, 16, 2048, nblk, bid};
    EpiIn1 E{ws + B_UV, (float*)(ws + OFF_STATP)};
    pg::gemm<false>(lds, D, D, D, S, E);
}

constexpr int MOE_T_SS = 131072, MOE_T_S0 = 131072 + 512, MOE_T_E = 131072 + 512 + 4864;
__device__ __forceinline__ int moe_meta(const Params& p, LAS unsigned char* lds) {
    LAS int* ss = (LAS int*)(lds + MOE_T_SS); LAS int* ts0 = (LAS int*)(lds + MOE_T_S0); LAS unsigned char* te = lds + MOE_T_E;
    const int* meta = (const int*)(p.ws + OFF_META);
    const int tid = opq_tid();
    if (tid < 66) ss[tid] = meta[tid];
    __syncthreads();
    const int ntile = ss[65] / TM;
    for (int t = tid; t < ntile; t += NTHR) {
        const int slot0 = t * TM; int e = 0;
        for (int q = 1; q < 65; ++q) e = (ss[q] <= slot0) ? q : e;
        ts0[t] = slot0; te[t] = (unsigned char)e;
    }
    __syncthreads();
    return ntile;
}
template <int NPN, bool GATHER>
struct SchedMoe {
    const char* A; const char* W; const int* tokof; const int* ident; LAS unsigned char* lds; int lda, wrows, wk, nunits, G, c;
    __device__ __forceinline__ bool next(int i, pg::Unit& u) const {
        const int L = i * G + c; if (L >= nunits) return false;
        const int wgid = pg::xcd_remap(L, nunits), tile = wgid / NPN;
        const int slot0 = __builtin_amdgcn_readfirstlane(((LAS int*)(lds + MOE_T_S0))[tile]);
        const int e = __builtin_amdgcn_readfirstlane((int)(lds + MOE_T_E)[tile]);
        const int ss64 = __builtin_amdgcn_readfirstlane(((LAS int*)(lds + MOE_T_SS))[64]);
        u.pm = slot0; u.pn = wgid % NPN; u.e = e;
        u.rows = e < 64 ? tokof + slot0 : ident + (slot0 - ss64);
        u.a = GATHER ? A : A + (size_t)slot0 * lda * 2;
        u.b = W + ((size_t)e * wrows + (size_t)u.pn * 256) * wk * 2;
        return true;
    }
};
__device__ __forceinline__ f32x4 silu4(f32x4 v) { return (f32x4){silu(v.x), silu(v.y), silu(v.z), silu(v.w)}; }
struct EpiUp {
    static constexpr int PERM = 1; unsigned char* hh; const float* wof; LAS unsigned char* stg;
    __device__ __forceinline__ void operator()(const f32x4 (&acc)[2][2][4][2], const pg::Unit& u, int wr, int wc, int fr, int fq) const {
        float w[8];
#pragma unroll
        for (int i = 0; i < 8; ++i) w[i] = u.e < 64 ? wof[u.pm + (i >> 2) * 128 + wr * 64 + (i & 3) * 16 + fr] : 1.0f;
#pragma unroll
        for (int ai = 0; ai < 2; ++ai)
#pragma unroll
            for (int m = 0; m < 4; ++m) {
                const float ww = w[ai * 4 + m];
                const u32x4 p0 = pack8(silu4(acc[ai][0][m][0]) * acc[ai][1][m][0] * ww, silu4(acc[ai][0][m][1]) * acc[ai][1][m][1] * ww);
                LAS unsigned char* sbuf = stg + ((ai * 4 + m) & 1) * 8704;
                *(LAS u32x4*)(sbuf + (wr * 16 + fr) * 272 + wc * 64 + fq * 16) = p0;
                stg_sync();
                { const int tid = (wr * 4 + wc) * 64 + fq * 16 + fr, rl = tid >> 4, c = tid & 15;
                  const u32x4 v = *(LAS u32x4*)(sbuf + rl * 272 + c * 16);
                  *(u32x4*)(hh + ((size_t)(u.pm + ai * 128 + (rl >> 4) * 64 + m * 16 + (rl & 15)) * EFF + u.pn * 128) * 2 + c * 16) = v; }
            }
    }
};
__device__ __forceinline__ void phase_moe_up(const Params& p, LAS unsigned char* lds, int bid, int nblk, int l) {
    unsigned char* ws = p.ws;
    const int ntile = moe_meta(p, lds);
    SchedMoe<2, true> S{(const char*)(ws + OFF_HX), (const char*)(ws + W_GU) + (size_t)l * 65 * 512 * 1024 * 2, (const int*)(ws + OFF_TOKOF), (const int*)(ws + OFF_IDENT), lds, D, 512, D, ntile * 2, nblk, bid};
    EpiUp E{ws + B_HH, (const float*)(ws + OFF_WOF), lds + STG_OFF};
    pg::gemm<true>(lds, D, D, D, S, E);
    if (l == 0 && bg_idle(ntile * 2, nblk, bid)) bg_convert(p, lds, 1, 3);
}
struct EpiDown {
    static constexpr int PERM = 1; LAS unsigned char* stg; unsigned char* Y; unsigned char* ys; int ss64;
    __device__ __forceinline__ void operator()(const f32x4 (&acc)[2][2][4][2], const pg::Unit& u, int wr, int wc, int fr, int fq) const {
        const int tid = (wr * 4 + wc) * 64 + fq * 16 + fr, rl = tid >> 4, c = tid & 15;
        unsigned char* base = u.e < 64 ? Y + ((size_t)u.pm * D + u.pn * 256) : ys + ((size_t)(u.pm - ss64) * D + u.pn * 256);
#pragma unroll
        for (int ai = 0; ai < 2; ++ai)
#pragma unroll
            for (int m = 0; m < 4; ++m) {
                LAS unsigned char* sbuf = stg + ((ai * 4 + m) & 1) * 8704;
                LAS unsigned char* w = sbuf + (wr * 16 + fr) * 272 + wc * 32 + fq * 8;
                *(LAS u32x2*)w = (u32x2){pk4_fp8(acc[ai][0][m][0]), pk4_fp8(acc[ai][0][m][1])};
                *(LAS u32x2*)(w + 128) = (u32x2){pk4_fp8(acc[ai][1][m][0]), pk4_fp8(acc[ai][1][m][1])};
                stg_sync();
                const u32x4 v = *(LAS u32x4*)(sbuf + rl * 272 + c * 16);
                *(u32x4*)(base + (size_t)(ai * 128 + (rl >> 4) * 64 + m * 16 + (rl & 15)) * D + c * 16) = v;
            }
    }
};
__device__ __forceinline__ void phase_moe_down(const Params& p, LAS unsigned char* lds, int bid, int nblk, int l) {
    unsigned char* ws = p.ws;
    const int ntile = moe_meta(p, lds);
    const int ss64 = ((LAS int*)(lds + MOE_T_SS))[64];
    SchedMoe<4, false> S{(const char*)(ws + B_HH), (const char*)(ws + W_DN) + (size_t)l * 65 * 1024 * 256 * 2, nullptr, nullptr, lds, EFF, 1024, EFF, ntile * 4, nblk, bid};
    EpiDown E{lds + STG_OFF, ws + B_YY, ws + B_YS, ss64};
    pg::gemm<false>(lds, EFF, EFF, EFF, S, E);
    if (l == 0 && bg_idle(ntile * 4, nblk, bid)) bg_convert(p, lds, 1, 1);
}

typedef _Float16 h16x2 __attribute__((ext_vector_type(2)));
__device__ __forceinline__ unsigned pkh2(float a, float b) { h16x2 v; v.x = (_Float16)a; v.y = (_Float16)b; return __builtin_bit_cast(unsigned, v); }
__device__ __forceinline__ float h2lo(unsigned w) { return (float)__builtin_bit_cast(h16x2, w).x; }
__device__ __forceinline__ float h2hi(unsigned w) { return (float)__builtin_bit_cast(h16x2, w).y; }
template <int CTRL> __device__ __forceinline__ float dppf(float oldv, float v) {
    return __builtin_bit_cast(float, __builtin_amdgcn_update_dpp(__builtin_bit_cast(int, oldv), __builtin_bit_cast(int, v), CTRL, 0xf, 0xf, false));
}
template <bool SHL> __device__ __forceinline__ void scan16(float& A, float& H) {
#define SC_STEP(N) { const float Ap = dppf<(SHL ? 0x100 : 0x110) + N>(1.0f, A); const float Hp = dppf<(SHL ? 0x100 : 0x110) + N>(0.0f, H); H = A * Hp + H; A = A * Ap; }
    SC_STEP(1) SC_STEP(2) SC_STEP(4) SC_STEP(8)
#undef SC_STEP
}
struct SchedGates {
    const char* U; const char* W; int G, c;
    __device__ __forceinline__ bool next(int i, pg::Unit& u) const {
        const int L = i * G + c; if (L >= 2640) return false;
        const int wgid = pg::xcd_remap(L, 2640), pm = wgid / 20, rem = wgid % 20, h = rem >> 2, q = rem & 3;
        u.pm = pm; u.pn = q; u.e = h; u.rows = nullptr;
        u.a = U + ((size_t)pm * 256 * RW + h * 256) * 2; u.b = W + ((size_t)h * 1024 + q * 256) * 256 * 2; return true;
    }
};
struct EpiGates {
    static constexpr int PERM = 0;
    const bf16_t* uu; const float* rbias; const float* ibias; const float* cdec; unsigned char* ab; LAS unsigned char* stg;
    __device__ __forceinline__ void operator()(const f32x4 (&acc)[2][2][4][2], const pg::Unit& u, int wr, int wc, int fr, int fq) const {
        const int ch0 = u.e * 256 + u.pn * 64 + 16 * wc + 4 * fq;
        const f32x4 rb0 = *(const f32x4*)(rbias + ch0), rb1 = *(const f32x4*)(rbias + RW + ch0), ib0 = *(const f32x4*)(ibias + ch0), ib1 = *(const f32x4*)(ibias + RW + ch0);
        const f32x4 cd0 = *(const f32x4*)(cdec + ch0), cd1 = *(const f32x4*)(cdec + RW + ch0);
        u32x2 uws[8];
#pragma unroll
        for (int i = 0; i < 8; ++i) uws[i] = *(const u32x2*)(uu + ((size_t)u.pm * 256 + (i >> 2) * 128 + wr * 64 + (i & 3) * 16 + fr) * RW + ch0);
#pragma unroll
        for (int ai = 0; ai < 2; ++ai)
#pragma unroll
            for (int m = 0; m < 4; ++m) {
                const int rl = ai * 128 + wr * 64 + m * 16 + fr; const size_t R = (size_t)u.pm * 256 + rl;
                const u32x2 uw = uws[ai * 4 + m];
                const float uv[4] = {bflo(uw.x), bfhi(uw.x), bflo(uw.y), bfhi(uw.y)};
                unsigned o[8];
#pragma unroll
                for (int gi = 0; gi < 4; ++gi) {
                    const f32x4 v = acc[ai][gi >> 1][m][gi & 1];
                    const float r0 = sigm(v.x + rb0[gi]), i0 = sigm(v.y + ib0[gi]), r1 = sigm(v.z + rb1[gi]), i1 = sigm(v.w + ib1[gi]);
                    const float la0 = r0 * cd0[gi], la1 = r1 * cd1[gi];
                    float a0 = __expf(la0), a1 = __expf(la1);
                    float m0 = __builtin_amdgcn_sqrtf(fmaxf(1.0f - a0 * a0, 0.0f)), m1 = __builtin_amdgcn_sqrtf(fmaxf(1.0f - a1 * a1, 0.0f));
                    if (u.pm >= 128) { if (rl == 0) m0 = 1.0f; if (rl == CTXL - 1) m1 = 1.0f; }
                    float h0 = m0 * i0 * uv[gi], h1 = m1 * i1 * uv[gi];
#define GS_STEP(N) asm volatile("s_nop 1\n\tv_fmac_f32_dpp %0, %0, %2 row_shr:" #N " row_mask:0xf bank_mask:0xf\n\tv_fmac_f32_dpp %1, %1, %3 row_shl:" #N " row_mask:0xf bank_mask:0xf\n\tv_mul_f32_dpp %2, %2, %2 row_shr:" #N " row_mask:0xf bank_mask:0xf\n\tv_mul_f32_dpp %3, %3, %3 row_shl:" #N " row_mask:0xf bank_mask:0xf" : "+v"(h0), "+v"(h1), "+v"(a0), "+v"(a1));
                    GS_STEP(1) GS_STEP(2) GS_STEP(4) GS_STEP(8)
#undef GS_STEP
                    o[gi * 2] = pkh2(a0, h0); o[gi * 2 + 1] = pkh2(a1, h1);
                }
                u32x4* dst = (u32x4*)(ab + (R * RW + ch0) * 8);
                dst[0] = (u32x4){o[0], o[1], o[2], o[3]}; dst[1] = (u32x4){o[4], o[5], o[6], o[7]};
            }
    }
};
__device__ __forceinline__ void phase_gates_pg(const Params& p, LAS unsigned char* lds, int bid, int nblk) {
    unsigned char* ws = p.ws;
    SchedGates S{(const char*)(ws + B_UU), (const char*)(ws + W_GATE), nblk, bid};
    EpiGates E{(const bf16_t*)(ws + B_UU), p.in[12], p.in[14], (const float*)(ws + OFF_CDEC), ws + B_AB, lds + STG_OFF};
    pg::gemm<false>(lds, 256, RW, 256, S, E);
    if (bg_idle(2640, nblk, bid)) bg_convert(p, lds, 0, 2);
}
__device__ __forceinline__ void phase_scan_sb(const Params& p, int bid, int nblk) {
    unsigned char* ws = p.ws;
    const unsigned* ab = (const unsigned*)(ws + B_AB); float* sbc = (float*)(ws + OFF_AGG);
    const int gt = bid * NTHR + opq_tid(), ngt = nblk * NTHR;
    for (int i = gt; i < 2 * 132 * RW; i += ngt) {
        const int d = i / (132 * RW), sb = (i / RW) % 132, ch = i % RW;
        float A = 1.0f, H = 0.0f;
#pragma unroll 16
        for (int j = 0; j < 16; ++j) {
            const int k = d == 0 ? j : 15 - j; const size_t row = (size_t)sb * 256 + 16 * k + (d == 0 ? 15 : 0);
            const unsigned w = ab[(row * RW + ch) * 2 + d];
            H = h2lo(w) * H + h2hi(w); A *= h2lo(w);
        }
        sbc[(size_t)i * 2] = A; sbc[(size_t)i * 2 + 1] = H;
    }
}
__device__ __forceinline__ void phase_scan_carry(const Params& p, int bid, int nblk) {
    unsigned char* ws = p.ws;
    const unsigned* ab = (const unsigned*)(ws + B_AB); const float* sbc = (const float*)(ws + OFF_AGG); float* car = (float*)(ws + B_CAR);
    const int gt = bid * NTHR + opq_tid(), ngt = nblk * NTHR;
    for (int i = gt; i < 2 * 128 * RW; i += ngt) {
        const int d = i / (128 * RW), sb = (i / RW) % 128, ch = i % RW, b = sb >> 5, sl = sb & 31;
        float c = sbc[((size_t)(d * 132 + 128 + b) * RW + ch) * 2 + 1];
        const int nprev = d == 0 ? sl : 31 - sl;
        for (int j = 0; j < nprev; ++j) {
            const int s2 = d == 0 ? b * 32 + j : b * 32 + 31 - j;
            const float* q = sbc + ((size_t)(d * 132 + s2) * RW + ch) * 2;
            c = q[0] * c + q[1];
        }
#pragma unroll 16
        for (int j = 0; j < 16; ++j) {
            const int k = d == 0 ? j : 15 - j; const size_t row = (size_t)sb * 256 + 16 * k + (d == 0 ? 15 : 0);
            car[((size_t)d * 2048 + sb * 16 + k) * RW + ch] = c;
            const unsigned w = ab[(row * RW + ch) * 2 + d];
            c = h2lo(w) * c + h2hi(w);
        }
    }
}
__device__ __forceinline__ void phase_scan_apply(const Params& p, int bid, int nblk) {
    unsigned char* ws = p.ws;
    const unsigned char* ab = ws + B_AB; const float* car = (const float*)(ws + B_CAR); const bf16_t* gate0 = (const bf16_t*)(ws + B_GATE0); bf16_t* z0 = (bf16_t*)(ws + B_Z0);
    const int gt = bid * NTHR + opq_tid(), ngt = nblk * NTHR;
    for (int item = gt; item < 2048 * 320; item += ngt) {
        const int blk = item / 320, c4 = (item % 320) * 4;
        const f32x4 cf = *(const f32x4*)(car + (size_t)blk * RW + c4), cb = *(const f32x4*)(car + ((size_t)2048 + blk) * RW + c4);
#pragma unroll 8
        for (int r = 0; r < 16; ++r) {
            const size_t e = ((size_t)blk * 16 + r) * RW + c4;
            const u32x4 w0 = *(const u32x4*)(ab + e * 8), w1 = *(const u32x4*)(ab + e * 8 + 16);
            const u32x2 g = *(const u32x2*)(gate0 + e);
            const float y0 = (h2hi(w0.x) + h2lo(w0.x) * cf.x) + (h2hi(w0.y) + h2lo(w0.y) * cb.x);
            const float y1 = (h2hi(w0.z) + h2lo(w0.z) * cf.y) + (h2hi(w0.w) + h2lo(w0.w) * cb.y);
            const float y2 = (h2hi(w1.x) + h2lo(w1.x) * cf.z) + (h2hi(w1.y) + h2lo(w1.y) * cb.z);
            const float y3 = (h2hi(w1.z) + h2lo(w1.z) * cf.w) + (h2hi(w1.w) + h2lo(w1.w) * cb.w);
            u32x2 o; o.x = pk2(bflo(g.x) * y0, bfhi(g.x) * y1); o.y = pk2(bflo(g.y) * y2, bfhi(g.y) * y3);
            *(u32x2*)(z0 + e) = o;
        }
    }
}

#define XB_TMO      128
#define XB_XCNT(j)  (256  + 64 * (j))
#define XB_XSUB(j)  (1280 + 64 * (j))
#define XB_XGEN(j)  (2304 + 64 * (j))
#define XB_TOP      3328
#define XB_TOPGEN   3392
#define XCD_BAR_WORDS 3456
#define XB_SPIN_CAP (1u << 18)
__device__ __forceinline__ unsigned xb_ld(unsigned* p)              { return __hip_atomic_load(p, __ATOMIC_RELAXED, __HIP_MEMORY_SCOPE_AGENT); }
__device__ __forceinline__ unsigned xb_add(unsigned* p, unsigned v) { return __hip_atomic_fetch_add(p, v, __ATOMIC_RELAXED, __HIP_MEMORY_SCOPE_AGENT); }
__device__ __forceinline__ unsigned xb_xcc_id() { return (unsigned)__builtin_amdgcn_s_getreg((3 << 11) | 20) & 0xFu; }
#define XB_SPIN(cond, bar) do { unsigned _sp = 0; while (cond) { __builtin_amdgcn_s_sleep(1); \
    if ((++_sp & 255u) == 0u) { if (xb_ld(&(bar)[XB_TMO])) break; if (_sp > XB_SPIN_CAP) { atomicAdd(&(bar)[XB_TMO], 1u); break; } } } } while (0)
struct XcdBarrier { unsigned* bar; unsigned x; volatile LAS unsigned* st; };
__device__ __forceinline__ XcdBarrier xcd_barrier_post(unsigned* bar, volatile LAS unsigned* st) {
    XcdBarrier b; b.bar = bar; b.x = xb_xcc_id(); b.st = st;
    if (threadIdx.x == 0) (void)xb_add(&bar[XB_XCNT(b.x)], 1u);
    return b;
}
__device__ __forceinline__ void xcd_barrier_complete(unsigned* bar, unsigned x, unsigned& nloc, unsigned& nx) {
    const unsigned G = gridDim.x * gridDim.y * gridDim.z;
    unsigned sum, cnt, mine, sp = 0u;
    for (;;) {
        sum = 0u; cnt = 0u; mine = 0u;
#pragma unroll
        for (unsigned j = 0; j < 16; ++j) { const unsigned c = xb_ld(&bar[XB_XCNT(j)]); sum += c; cnt += (c > 0u) ? 1u : 0u; mine = (j == x) ? c : mine; }
        if (sum == G) break;
        __builtin_amdgcn_s_sleep(1);
        if ((++sp & 255u) == 0u) { if (xb_ld(&bar[XB_TMO])) break; if (sp > XB_SPIN_CAP) { atomicAdd(&bar[XB_TMO], 1u); break; } }
    }
    nloc = mine > 0u ? mine : 1u; nx = cnt > 0u ? cnt : 1u;
}
__device__ __forceinline__ void xcd_barrier(const XcdBarrier& b) {
    asm volatile("s_waitcnt vmcnt(0)" ::: "memory");
    __syncthreads();
    if (threadIdx.x == 0) {
        unsigned* bar = b.bar;
        __builtin_amdgcn_s_waitcnt(0);
        unsigned nloc = b.st[0], nx = b.st[1];
        if (nloc == 0u) { xcd_barrier_complete(bar, b.x, nloc, nx); b.st[0] = nloc; b.st[1] = nx; }
        const unsigned old = xb_add(&bar[XB_XSUB(b.x)], 1u);
        const unsigned gen = old / nloc;
        if (old + 1u == (gen + 1u) * nloc) {
            __builtin_amdgcn_fence(__ATOMIC_RELEASE, "agent");
            asm volatile("s_waitcnt vmcnt(0)" ::: "memory");
            const unsigned og = xb_add(&bar[XB_TOP], 1u);
            const unsigned tg = og / nx;
            if (og + 1u == (tg + 1u) * nx) xb_add(&bar[XB_TOPGEN], 1u);
            else XB_SPIN(xb_ld(&bar[XB_TOPGEN]) == tg, bar);
            __builtin_amdgcn_fence(__ATOMIC_ACQUIRE, "agent");
            xb_add(&bar[XB_XGEN(b.x)], 1u);
            asm volatile("s_waitcnt vmcnt(0)" ::: "memory");
        } else {
            XB_SPIN(xb_ld(&bar[XB_XGEN(b.x)]) == gen, bar);
            __builtin_amdgcn_fence(__ATOMIC_ACQUIRE, "agent");
            asm volatile("s_waitcnt vmcnt(0)" ::: "memory");
        }
    }
    __syncthreads();
}

#ifndef PROBE_G
#define PROBE_G 0
#endif
#define PH(g, call) do { unsigned long long _t0 = 0; if (PROBE_G == (g)) _t0 = __builtin_amdgcn_s_memrealtime(); call; xcd_barrier(xb); if (PROBE_G == (g)) tacc += __builtin_amdgcn_s_memrealtime() - _t0; } while (0)
__global__ void __launch_bounds__(NTHR) mk_fwd(Params p) {
    extern __shared__ __attribute__((aligned(16))) unsigned char lds_raw[];
    LAS unsigned char* lds = (LAS unsigned char*)lds_raw;
    cg::grid_group grid = cg::this_grid();
    const int bid = blockIdx.x, nblk = gridDim.x;
    unsigned char* ws = p.ws;
    const float* mod0 = (const float*)(ws + OFF_MOD); const float* mod1 = mod0 + 5 * 6144;
    unsigned long long tacc = 0;
    { volatile LAS unsigned* st0 = (volatile LAS unsigned*)(lds + LDS_BYTES - 16); if (threadIdx.x < 4) st0[threadIdx.x] = 0u; }
    __syncthreads();
    XcdBarrier xb = xcd_barrier_post((unsigned*)ws, (volatile LAS unsigned*)(lds + LDS_BYTES - 16));
    { unsigned long long _t0 = 0; if (PROBE_G == 1) _t0 = __builtin_amdgcn_s_memrealtime();
      phase0(p, lds, bid, nblk);
      grid.sync();
      if (PROBE_G == 1) tacc += __builtin_amdgcn_s_memrealtime() - _t0; }
    PH(2, (row_phase<0, false, false>(p, bid, nblk, p.in[6], mod0, 0, 1024, nullptr, nullptr)));
    PH(6, phase_inproj0_pg(p, lds, bid, nblk));
    PH(12, phase_conv(p, bid, nblk));
    PH(7, phase_gates_pg(p, lds, bid, nblk));
    PH(3, phase_scan_sb(p, bid, nblk));
    PH(3, phase_scan_carry(p, bid, nblk));
    PH(13, phase_scan_apply(p, bid, nblk));
    PH(6, phase_outproj_pg(p, lds, bid, nblk, (const bf16_t*)(ws + B_Z0), RW, (const bf16_t*)(ws + W_AOUT), mod0, ws + B_DX0));
    PH(4, phase_normroute(p, lds, bid, nblk, 0, p.in[7], mod0, (const bf16_t*)(ws + B_DX0)));
    PH(10, phase_scatter(p, lds, bid, nblk, 0));
    PH(8, phase_moe_up(p, lds, bid, nblk, 0));
    PH(9, phase_moe_down(p, lds, bid, nblk, 0));
    PH(2, (row_phase<2, false, false>(p, bid, nblk, p.in[6] + D, mod1, 0, 1024, mod0, nullptr)));
    PH(6, phase_inproj1_pg(p, lds, bid, nblk));
    PH(11, phase_sgu(p, lds, bid, nblk));
    PH(6, phase_outproj_pg(p, lds, bid, nblk, (const bf16_t*)(ws + B_Z1), SW, (const bf16_t*)(ws + W_BOUT), mod1, ws + B_DX1));
    PH(4, phase_normroute(p, lds, bid, nblk, 1, p.in[7] + D, mod1, (const bf16_t*)(ws + B_DX1)));
    PH(10, phase_scatter(p, lds, bid, nblk, 1));
    PH(8, phase_moe_up(p, lds, bid, nblk, 1));
    PH(9, phase_moe_down(p, lds, bid, nblk, 1));
    { unsigned long long _t0 = 0; if (PROBE_G == 2) _t0 = __builtin_amdgcn_s_memrealtime();
      row_phase<2, false, true>(p, bid, nblk, p.in[29], mod1, 0, 0, mod1, nullptr);
      if (PROBE_G == 2) tacc += __builtin_amdgcn_s_memrealtime() - _t0; }
    if (PROBE_G != 0 && bid == 0 && threadIdx.x == 0) {
        const unsigned long long t0 = __builtin_amdgcn_s_memrealtime();
        while (__builtin_amdgcn_s_memrealtime() - t0 < 3ull * tacc) __builtin_amdgcn_s_sleep(20);
    }
}

extern "C" void kernel_launch(void* const* d_in, const int* in_sizes, int n_in, void* d_out, int out_size, void* d_ws, size_t ws_size, hipStream_t stream) {
    static int grid_blocks = 0;
    if (grid_blocks == 0) {
        if (n_in != 30 || out_size != NTOK * D || ws_size < WS_NEED) { fprintf(stderr, "kernel_launch: unexpected shapes (n_in %d out %d ws %zu need %zu)\n", n_in, out_size, ws_size, (size_t)WS_NEED); grid_blocks = -1; return; }
        int dev = 0, cus = 0, per_cu = 0;
        (void)hipGetDevice(&dev);
        (void)hipDeviceGetAttribute(&cus, hipDeviceAttributeMultiprocessorCount, dev);
        if (hipFuncSetAttribute((const void*)mk_fwd, hipFuncAttributeMaxDynamicSharedMemorySize, LDS_BYTES) != hipSuccess) { fprintf(stderr, "kernel_launch: hipFuncSetAttribute failed\n"); grid_blocks = -1; return; }
        (void)hipOccupancyMaxActiveBlocksPerMultiprocessor(&per_cu, mk_fwd, NTHR, LDS_BYTES);
        if (per_cu < 1) per_cu = 1;
        if (per_cu > 2) per_cu = 2;
        grid_blocks = cus * per_cu;
        fprintf(stderr, "kernel_launch: cus %d per_cu %d grid %d\n", cus, per_cu, grid_blocks);
    }
    if (grid_blocks < 0) return;
    if (hipMemsetAsync(d_ws, 0, 65536, stream) != hipSuccess) { fprintf(stderr, "kernel_launch: memset failed\n"); return; }
    Params p{};
    for (int i = 0; i < 30; ++i) p.in[i] = (const float*)d_in[i];
    p.out = (float*)d_out; p.ws = (unsigned char*)d_ws;
    void* args[] = {&p};
    hipError_t e = hipLaunchCooperativeKernel((void*)mk_fwd, dim3(grid_blocks), dim3(NTHR), args, LDS_BYTES, stream);
    if (e != hipSuccess) fprintf(stderr, "cooperative launch failed: %s (grid %d)\n", hipGetErrorString(e), grid_blocks);
}
```

```cpp
#include <hip/hip_runtime.h>
#include <hip/hip_cooperative_groups.h>
#include <cstdio>
#include <cstdint>
namespace cg = cooperative_groups;

#define LAS __attribute__((address_space(3)))
typedef unsigned short bf16_t;
typedef short bf16x8 __attribute__((ext_vector_type(8)));
typedef float f32x4 __attribute__((ext_vector_type(4)));
typedef unsigned u32x4 __attribute__((ext_vector_type(4)));
typedef unsigned u32x2 __attribute__((ext_vector_type(2)));

constexpr int D = 1024, NB = 4, SEQ = 8192, NTOK = NB * SEQ, CTXL = 256, NCTX = NB * CTXL, NROW = NTOK + NCTX;
constexpr int RW = 1280;
constexpr int SW = 2048;
constexpr int NE = 64, TOPK = 8, EFF = 256;
constexpr int TM = 256;
constexpr int NSLOT = 278528;
constexpr int NTHR = 512;
constexpr int STG_OFF = 139264;
constexpr int LDS_BYTES = 157248;

constexpr size_t MiB = (size_t)1 << 20;
constexpr size_t OFF_MOD = 1 * MiB;
constexpr size_t OFF_POS = OFF_MOD + 262144;
constexpr size_t OFF_CDEC = OFF_POS + 262144;
constexpr size_t OFF_CNT = OFF_CDEC + 16384;
constexpr size_t OFF_META = OFF_CNT + 65536;
constexpr size_t OFF_IDENT = OFF_META + 4096 + 45056;
constexpr size_t OFF_AGG = 2 * MiB;
constexpr size_t OFF_CARRY = 8 * MiB;
constexpr size_t OFF_EIDX = 11 * MiB;
constexpr size_t OFF_GATEW = 12 * MiB;
constexpr size_t OFF_SLOTOF = 13 * MiB;
constexpr size_t OFF_TOKOF = 14 * MiB;
constexpr size_t OFF_WOF = 16 * MiB;
constexpr size_t OFF_CNTW2 = 17 * MiB + 512 * 1024;
constexpr size_t OFF_W = 18 * MiB;
constexpr size_t W_AIN = OFF_W;
constexpr size_t W_AOUT = W_AIN + (size_t)2560 * 1024 * 2;
constexpr size_t W_GATE = W_AOUT + (size_t)1024 * 1280 * 2;
constexpr size_t W_BIN = W_GATE + (size_t)5 * 1024 * 256 * 2;
constexpr size_t W_BOUT = W_BIN + (size_t)4096 * 1024 * 2;
constexpr size_t W_S = W_BOUT + (size_t)1024 * 2048 * 2;
constexpr size_t W_RT = W_S + (size_t)8 * 128 * 128 * 2;
constexpr size_t W_GU = W_RT + (size_t)2 * 128 * 3072 * 2;
constexpr size_t W_DN = W_GU + (size_t)2 * 65 * 512 * 1024 * 2;
constexpr size_t W_END = W_DN + (size_t)2 * 65 * 1024 * 256 * 2;
constexpr size_t OFF_HX = 237 * MiB;
constexpr size_t OFF_BIG = OFF_HX + 66 * MiB;
constexpr size_t OFF_STATP = OFF_BIG + 320 * MiB;
constexpr size_t B_GATE0 = OFF_BIG;
constexpr size_t B_UPRE = OFF_BIG + 80 * MiB;
constexpr size_t B_UU = OFF_BIG + 163 * MiB;
constexpr size_t B_Z0 = OFF_BIG + 246 * MiB;
constexpr size_t B_AB = OFF_BIG + 326 * MiB;
constexpr size_t B_CAR = OFF_BIG + 80 * MiB;
constexpr size_t B_DX0 = OFF_BIG + 326 * MiB;
constexpr size_t B_DX1 = OFF_BIG + 256 * MiB;
constexpr size_t B_UV = OFF_BIG;
constexpr size_t B_VNT = OFF_BIG + 256 * MiB;
constexpr size_t B_Z1 = OFF_BIG + 384 * MiB;
constexpr size_t B_HLO = OFF_BIG;
constexpr size_t B_HH = OFF_BIG;
constexpr size_t B_YY = OFF_BIG + 160 * MiB;
constexpr size_t B_YS = OFF_BIG + 448 * MiB;
constexpr size_t B_XR = OFF_BIG + 656 * MiB;
constexpr size_t WS_NEED = OFF_BIG + 720 * MiB;
static_assert(W_END <= OFF_HX, "weights overflow");
static_assert((size_t)(NSLOT + NTOK) * 256 * 2 <= 160 * MiB, "H overflow");
static_assert((size_t)NSLOT * 1024 * 2 <= 544 * MiB, "Y overflow");
static_assert(WS_NEED <= 1024 * MiB, "ws overflow");
constexpr long LO_DELTA = (long)((B_HLO - OFF_HX) / 2);

__device__ __forceinline__ unsigned f2bf(float f) { unsigned u = __builtin_bit_cast(unsigned, f); return (u + 0x7fffu + ((u >> 16) & 1u)) >> 16; }
__device__ __forceinline__ unsigned pk2(float lo, float hi) { unsigned r; asm volatile("v_cvt_pk_bf16_f32 %0, %1, %2" : "=v"(r) : "v"(lo), "v"(hi)); return r; }
__device__ __forceinline__ float bf2f(unsigned b) { return __builtin_bit_cast(float, b << 16); }
__device__ __forceinline__ float bflo(unsigned w) { return __builtin_bit_cast(float, w << 16); }
__device__ __forceinline__ float bfhi(unsigned w) { return __builtin_bit_cast(float, w & 0xffff0000u); }
__device__ __forceinline__ float sigm(float x) { return __builtin_amdgcn_rcpf(1.0f + __expf(-x)); }
__device__ __forceinline__ float silu(float x) { return x * __builtin_amdgcn_rcpf(1.0f + __expf(-x)); }
__device__ __forceinline__ float gelu_t(float x) { const float y = 1.5957691216057308f * (x + 0.044715f * x * x * x); return x * __builtin_amdgcn_rcpf(1.0f + __expf(-y)); }
template <int CTRL> __device__ __forceinline__ float dpp_mv(float v) { return __builtin_bit_cast(float, __builtin_amdgcn_update_dpp(__builtin_bit_cast(int, v), __builtin_bit_cast(int, v), CTRL, 0xf, 0xf, false)); }
template <int CTRL> __device__ __forceinline__ int dpp_mvi(int v) { return __builtin_amdgcn_update_dpp(v, v, CTRL, 0xf, 0xf, false); }
__device__ __forceinline__ float wave_sum(float v) {
    v += dpp_mv<0xB1>(v); v += dpp_mv<0x4E>(v); v += dpp_mv<0x141>(v); v += dpp_mv<0x140>(v);
    const int b = __builtin_bit_cast(int, v);
    return (__builtin_bit_cast(float, __builtin_amdgcn_readlane(b, 0)) + __builtin_bit_cast(float, __builtin_amdgcn_readlane(b, 16)))
         + (__builtin_bit_cast(float, __builtin_amdgcn_readlane(b, 32)) + __builtin_bit_cast(float, __builtin_amdgcn_readlane(b, 48)));
}
__device__ __forceinline__ float max8(float v) { v = fmaxf(v, dpp_mv<0xB1>(v)); v = fmaxf(v, dpp_mv<0x4E>(v)); return fmaxf(v, dpp_mv<0x141>(v)); }
__device__ __forceinline__ int min8(int v) { v = min(v, dpp_mvi<0xB1>(v)); v = min(v, dpp_mvi<0x4E>(v)); return min(v, dpp_mvi<0x141>(v)); }

__device__ __forceinline__ int opq_tid() { int t = threadIdx.x; asm volatile("" : "+v"(t)); return t; }
__device__ __forceinline__ u32x4 pack8(f32x4 a, f32x4 b) { u32x4 w; w.x = pk2(a.x, a.y); w.y = pk2(a.z, a.w); w.z = pk2(b.x, b.y); w.w = pk2(b.z, b.w); return w; }
__device__ __forceinline__ unsigned pk4_fp8(f32x4 v) { int w = 0; w = __builtin_amdgcn_cvt_pk_fp8_f32(v.x, v.y, w, false); w = __builtin_amdgcn_cvt_pk_fp8_f32(v.z, v.w, w, true); return (unsigned)w; }
__device__ __forceinline__ f32x4 up4_fp8(unsigned w) { return (f32x4){__builtin_amdgcn_cvt_f32_fp8((int)w, 0), __builtin_amdgcn_cvt_f32_fp8((int)w, 1), __builtin_amdgcn_cvt_f32_fp8((int)w, 2), __builtin_amdgcn_cvt_f32_fp8((int)w, 3)}; }
struct Params { const float* in[30]; float* out; unsigned char* ws; };

struct KDef { __device__ __forceinline__ long operator()(int kt) const { return (long)kt * 32; } };

template <class KOffA, class Epi>
__device__ __forceinline__ void gemm_tile(const bf16_t* arow, const bf16_t* brow, int nk, KOffA koffa, Epi epi, LAS unsigned char* lds) {
    const int tid = opq_tid(), lane = tid & 63, wid = tid >> 6, wr = wid >> 2, wc = wid & 3, fr = lane & 15, fq = lane >> 4;
    const int sw = (tid >> 2) * 80 + (tid & 3) * 16;
    f32x4 acc[4][2];
#pragma unroll
    for (int m = 0; m < 4; ++m)
#pragma unroll
        for (int n = 0; n < 2; ++n) acc[m][n] = (f32x4){0.f, 0.f, 0.f, 0.f};
    u32x4 ra = *(const u32x4*)(arow + koffa(0));
    u32x4 rb = *(const u32x4*)(brow);
    const int aoff = (wr * 64 + fr) * 80 + fq * 16, boff = 10240 + (wc * 32 + fr) * 80 + fq * 16;
    for (int kt = 0; kt < nk; ++kt) {
        LAS unsigned char* buf = lds + (kt & 1) * 20480;
        *(LAS u32x4*)(buf + sw) = ra;
        *(LAS u32x4*)(buf + 10240 + sw) = rb;
        __syncthreads();
        if (kt + 1 < nk) { ra = *(const u32x4*)(arow + koffa(kt + 1)); rb = *(const u32x4*)(brow + (long)(kt + 1) * 32); }
        bf16x8 af[4], bfv[2];
#pragma unroll
        for (int m = 0; m < 4; ++m) af[m] = *(LAS bf16x8*)(buf + aoff + m * 1280);
#pragma unroll
        for (int n = 0; n < 2; ++n) bfv[n] = *(LAS bf16x8*)(buf + boff + n * 1280);
#pragma unroll
        for (int m = 0; m < 4; ++m)
#pragma unroll
            for (int n = 0; n < 2; ++n) acc[m][n] = __builtin_amdgcn_mfma_f32_16x16x32_bf16(bfv[n], af[m], acc[m][n], 0, 0, 0);
    }
    __syncthreads();
#pragma unroll
    for (int m = 0; m < 4; ++m)
#pragma unroll
        for (int n = 0; n < 2; ++n) epi(wr * 64 + m * 16 + fr, wc * 32 + n * 16 + fq * 4, acc[m][n]);
}

namespace pg {
constexpr int BM = 256, BK = 64, HALF = 128, HTB = HALF * BK * 2, STAGE_BYTES = 8 * HTB;
__device__ __forceinline__ int lds_byte(int r, int c) { const int st = (r >> 4) * 2 + (c >> 5), rr = r & 15, cc = c & 31, ob = rr * 64 + cc * 2; return st * 1024 + (ob ^ (((ob >> 9) & 1) << 5)); }
__device__ __forceinline__ void stage_rc(int b, int& R, int& C) { const int st = b / 1024, sb = b % 1024, swz = sb ^ (((sb >> 9) & 1) << 5); R = (st >> 1) * 16 + swz / 64; C = (st & 1) * 32 + (swz % 64) / 2; }
__device__ __forceinline__ int perm32(int rho) { const int n = rho >> 4, i = rho & 15; return 8 * (i >> 2) + 4 * n + (i & 3); }
__device__ __forceinline__ int xcd_remap(int L, int nwg) { const int q = nwg / 8, r = nwg % 8, xcd = L % 8, off = L / 8; return (xcd < r ? xcd * (q + 1) : r * (q + 1) + (xcd - r) * q) + off; }

struct Unit { const char* a; const char* b; const int* rows; int pm, pn, e; };

template <bool GATHER, class Sched, class Epi>
__device__ __forceinline__ void gemm(LAS unsigned char* lds, const int K, const int lda, const int ldb, const Sched& S, const Epi& E) {
    const int tid = opq_tid(), wid = __builtin_amdgcn_readfirstlane(tid >> 6), lane = tid & 63, wr = wid >> 2, wc = wid & 3, fr = lane & 15, fq = lane >> 4;
    const int nt = K / BK;
    int RA[2]; unsigned ca2[2], voffB[2][2];
#pragma unroll
    for (int i = 0; i < 2; ++i) { int R, C; stage_rc(tid * 16 + i * 8192, R, C);
        RA[i] = R; ca2[i] = (unsigned)C * 2u;
#pragma unroll
        for (int h = 0; h < 2; ++h) {
            const int Rb = (int)Epi::PERM == 2 ? 64 * (R >> 5) + 32 * h + perm32(R & 31) : HALF * h + ((int)Epi::PERM == 1 ? ((R & ~31) + perm32(R & 31)) : R);
            voffB[h][i] = (unsigned)(Rb * ldb + C) * 2u; } }
    const unsigned lda2 = (unsigned)lda * 2u;
    const size_t kstep = (size_t)(BK * 2);
    const unsigned ldsw = (unsigned)wid * 1024u;
    const int aoff = lds_byte(wr * 64 + fr, fq * 8), boff = lds_byte(wc * 32 + fr, fq * 8);
    unsigned vc[2][2], vn[2][2];
#define PG_SA(b, h) (((b) * 2 + (h)) * HTB)
#define PG_SB(b, h) ((4 + (b) * 2 + (h)) * HTB)
#define PG_GL(bufoff, gp0, gp1) do { \
        __builtin_amdgcn_global_load_lds((const unsigned*)(gp0), (LAS unsigned*)(lds + (bufoff) + ldsw), 16, 0, 0); \
        __builtin_amdgcn_global_load_lds((const unsigned*)(gp1), (LAS unsigned*)(lds + (bufoff) + ldsw + 8192), 16, 0, 0); } while (0)
#define PG_STB(bufoff, gbase, h) PG_GL(bufoff, (const char*)(gbase) + voffB[h][0], (const char*)(gbase) + voffB[h][1])
#define PG_STA(bufoff, gbase, V, h) PG_GL(bufoff, (const char*)(gbase) + V[h][0], (const char*)(gbase) + V[h][1])
#define PG_LDA(dst, b, h) do { _Pragma("unroll") for (int m = 0; m < 4; ++m) _Pragma("unroll") for (int k = 0; k < 2; ++k) dst[m][k] = *(const LAS bf16x8*)(lds + PG_SA(b, h) + aoff + m * 2048 + k * 1024); } while (0)
#define PG_LDB(dst, b, h) do { _Pragma("unroll") for (int n = 0; n < 2; ++n) _Pragma("unroll") for (int k = 0; k < 2; ++k) dst[n][k] = *(const LAS bf16x8*)(lds + PG_SB(b, h) + boff + n * 2048 + k * 1024); } while (0)
#define PG_MMA(ai, bj, At, Bt) do { __builtin_amdgcn_s_setprio(1); _Pragma("unroll") for (int m = 0; m < 4; ++m) _Pragma("unroll") for (int n = 0; n < 2; ++n) _Pragma("unroll") for (int k = 0; k < 2; ++k) \
        acc[ai][bj][m][n] = __builtin_amdgcn_mfma_f32_16x16x32_bf16(Bt[n][k], At[m][k], acc[ai][bj][m][n], 0, 0, 0); __builtin_amdgcn_s_setprio(0); } while (0)
#define PG_WAIT_V(n) asm volatile("s_waitcnt vmcnt(" #n ")" ::: "memory")
#define PG_WAIT_L(n) asm volatile("s_waitcnt lgkmcnt(" #n ")" ::: "memory")
#define PG_BAR __builtin_amdgcn_s_barrier()
#define PG_SCHED __builtin_amdgcn_sched_barrier(0)
#define PG_SETOFF(V, U) do { _Pragma("unroll") for (int h = 0; h < 2; ++h) _Pragma("unroll") for (int i = 0; i < 2; ++i) \
        V[h][i] = (GATHER ? (unsigned)(U).rows[RA[i] + HALF * h] : (unsigned)(RA[i] + HALF * h)) * lda2 + ca2[i]; } while (0)
    Unit cur, nxt; int ui = 0;
    if (!S.next(0, cur)) return;
    PG_SETOFF(vc, cur);
    f32x4 acc[2][2][4][2];
#pragma unroll
    for (int a = 0; a < 2; ++a)
#pragma unroll
        for (int b = 0; b < 2; ++b)
#pragma unroll
            for (int m = 0; m < 4; ++m)
#pragma unroll
                for (int n = 0; n < 2; ++n) acc[a][b][m][n] = (f32x4){0.f, 0.f, 0.f, 0.f};
    bf16x8 At[4][2], B0[2][2], B1[2][2];
    const char* cA = cur.a; const char* cB = cur.b;
    PG_STB(PG_SB(0, 0), cB, 0); PG_STB(PG_SB(0, 1), cB, 1); PG_STA(PG_SA(0, 0), cA, vc, 0); PG_STA(PG_SA(0, 1), cA, vc, 1);
    if (wr == 1) PG_BAR;
    PG_WAIT_V(2); PG_BAR;
    PG_STB(PG_SB(1, 0), cB + kstep, 0); PG_STA(PG_SA(1, 0), cA + kstep, vc, 0); PG_STB(PG_SB(1, 1), cB + kstep, 1);
    PG_WAIT_V(6); PG_BAR;
#define PG_PAIR(a1, a2, b2, a3, b3, SWAP) do { \
        PG_LDB(B0, 0, 0); PG_LDB(B1, 0, 1); PG_SCHED; PG_LDA(At, 0, 0); PG_STA(PG_SA(1, 1), a1, vc, 1); \
        if (GATHER) { if (SWAP) { vc[0][0] = vn[0][0]; vc[0][1] = vn[0][1]; vc[1][0] = vn[1][0]; vc[1][1] = vn[1][1]; } } \
        PG_WAIT_V(8); PG_WAIT_L(0); PG_BAR; PG_MMA(0, 0, At, B0); PG_MMA(0, 1, At, B1); PG_BAR; PG_SCHED; \
        PG_LDA(At, 0, 1); PG_STB(PG_SB(0, 0), b2, 0); PG_STB(PG_SB(0, 1), b2, 1); PG_STA(PG_SA(0, 0), a2, vc, 0); \
        PG_WAIT_V(8); PG_WAIT_L(0); PG_BAR; PG_MMA(1, 0, At, B0); PG_MMA(1, 1, At, B1); PG_BAR; PG_SCHED; \
        PG_LDB(B0, 1, 0); PG_LDB(B1, 1, 1); PG_SCHED; PG_LDA(At, 1, 0); PG_STA(PG_SA(0, 1), a2, vc, 1); \
        PG_WAIT_V(8); PG_WAIT_L(0); PG_BAR; PG_MMA(0, 0, At, B0); PG_MMA(0, 1, At, B1); PG_BAR; PG_SCHED; \
        PG_LDA(At, 1, 1); PG_STB(PG_SB(1, 0), b3, 0); PG_STB(PG_SB(1, 1), b3, 1); PG_STA(PG_SA(1, 0), a3, vc, 0); \
        PG_WAIT_V(8); PG_WAIT_L(0); PG_BAR; PG_MMA(1, 0, At, B0); PG_MMA(1, 1, At, B1); PG_BAR; PG_SCHED; } while (0)
    for (;;) {
        const bool has_next = S.next(ui + 1, nxt);
        const char* nA = has_next ? nxt.a : cA; const char* nB = has_next ? nxt.b : cB;
        if (GATHER) { if (has_next) { PG_SETOFF(vn, nxt); } }
#pragma nounroll
        for (int t = 0; t < nt; t += 2) {
            const bool last = (t == nt - 2);
            const char* a1 = cA + (size_t)(t + 1) * kstep;
            const char* a2 = last ? nA : cA + (size_t)(t + 2) * kstep; const char* b2 = last ? nB : cB + (size_t)(t + 2) * kstep;
            const char* a3 = a2 + kstep; const char* b3 = b2 + kstep;
            PG_PAIR(a1, a2, b2, a3, b3, (last && has_next));
        }
        if (wr == 0) PG_BAR;
        { int efr = fr, efq = fq; asm volatile("" : "+v"(efr), "+v"(efq)); E(acc, cur, wr, wc, efr, efq); }
        if (!has_next) break;
#pragma unroll
        for (int a = 0; a < 2; ++a)
#pragma unroll
            for (int b = 0; b < 2; ++b)
#pragma unroll
                for (int m = 0; m < 4; ++m)
#pragma unroll
                    for (int n = 0; n < 2; ++n) acc[a][b][m][n] = (f32x4){0.f, 0.f, 0.f, 0.f};
        cur = nxt; cA = nA; cB = nB; ++ui;
        if (wr == 1) PG_BAR;
    }
    PG_WAIT_V(0);
    PG_BAR;
#undef PG_SA
#undef PG_SB
#undef PG_GL
#undef PG_STB
#undef PG_STA
#undef PG_LDA
#undef PG_LDB
#undef PG_MMA
#undef PG_WAIT_V
#undef PG_WAIT_L
#undef PG_BAR
#undef PG_SCHED
#undef PG_SETOFF
#undef PG_PAIR
}

struct SchedPlain {
    const char* A; const char* B; int lda, ldb, nM, nN, nwg, G, c;
    __device__ __forceinline__ bool next(int i, Unit& u) const {
        const long L = (long)i * G + c; if (L >= nwg) return false;
        const int wgid = xcd_remap((int)L, nwg);
        const int nig = 8 * nN, gid = wgid / nig, fm = gid * 8, gsz = (nM - fm) < 8 ? (nM - fm) : 8;
        u.pm = fm + ((wgid % nig) % gsz); u.pn = (wgid % nig) / gsz; u.e = 0; u.rows = nullptr;
        u.a = A + (size_t)u.pm * BM * lda * 2; u.b = B + (size_t)u.pn * BM * ldb * 2; return true;
    }
};
}

__device__ __forceinline__ void tr_item(const float* W, int N, int k0, int n0, bf16_t* WT, int ldt, int mode, int rmul, int radd, LAS float* scr, int lane) {
    f32x4 t[16];
#pragma unroll
    for (int i = 0; i < 16; ++i) t[i] = *(const f32x4*)(W + (size_t)(k0 + (lane >> 4) + 4 * i) * N + n0 + (lane & 15) * 4);
#pragma unroll
    for (int i = 0; i < 16; ++i) { LAS float* d = scr + ((lane >> 4) + 4 * i) * 65 + (lane & 15) * 4; d[0] = t[i].x; d[1] = t[i].y; d[2] = t[i].z; d[3] = t[i].w; }
    asm volatile("s_waitcnt lgkmcnt(0)" ::: "memory");
    const int c = lane & 7;
#pragma unroll
    for (int j = 0; j < 8; ++j) {
        const int n = (lane >> 3) + 8 * j; const LAS float* s = scr + (8 * c) * 65 + n;
        u32x4 o; o.x = pk2(s[0 * 65], s[1 * 65]); o.y = pk2(s[2 * 65], s[3 * 65]); o.z = pk2(s[4 * 65], s[5 * 65]); o.w = pk2(s[6 * 65], s[7 * 65]);
        const int ng = n0 + n;
        const int drow = mode == 1 ? (((ng & 255) >> 7) * 256 + (ng >> 8) * 128 + (ng & 127))
                       : mode == 2 ? ((ng >> 6) * 256 + ((ng >> 1) & 1) * 128 + ((ng >> 4) & 3) * 32 + (ng & 1) * 16 + ((ng >> 2) & 3) * 4 + radd) : ng * rmul + radd;
        *(u32x4*)(WT + (size_t)drow * ldt + k0 + 8 * c) = o;
    }
    asm volatile("s_waitcnt lgkmcnt(0)" ::: "memory");
}

__device__ __forceinline__ void phase0(const Params& p, LAS unsigned char* lds, int bid, int nblk) {
    const int tid = opq_tid(), lane = tid & 63, wid = tid >> 6;
    unsigned char* ws = p.ws;
    const int gt = bid * NTHR + tid, ngt = nblk * NTHR;
    float* pos = (float*)(ws + OFF_POS);
    for (int i = gt; i < 128 * 512; i += ngt) {
        const int r = i >> 9, c = i & 511, q = c & 255;
        const float omega = 1.0f / exp2f((float)q * (13.287712379549449f / 256.0f));
        const float ang = (float)r * omega;
        pos[i] = c < 256 ? __sinf(ang) : __cosf(ang);
    }
    float* cdec = (float*)(ws + OFF_CDEC);
    for (int i = gt; i < 2 * RW; i += ngt) cdec[i] = -8.0f * log1pf(expf(-p.in[15][i]));
    { int* ident = (int*)(ws + OFF_IDENT); for (int i = gt; i < NTOK; i += ngt) ident[i] = i; }
    {
        bf16_t* ws_s = (bf16_t*)(ws + W_S);
        for (int i = gt; i < 8 * 128 * 128; i += ngt) ws_s[i] = (bf16_t)f2bf(p.in[20][i]);
        bf16_t* wrt = (bf16_t*)(ws + W_RT);
        for (int i = gt; i < 2 * 1024 * 64; i += ngt) {
            const int l = i >> 16, k = (i >> 6) & 1023, e = i & 63;
            const float w = p.in[23][i];
            const unsigned hi = f2bf(w); const unsigned lo = f2bf(w - bf2f(hi));
            bf16_t* row = wrt + ((size_t)(l * 128 + e)) * 3072;
            row[k] = (bf16_t)hi; row[1024 + k] = (bf16_t)hi; row[2048 + k] = (bf16_t)lo;
        }
        unsigned* wz = (unsigned*)wrt;
        for (int i = gt; i < 2 * 64 * 1536; i += ngt) { const int l = i / (64 * 1536), r = i % (64 * 1536); wz[(size_t)(l * 128 + 64) * 1536 + r] = 0u; }
    }
    for (int it = bid; it < 192; it += nblk) {
        LAS float* sv = (LAS float*)lds;
        LAS float* red = (LAS float*)(lds + 20480);
        for (int i = tid; i < 5 * 1024; i += NTHR) { const float cv = i < 4096 ? p.in[1][i] : p.in[3][i - 4096]; sv[i] = silu(cv); }
        __syncthreads();
        const int l = it / 96, col0 = (it % 96) * 64;
        const float* w = p.in[4] + (size_t)l * 1024 * 6144 + col0 + lane;
        float a0 = 0.f, a1 = 0.f, a2 = 0.f, a3 = 0.f, a4 = 0.f;
        const int kb = wid * 128;
#pragma unroll 8
        for (int k = kb; k < kb + 128; ++k) {
            const float wv = w[(size_t)k * 6144];
            a0 += sv[k] * wv; a1 += sv[1024 + k] * wv; a2 += sv[2048 + k] * wv; a3 += sv[3072 + k] * wv; a4 += sv[4096 + k] * wv;
        }
        red[(wid * 5 + 0) * 64 + lane] = a0; red[(wid * 5 + 1) * 64 + lane] = a1; red[(wid * 5 + 2) * 64 + lane] = a2;
        red[(wid * 5 + 3) * 64 + lane] = a3; red[(wid * 5 + 4) * 64 + lane] = a4;
        __syncthreads();
        if (tid < 320) {
            const int v = tid >> 6, ln = tid & 63; float s = 0.f;
#pragma unroll
            for (int w8 = 0; w8 < 8; ++w8) s += red[(w8 * 5 + v) * 64 + ln];
            ((float*)(ws + OFF_MOD))[(size_t)(l * 5 + v) * 6144 + col0 + ln] = s + p.in[5][l * 6144 + col0 + ln];
        }
        __syncthreads();
    }
    LAS float* scr = (LAS float*)(lds + wid * 16640);
    const int gw = bid * 8 + wid, ngw = nblk * 8;
    constexpr int I_AIN = 16 * 40, I_AOUT = 20 * 16, I_GATE = 20 * 16, I_BIN = 16 * 64, I_BOUT = 32 * 16;
    constexpr int NITEMS = I_AIN + I_AOUT + I_GATE + I_BIN + I_BOUT;
    for (int it = gw; it < NITEMS; it += ngw) {
        int r = it;
        if (r < I_AIN) { const int kb = r / 40, nb = r % 40; tr_item(p.in[8], 2560, kb * 64, nb * 64, (bf16_t*)(ws + W_AIN), 1024, 0, 1, 0, scr, lane); continue; }
        r -= I_AIN;
        if (r < I_AOUT) { const int kb = r / 16, nb = r % 16; tr_item(p.in[16], 1024, kb * 64, nb * 64, (bf16_t*)(ws + W_AOUT), 1280, 0, 1, 0, scr, lane); continue; }
        r -= I_AOUT;
        if (r < I_GATE) {
            const int mi = r >> 4, q = r & 15, kb = q >> 2, nb = q & 3, h = mi % 5, dg = mi / 5, d = dg >> 1, g = dg & 1;
            const float* src = (g ? p.in[13] : p.in[11]) + (size_t)(d * 5 + h) * 65536;
            tr_item(src, 256, kb * 64, nb * 64, (bf16_t*)(ws + W_GATE) + (size_t)h * 1024 * 256, 256, 2, 4, d * 2 + g, scr, lane); continue; }
        r -= I_GATE;
        if (r < I_BIN) { const int kb = r / 64, nb = r % 64; tr_item(p.in[17], 4096, kb * 64, nb * 64, (bf16_t*)(ws + W_BIN), 1024, 0, 1, 0, scr, lane); continue; }
        r -= I_BIN;
        { const int kb = r / 16, nb = r % 16; tr_item(p.in[22], 1024, kb * 64, nb * 64, (bf16_t*)(ws + W_BOUT), 2048, 0, 1, 0, scr, lane); }
    }
}

constexpr int BG_TILES = 65 * 128 + 65 * 64, BG_CHUNKS = BG_TILES / 8;
__device__ __forceinline__ void bg_tile(const Params& p, int l, int t, LAS float* scr, int lane) {
    unsigned char* ws = p.ws;
    if (t < 65 * 128) { const int e = t >> 7, q = t & 127, kb = q >> 3, nb = q & 7, le = l * 65 + e;
        const float* src = e < 64 ? p.in[25] + (size_t)(l * 64 + e) * 1024 * 512 : p.in[27] + (size_t)l * 1024 * 512;
        tr_item(src, 512, kb * 64, nb * 64, (bf16_t*)(ws + W_GU) + (size_t)le * 512 * 1024, 1024, 1, 1, 0, scr, lane);
    } else { const int r = t - 65 * 128, e = r >> 6, q = r & 63, kb = q >> 4, nb = q & 15, le = l * 65 + e;
        const float* src = e < 64 ? p.in[26] + (size_t)(l * 64 + e) * 256 * 1024 : p.in[28] + (size_t)l * 256 * 1024;
        tr_item(src, 1024, kb * 64, nb * 64, (bf16_t*)(ws + W_DN) + (size_t)le * 1024 * 256, 256, 0, 1, 0, scr, lane); }
}
__device__ __forceinline__ void bg_convert(const Params& p, LAS unsigned char* lds, int l, int maxchunks) {
    const int tid = opq_tid(), lane = tid & 63, wid = tid >> 6;
    unsigned* q = (unsigned*)(p.ws + 32768) + l * 64;
    LAS int* slot = (LAS int*)(lds + LDS_BYTES - 64);
    LAS float* scr = (LAS float*)(lds + wid * 16640);
    for (int n = 0; n < maxchunks; ++n) {
        if (tid == 0) *slot = (int)atomicAdd(q, 1u);
        __syncthreads();
        const int c = *slot;
        __syncthreads();
        if (c >= BG_CHUNKS) break;
        bg_tile(p, l, c * 8 + wid, scr, lane);
    }
    __syncthreads();
}
__device__ __forceinline__ bool bg_idle(int nunits, int G, int c) { return (nunits - c + G - 1) / G < (nunits + G - 1) / G; }

template <int MODE, bool WRITE_LO, bool FINAL>
__device__ __forceinline__ void row_phase(const Params& p, int bid, int nblk, const float* gnorm, const float* modl  , int off_sh, int off_sc,
                                           const float* modprev  , const bf16_t* dx  ) {
    const int tid = opq_tid(), lane = tid & 63, wid = tid >> 6;
    unsigned char* ws = p.ws;
    float* xout = p.out;
    bf16_t* xres = (bf16_t*)(ws + B_XR);
    bf16_t* hx = (bf16_t*)(ws + OFF_HX);
    bf16_t* hlo = (bf16_t*)(ws + B_HLO);
    const float* pos = (const float*)(ws + OFF_POS);
    const int* slotof = (const int*)(ws + OFF_SLOTOF);
    const bf16_t* Y = (const bf16_t*)(ws + B_YY);
    const int nrows = MODE == 0 ? NROW : NTOK;
    for (int row = bid * 8 + wid; row < nrows; row += nblk * 8) {
        f32x4 v[4];
        int mv;
        if (MODE == 0) {
            if (row < NTOK) {
                mv = row >> 13; const int t = row & (SEQ - 1);
                const f32x4* xr = (const f32x4*)(p.in[0] + (size_t)row * D) + lane;
                const f32x4* pr = (const f32x4*)(pos + (size_t)(t >> 6) * 512) + lane;
                const f32x4* pc = (const f32x4*)(pos + (size_t)(t & 63) * 512) + lane;
                v[0] = xr[0] + pr[0]; v[1] = xr[64] + pr[64]; v[2] = xr[128] + pc[0]; v[3] = xr[192] + pc[64];
                u32x2* xo = (u32x2*)(xres + (size_t)row * D) + lane;
#pragma unroll
                for (int j = 0; j < 4; ++j) xo[64 * j] = (u32x2){pk2(v[j].x, v[j].y), pk2(v[j].z, v[j].w)};
            } else {
                mv = 4;
                const f32x4* xr = (const f32x4*)(p.in[2] + (size_t)(row - NTOK) * D) + lane;
#pragma unroll
                for (int j = 0; j < 4; ++j) v[j] = xr[64 * j];
            }
        } else {
            mv = row >> 13;
            u32x2* xo = (u32x2*)(xres + (size_t)row * D) + lane;
#pragma unroll
            for (int j = 0; j < 4; ++j) { const u32x2 w = xo[64 * j]; v[j] = (f32x4){bflo(w.x), bfhi(w.x), bflo(w.y), bfhi(w.y)}; }
            if (MODE == 1) {
                const u32x2* dr = (const u32x2*)(dx + (size_t)row * D) + lane;
#pragma unroll
                for (int j = 0; j < 4; ++j) { const u32x2 w = dr[64 * j]; v[j].x += bflo(w.x); v[j].y += bfhi(w.x); v[j].z += bflo(w.y); v[j].w += bfhi(w.y); xo[64 * j] = (u32x2){pk2(v[j].x, v[j].y), pk2(v[j].z, v[j].w)}; }
            }
            if (MODE == 2) {
                f32x4 s[4];
                {
                    const unsigned* yr = (const unsigned*)(ws + B_YS + (size_t)row * D) + lane;
#pragma unroll
                    for (int j = 0; j < 4; ++j) s[j] = up4_fp8(yr[64 * j]);
                }
#pragma unroll
                for (int k = 0; k < TOPK; ++k) {
                    const int slot = slotof[row * 8 + k];
                    const unsigned* yr = (const unsigned*)(ws + B_YY + (size_t)slot * D) + lane;
#pragma unroll
                    for (int j = 0; j < 4; ++j) s[j] = s[j] + up4_fp8(yr[64 * j]);
                }
                const f32x4* g2 = (const f32x4*)(modprev + (size_t)mv * 6144 + 5120) + lane;
#pragma unroll
                for (int j = 0; j < 4; ++j) { v[j] = v[j] + g2[64 * j] * s[j]; if (!FINAL) xo[64 * j] = (u32x2){pk2(v[j].x, v[j].y), pk2(v[j].z, v[j].w)}; }
            }
        }
        float ss = 0.f;
#pragma unroll
        for (int j = 0; j < 4; ++j) ss += (v[j].x * v[j].x + v[j].y * v[j].y) + (v[j].z * v[j].z + v[j].w * v[j].w);
        ss = wave_sum(ss);
        const float rinv = 1.0f / sqrtf(ss * (1.0f / D) + 1e-6f);
        const f32x4* gn = (const f32x4*)gnorm + lane;
        if (FINAL) {
            f32x4* xo = (f32x4*)(xout + (size_t)row * D) + lane;
#pragma unroll
            for (int j = 0; j < 4; ++j) xo[64 * j] = v[j] * rinv * gn[64 * j];
        } else {
            const f32x4* sh = (const f32x4*)(modl + (size_t)mv * 6144 + off_sh) + lane;
            const f32x4* sc = (const f32x4*)(modl + (size_t)mv * 6144 + off_sc) + lane;
            u32x2* ho = (u32x2*)(hx + (size_t)row * D) + lane;
            u32x2* lo = (u32x2*)(hlo + (size_t)row * D) + lane;
#pragma unroll
            for (int j = 0; j < 4; ++j) {
                const f32x4 y = v[j] * rinv * gn[64 * j] * (sc[64 * j] + 1.0f) + sh[64 * j];
                u32x2 w; w.x = pk2(y.x, y.y); w.y = pk2(y.z, y.w);
                ho[64 * j] = w;
                if (WRITE_LO) { u32x2 q; q.x = pk2(y.x - bflo(w.x), y.y - bfhi(w.x)); q.y = pk2(y.z - bflo(w.y), y.w - bfhi(w.y)); lo[64 * j] = q; }
            }
        }
    }
}

__device__ __forceinline__ void phase_inproj0(const Params& p, LAS unsigned char* lds, int bid, int nblk) {
    unsigned char* ws = p.ws;
    const bf16_t* hx = (const bf16_t*)(ws + OFF_HX); const bf16_t* W = (const bf16_t*)(ws + W_AIN);
    bf16_t* gate0 = (bf16_t*)(ws + B_GATE0); bf16_t* upre = (bf16_t*)(ws + B_UPRE);
    const int tid = opq_tid(), srow = tid >> 2, skc = (tid & 3) * 8;
    constexpr int NU = 256 * 20 + 8 * 10;
    for (int u = bid; u < NU; u += nblk) {
        int mt, nt;
        if (u < 5120) { mt = u / 20; nt = u % 20; } else { const int q = u - 5120; mt = 256 + q / 10; nt = 10 + q % 10; }
        const bf16_t* arow = hx + (size_t)(mt * 128 + srow) * D + skc;
        const bf16_t* brow = W + (size_t)(nt * 128 + srow) * D + skc;
        gemm_tile(arow, brow, 32, KDef(), [=](int r, int c, f32x4 v) {
            const int row = mt * 128 + r, col = nt * 128 + c;
            if (col < RW) { u32x2 w; w.x = pk2(gelu_t(v.x), gelu_t(v.y)); w.y = pk2(gelu_t(v.z), gelu_t(v.w)); *(u32x2*)(gate0 + (size_t)row * RW + col) = w; }
            else { u32x2 w; w.x = pk2(v.x, v.y); w.y = pk2(v.z, v.w); *(u32x2*)(upre + (size_t)row * RW + (col - RW)) = w; }
        }, lds);
    }
}

__device__ __forceinline__ void phase_conv(const Params& p, int bid, int nblk) {
    unsigned char* ws = p.ws;
    const bf16_t* upre = (const bf16_t*)(ws + B_UPRE); bf16_t* uu = (bf16_t*)(ws + B_UU);
    const float* cw = p.in[9]; const float* cb = p.in[10];
    const int gt = bid * NTHR + opq_tid(), ngt = nblk * NTHR;
    for (int item = gt; item < (NROW / 16) * 160; item += ngt) {
        const int rb = item / 160, cg8 = (item % 160) * 8, R0 = rb * 16;
        int t0, T;
        if (R0 < NTOK) { t0 = R0 & (SEQ - 1); T = SEQ; } else { t0 = (R0 - NTOK) & (CTXL - 1); T = CTXL; }
        f32x4 wa[4], wb[4];
#pragma unroll
        for (int k = 0; k < 4; ++k) { wa[k] = *(const f32x4*)(cw + k * RW + cg8); wb[k] = *(const f32x4*)(cw + k * RW + cg8 + 4); }
        const f32x4 ba = *(const f32x4*)(cb + cg8), bb = *(const f32x4*)(cb + cg8 + 4);
        u32x4 raw[19];
#pragma unroll
        for (int j = 0; j < 19; ++j) { const int tt = t0 + j - 2; raw[j] = (tt >= 0 && tt < T) ? *(const u32x4*)(upre + (size_t)(R0 + j - 2) * RW + cg8) : (u32x4){0u, 0u, 0u, 0u}; }
#pragma unroll
        for (int r = 0; r < 16; ++r) {
            f32x4 oa = ba, ob = bb;
#pragma unroll
            for (int k = 0; k < 4; ++k) { const u32x4 w = raw[r + k];
                oa = oa + wa[k] * (f32x4){bflo(w.x), bfhi(w.x), bflo(w.y), bfhi(w.y)}; ob = ob + wb[k] * (f32x4){bflo(w.z), bfhi(w.z), bflo(w.w), bfhi(w.w)}; }
            *(u32x4*)(uu + (size_t)(R0 + r) * RW + cg8) = pack8(oa, ob);
        }
    }
}

__device__ __forceinline__ void phase_outproj(const Params& p, LAS unsigned char* lds, int bid, int nblk, const bf16_t* Z, int K, const bf16_t* W, const float* modl) {
    float* xres = p.out;
    const int tid = opq_tid(), srow = tid >> 2, skc = (tid & 3) * 8;
    for (int u = bid; u < 256 * 8; u += nblk) {
        const int mt = u >> 3, nt = u & 7;
        const bf16_t* arow = Z + (size_t)(mt * 128 + srow) * K + skc;
        const bf16_t* brow = W + (size_t)(nt * 128 + srow) * K + skc;
        gemm_tile(arow, brow, K / 32, KDef(), [=](int r, int c, f32x4 v) {
            const int row = mt * 128 + r, col = nt * 128 + c;
            const f32x4 g1 = *(const f32x4*)(modl + (size_t)(row >> 13) * 6144 + 2048 + col);
            f32x4* xo = (f32x4*)(xres + (size_t)row * D + col);
            *xo = *xo + g1 * v;
        }, lds);
    }
}

__device__ __forceinline__ float rdlane(float v, int l) { return __builtin_bit_cast(float, __builtin_amdgcn_readlane(__builtin_bit_cast(int, v), l)); }
__device__ __forceinline__ float xmax(float v, int m) { return fmaxf(v, __shfl_xor(v, m)); }
__device__ __forceinline__ void phase_router(const Params& p, LAS unsigned char* lds, int bid, int nblk, int l) {
    unsigned char* ws = p.ws;
    const bf16_t* hx = (const bf16_t*)(ws + OFF_HX); const bf16_t* W = (const bf16_t*)(ws + W_RT) + (size_t)l * 128 * 3072;
    int* eidx = (int*)(ws + OFF_EIDX); float* gatew = (float*)(ws + OFF_GATEW); int* cnt = (int*)(ws + OFF_CNT); int* cntw = (int*)(ws + OFF_CNTW2);
    const int tid = opq_tid(), lane = tid & 63, wid = tid >> 6, fr = lane & 15, fq = lane >> 4;
    const float rbl = p.in[24][l * 64 + lane];
    LAS float* part = (LAS float*)lds;
    LAS float* L = (LAS float*)(lds + 69632);
    LAS int* cw = (LAS int*)(lds + 69632 + 8320);
    bf16x8 Bh[4][4], Bl[4][4];
#pragma unroll
    for (int s = 0; s < 4; ++s)
#pragma unroll
        for (int nb = 0; nb < 4; ++nb) { const bf16_t* wp = W + (size_t)(16 * nb + fr) * 3072 + 128 * wid + 32 * s + 8 * fq; Bh[s][nb] = *(const bf16x8*)wp; Bl[s][nb] = *(const bf16x8*)(wp + 2048); }
    bf16x8 Ah[2][4], Al[2][4];
#define RT_LOADA(ROW0) do { _Pragma("unroll") for (int g = 0; g < 2; ++g) _Pragma("unroll") for (int s = 0; s < 4; ++s) { \
        const bf16_t* ap = hx + (size_t)((ROW0) + 16 * g + fr) * D + 128 * wid + 32 * s + 8 * fq; Ah[g][s] = *(const bf16x8*)ap; Al[g][s] = *(const bf16x8*)(ap + LO_DELTA); } } while (0)
    if (bid < 256) RT_LOADA(bid * 128);
    for (int tile = bid; tile < 256; tile += nblk) {
        int cnt_e = 0;
        for (int it = 0; it < 4; ++it) {
            const int row0 = tile * 128 + it * 32;
            f32x4 acc[2][4];
#pragma unroll
            for (int g = 0; g < 2; ++g)
#pragma unroll
                for (int nb = 0; nb < 4; ++nb) acc[g][nb] = (f32x4){0.f, 0.f, 0.f, 0.f};
#pragma unroll
            for (int g = 0; g < 2; ++g)
#pragma unroll
                for (int s = 0; s < 4; ++s)
#pragma unroll
                    for (int nb = 0; nb < 4; ++nb) {
                        acc[g][nb] = __builtin_amdgcn_mfma_f32_16x16x32_bf16(Bh[s][nb], Ah[g][s], acc[g][nb], 0, 0, 0);
                        acc[g][nb] = __builtin_amdgcn_mfma_f32_16x16x32_bf16(Bh[s][nb], Al[g][s], acc[g][nb], 0, 0, 0);
                        acc[g][nb] = __builtin_amdgcn_mfma_f32_16x16x32_bf16(Bl[s][nb], Ah[g][s], acc[g][nb], 0, 0, 0);
                    }
            {
                const int nrow0 = it < 3 ? row0 + 32 : (tile + nblk) * 128;
                if (nrow0 < NTOK) RT_LOADA(nrow0);
            }
#pragma unroll
            for (int g = 0; g < 2; ++g)
#pragma unroll
                for (int nb = 0; nb < 4; ++nb) *(LAS f32x4*)(part + ((wid * 32 + 16 * g + fr) * 68 + 16 * nb + 4 * fq)) = acc[g][nb];
            __syncthreads();
            {
                const int r = tid >> 4, e0 = (tid & 15) * 4;
                f32x4 s = (f32x4){0.f, 0.f, 0.f, 0.f};
#pragma unroll
                for (int w = 0; w < 8; ++w) s = s + *(LAS f32x4*)(part + ((w * 32 + r) * 68 + e0));
                LAS float* o = L + r * 65 + e0; o[0] = s.x; o[1] = s.y; o[2] = s.z; o[3] = s.w;
            }
            __syncthreads();
#pragma unroll 1
            for (int j = 0; j < 4; ++j) {
                const int r = 4 * wid + j, tok = row0 + r;
                const float sc = sigm(L[r * 65 + lane]), sel = sc + rbl;
                const float m1 = xmax(xmax(xmax(sel, 1), 2), 4);
                int cand = sel == m1 ? lane : 64; cand = min(cand, __shfl_xor(cand, 1)); cand = min(cand, __shfl_xor(cand, 2)); cand = min(cand, __shfl_xor(cand, 4));
                const float s2 = lane == cand ? -__builtin_inff() : sel;
                const float gs = m1 + xmax(xmax(xmax(s2, 1), 2), 4);
                const int g = lane >> 3; int rank = 0;
#pragma unroll
                for (int gp = 0; gp < 8; ++gp) { const float o = rdlane(gs, gp * 8); rank += (o > gs || (o == gs && gp < g)) ? 1 : 0; }
                const bool keep = rank < 4;
                const unsigned bits = __builtin_bit_cast(unsigned, sel), srt = (bits & 0x80000000u) ? ~bits : (bits | 0x80000000u);
                const unsigned key = keep ? ((srt & ~63u) | (unsigned)(63 - lane)) : 0u;
                LAS unsigned* kb = (LAS unsigned*)(lds + 80000) + wid * 64;
                kb[lane] = key;
                int er = 0;
#pragma unroll
                for (int q4 = 0; q4 < 16; ++q4) { const u32x4 k4 = *(LAS u32x4*)(kb + 4 * q4); er += (k4.x > key ? 1 : 0) + (k4.y > key ? 1 : 0) + (k4.z > key ? 1 : 0) + (k4.w > key ? 1 : 0); }
                const bool chosen = keep && er < 8;
                const float ssum = wave_sum(chosen ? sc : 0.0f);
                if (chosen) { eidx[tok * 8 + er] = lane | (cnt_e << 8); gatew[tok * 8 + er] = sc * (2.5f / ssum); }
                cnt_e += chosen ? 1 : 0;
            }
        }
        cntw[(tile * 8 + wid) * 64 + lane] = cnt_e;
        cw[wid * 64 + lane] = cnt_e;
        __syncthreads();
        if (tid < 64) { int c = 0;
#pragma unroll
            for (int w = 0; w < 8; ++w) c += cw[w * 64 + tid];
            cnt[tile * 64 + tid] = c; }
        __syncthreads();
    }
}

__device__ __forceinline__ void phase_normroute(const Params& p, LAS unsigned char* lds, int bid, int nblk, int l, const float* gnorm, const float* modl, const bf16_t* dx) {
    unsigned char* ws = p.ws;
    bf16_t* xres = (bf16_t*)(ws + B_XR); bf16_t* hx = (bf16_t*)(ws + OFF_HX);
    const bf16_t* W = (const bf16_t*)(ws + W_RT) + (size_t)l * 128 * 3072;
    int* eidx = (int*)(ws + OFF_EIDX); float* gatew = (float*)(ws + OFF_GATEW); int* cnt = (int*)(ws + OFF_CNT); int* cntw = (int*)(ws + OFF_CNTW2);
    const int tid = opq_tid(), lane = tid & 63, wid = tid >> 6, fr = lane & 15, fq = lane >> 4;
    const float rbl = p.in[24][l * 64 + lane];
    LAS unsigned char* ahi = lds;
    LAS unsigned char* alo = lds + 33024;
    LAS float* part = (LAS float*)(lds + 66048);
    LAS float* L = (LAS float*)(lds + 66048 + 34816);
    LAS unsigned* kbase = (LAS unsigned*)(lds + 66048 + 34816 + 4224);
    LAS int* cw = (LAS int*)(lds + 66048 + 34816 + 4224 + 2048);
    bf16x8 Bh[4][4], Bl[4][4];
#pragma unroll
    for (int s = 0; s < 4; ++s)
#pragma unroll
        for (int nb = 0; nb < 4; ++nb) { const bf16_t* wp = W + (size_t)(16 * nb + fr) * 3072 + 128 * wid + 32 * s + 8 * fq; Bh[s][nb] = *(const bf16x8*)wp; Bl[s][nb] = *(const bf16x8*)(wp + 2048); }
    const f32x4* gn = (const f32x4*)gnorm + lane;
    u32x2 xa[2][4], da[2][4];
#define NR_LOAD(ROW0) do { _Pragma("unroll") for (int q = 0; q < 2; ++q) { const size_t r_ = (size_t)(ROW0) + 2 * wid + q; _Pragma("unroll") for (int j = 0; j < 4; ++j) { \
        xa[q][j] = ((const u32x2*)(xres + r_ * D) + lane)[64 * j]; da[q][j] = ((const u32x2*)(dx + r_ * D) + lane)[64 * j]; } } } while (0)
    if (bid < 256) NR_LOAD(bid * 128);
    for (int tile = bid; tile < 256; tile += nblk) {
        int cnt_e = 0;
        const int mv = tile >> 6;
        f32x4 ca[4];
#pragma unroll
        for (int j = 0; j < 4; ++j) ca[j] = gn[64 * j] * (((const f32x4*)(modl + (size_t)mv * 6144 + 4096) + lane)[64 * j] + 1.0f);
        const f32x4* sh = (const f32x4*)(modl + (size_t)mv * 6144 + 3072) + lane;
        for (int grp = 0; grp < 8; ++grp) {
            const int row0 = tile * 128 + grp * 16;
#pragma unroll
            for (int q = 0; q < 2; ++q) {
                const int rl = 2 * wid + q; const size_t row = (size_t)row0 + rl;
                f32x4 v[4]; float ss = 0.f;
#pragma unroll
                for (int j = 0; j < 4; ++j) { const u32x2 a = xa[q][j], b = da[q][j];
                    v[j] = (f32x4){bflo(a.x) + bflo(b.x), bfhi(a.x) + bfhi(b.x), bflo(a.y) + bflo(b.y), bfhi(a.y) + bfhi(b.y)};
                    ((u32x2*)(xres + row * D) + lane)[64 * j] = (u32x2){pk2(v[j].x, v[j].y), pk2(v[j].z, v[j].w)};
                    ss += (v[j].x * v[j].x + v[j].y * v[j].y) + (v[j].z * v[j].z + v[j].w * v[j].w); }
                ss = wave_sum(ss);
                const float rinv = 1.0f / sqrtf(ss * (1.0f / D) + 1e-6f);
#pragma unroll
                for (int j = 0; j < 4; ++j) {
                    const f32x4 y = v[j] * rinv * ca[j] + sh[64 * j];
                    u32x2 w; w.x = pk2(y.x, y.y); w.y = pk2(y.z, y.w);
                    ((u32x2*)(hx + row * D) + lane)[64 * j] = w;
                    u32x2 ql; ql.x = pk2(y.x - bflo(w.x), y.y - bfhi(w.x)); ql.y = pk2(y.z - bflo(w.y), y.w - bfhi(w.y));
                    *(LAS u32x2*)(ahi + rl * 2064 + (lane + 64 * j) * 8) = w; *(LAS u32x2*)(alo + rl * 2064 + (lane + 64 * j) * 8) = ql;
                }
            }
            __syncthreads();
            {
                const int nrow0 = grp < 7 ? row0 + 16 : (tile + nblk) * 128;
                if (nrow0 < NTOK) NR_LOAD(nrow0);
            }
            f32x4 acc[4];
#pragma unroll
            for (int nb = 0; nb < 4; ++nb) acc[nb] = (f32x4){0.f, 0.f, 0.f, 0.f};
#pragma unroll
            for (int s = 0; s < 4; ++s) {
                const int ko = fr * 2064 + (128 * wid + 32 * s + 8 * fq) * 2;
                const bf16x8 Ah = *(LAS bf16x8*)(ahi + ko), Al = *(LAS bf16x8*)(alo + ko);
#pragma unroll
                for (int nb = 0; nb < 4; ++nb) {
                    acc[nb] = __builtin_amdgcn_mfma_f32_16x16x32_bf16(Bh[s][nb], Ah, acc[nb], 0, 0, 0);
                    acc[nb] = __builtin_amdgcn_mfma_f32_16x16x32_bf16(Bh[s][nb], Al, acc[nb], 0, 0, 0);
                    acc[nb] = __builtin_amdgcn_mfma_f32_16x16x32_bf16(Bl[s][nb], Ah, acc[nb], 0, 0, 0);
                }
            }
#pragma unroll
            for (int nb = 0; nb < 4; ++nb) *(LAS f32x4*)(part + ((wid * 16 + fr) * 68 + 16 * nb + 4 * fq)) = acc[nb];
            __syncthreads();
            if (tid < 256) {
                const int r = tid >> 4, e0 = (tid & 15) * 4;
                f32x4 s = (f32x4){0.f, 0.f, 0.f, 0.f};
#pragma unroll
                for (int w = 0; w < 8; ++w) s = s + *(LAS f32x4*)(part + ((w * 16 + r) * 68 + e0));
                LAS float* o = L + r * 65 + e0; o[0] = s.x; o[1] = s.y; o[2] = s.z; o[3] = s.w;
            }
            __syncthreads();
#pragma unroll 1
            for (int j = 0; j < 2; ++j) {
                const int r = 2 * wid + j, tok = row0 + r;
                const float scv = sigm(L[r * 65 + lane]), sel = scv + rbl;
                const float m1 = max8(sel);
                const int cand = min8(sel == m1 ? lane : 64);
                const float s2 = lane == cand ? -__builtin_inff() : sel;
                const float gs = m1 + max8(s2);
                const int g = lane >> 3; int rank = 0;
#pragma unroll
                for (int gp = 0; gp < 8; ++gp) { const float o = rdlane(gs, gp * 8); rank += (o > gs || (o == gs && gp < g)) ? 1 : 0; }
                const bool keep = rank < 4;
                const unsigned bits = __builtin_bit_cast(unsigned, sel), srt = (bits & 0x80000000u) ? ~bits : (bits | 0x80000000u);
                const unsigned key = keep ? ((srt & ~63u) | (unsigned)(63 - lane)) : 0u;
                LAS unsigned* kb = kbase + wid * 64;
                kb[lane] = key;
                int er = 0;
#pragma unroll
                for (int q4 = 0; q4 < 16; ++q4) { const u32x4 k4 = *(LAS u32x4*)(kb + 4 * q4); er += (k4.x > key ? 1 : 0) + (k4.y > key ? 1 : 0) + (k4.z > key ? 1 : 0) + (k4.w > key ? 1 : 0); }
                const bool chosen = keep && er < 8;
                const float ssum = wave_sum(chosen ? scv : 0.0f);
                if (chosen) { eidx[tok * 8 + er] = lane | (cnt_e << 8); gatew[tok * 8 + er] = scv * (2.5f / ssum); }
                cnt_e += chosen ? 1 : 0;
            }
        }
        cntw[(tile * 8 + wid) * 64 + lane] = cnt_e;
        cw[wid * 64 + lane] = cnt_e;
        __syncthreads();
        if (tid < 64) { int c = 0;
#pragma unroll
            for (int w = 0; w < 8; ++w) c += cw[w * 64 + tid];
            cnt[tile * 64 + tid] = c; }
        __syncthreads();
    }
#undef NR_LOAD
}

__device__ __forceinline__ void phase_scatter(const Params& p, LAS unsigned char* lds, int bid, int nblk, int l) {
    unsigned char* ws = p.ws;
    const int* eidx = (const int*)(ws + OFF_EIDX); const float* gatew = (const float*)(ws + OFF_GATEW); const int* cnt = (const int*)(ws + OFF_CNT); const int* cntw = (const int*)(ws + OFF_CNTW2);
    int* slotof = (int*)(ws + OFF_SLOTOF); int* tokof = (int*)(ws + OFF_TOKOF); float* wof = (float*)(ws + OFF_WOF); int* meta = (int*)(ws + OFF_META);
    const int tid = opq_tid();
    LAS int* ps = (LAS int*)lds;
    LAS int* tot = (LAS int*)(lds + 2048);
    LAS int* sst = (LAS int*)(lds + 2048 + 256);
    LAS int* base = (LAS int*)(lds + 4096);
    LAS int* cl = (LAS int*)(lds + 8192);
    for (int i = tid; i < 256 * 64; i += NTHR) cl[i] = cnt[i];
    __syncthreads();
    {
        const int e = tid & 63, part = tid >> 6; int s = 0;
#pragma unroll 8
        for (int r = part * 32; r < part * 32 + 32; ++r) s += cl[r * 64 + e];
        ps[part * 64 + e] = s;
    }
    __syncthreads();
    if (tid < 64) { int s = 0; for (int q = 0; q < 8; ++q) s += ps[q * 64 + tid]; tot[tid] = s; }
    __syncthreads();
    if (tid == 0) { int a = 0; for (int e = 0; e < 64; ++e) { sst[e] = a; a += (tot[e] + TM - 1) / TM * TM; } sst[64] = a; sst[65] = a + NTOK; }
    __syncthreads();
    for (int tile = bid; tile < 256; tile += nblk) {
        {
            const int e = tid & 63, part = tid >> 6; int s = 0;
#pragma unroll 8
            for (int r = part * 32; r < part * 32 + 32; ++r) s += r < tile ? cl[r * 64 + e] : 0;
            ps[part * 64 + e] = s;
        }
        __syncthreads();
        {
            const int e = tid & 63, w = tid >> 6; int b = sst[e];
#pragma unroll
            for (int q = 0; q < 8; ++q) b += ps[q * 64 + e];
#pragma unroll
            for (int q = 0; q < 8; ++q) b += q < w ? cntw[(tile * 8 + q) * 64 + e] : 0;
            base[w * 64 + e] = b;
        }
        __syncthreads();
#pragma unroll
        for (int i = 0; i < 2; ++i) {
            const int a = tid + NTHR * i, r = a >> 3, tok = tile * 128 + r, w = (r & 15) >> 1;
            const int code = eidx[tile * 1024 + a], e = code & 63, lr = code >> 8;
            const int slot = base[w * 64 + e] + lr;
            tokof[slot] = tok; wof[slot] = gatew[tile * 1024 + a]; slotof[tile * 1024 + a] = slot;
        }
        if (tile == 0) {
            if (tid < 64) for (int s = sst[tid] + tot[tid]; s < sst[tid + 1]; ++s) { tokof[s] = 0; wof[s] = 0.0f; }
            if (tid < 66) meta[tid] = sst[tid];
        }
        __syncthreads();
    }
    bg_convert(p, lds, l, 1 << 30);
}

__device__ __forceinline__ void phase_inproj1(const Params& p, LAS unsigned char* lds, int bid, int nblk) {
    unsigned char* ws = p.ws;
    const bf16_t* hx = (const bf16_t*)(ws + OFF_HX); const bf16_t* W = (const bf16_t*)(ws + W_BIN); bf16_t* uv = (bf16_t*)(ws + B_UV);
    const int tid = opq_tid(), srow = tid >> 2, skc = (tid & 3) * 8;
    for (int u = bid; u < 256 * 32; u += nblk) {
        const int mt = u >> 5, nt = u & 31;
        const bf16_t* arow = hx + (size_t)(mt * 128 + srow) * D + skc;
        const bf16_t* brow = W + (size_t)(nt * 128 + srow) * D + skc;
        gemm_tile(arow, brow, 32, KDef(), [=](int r, int c, f32x4 v) {
            u32x2 w; w.x = pk2(gelu_t(v.x), gelu_t(v.y)); w.y = pk2(gelu_t(v.z), gelu_t(v.w));
            *(u32x2*)(uv + (size_t)(mt * 128 + r) * 4096 + nt * 128 + c) = w;
        }, lds);
    }
}

__device__ __forceinline__ void phase_sgu(const Params& p, LAS unsigned char* lds, int bid, int nblk) {
    unsigned char* ws = p.ws;
    const bf16_t* Wsb = (const bf16_t*)(ws + W_S); const bf16_t* uv = (const bf16_t*)(ws + B_UV); const float* statp = (const float*)(ws + OFF_STATP);
    bf16_t* z1 = (bf16_t*)(ws + B_Z1); const float* bs = p.in[21]; const float* lng = p.in[18]; const float* lnb = p.in[19];
    const int tid = opq_tid(), lane = tid & 63, wid = tid >> 6, wr = wid >> 2, wc = wid & 3, fr = lane & 15, fq = lane >> 4;
    LAS unsigned char* sa = lds;
    LAS unsigned char* sb = lds + 34816;
    LAS float* st = (LAS float*)(lds + 69632);
    u32x4 ra[4], rb[4], ru[4]; f32x4 rg[2], rbb[2]; float rm = 0.f, rr = 0.f;
#define SG_LOAD(U) do { const int chunk_ = (U) >> 4, g_ = ((U) >> 1) & 7, nt_ = (U) & 1; _Pragma("unroll") for (int k = 0; k < 4; ++k) { const int idx = k * NTHR + tid, r = idx >> 4, c8 = (idx & 15) * 8; \
        ra[k] = *(const u32x4*)(Wsb + (size_t)(g_ * 128 + r) * 128 + c8); rb[k] = *(const u32x4*)(uv + (size_t)(chunk_ * 128 + r) * 4096 + 2048 + g_ * 256 + nt_ * 128 + c8); \
        ru[k] = *(const u32x4*)(uv + (size_t)(chunk_ * 128 + r) * 4096 + g_ * 256 + nt_ * 128 + c8); } \
        { const int ch_ = g_ * 256 + nt_ * 128 + (tid & 15) * 8; rg[0] = *(const f32x4*)(lng + ch_); rg[1] = *(const f32x4*)(lng + ch_ + 4); rbb[0] = *(const f32x4*)(lnb + ch_); rbb[1] = *(const f32x4*)(lnb + ch_ + 4); } \
        if (tid < 128) { const f32x4* sp = (const f32x4*)(statp + (size_t)(chunk_ * 128 + tid) * 64); float S_ = 0.f, Q_ = 0.f; \
            _Pragma("unroll") for (int k = 0; k < 16; ++k) { const f32x4 t_ = sp[k]; S_ += t_.x + t_.z; Q_ += t_.y + t_.w; } \
            rm = S_ * (1.0f / SW); rr = 1.0f / sqrtf(fmaxf(Q_ * (1.0f / SW) - rm * rm, 0.0f) + 1e-6f); } } while (0)
    if (bid < 4096) SG_LOAD(bid);
    for (int u = bid; u < 256 * 16; u += nblk) {
        const int chunk = u >> 4, g = (u >> 1) & 7, nt = u & 1, R0 = chunk * 128;
        if (tid < 128) { st[tid * 2] = rm; st[tid * 2 + 1] = rr; }
        __syncthreads();
#pragma unroll
        for (int k = 0; k < 4; ++k) {
            const int idx = k * NTHR + tid, r = idx >> 4, c16 = (idx & 15) * 16;
            *(LAS u32x4*)(sa + r * 272 + c16) = ra[k];
            const float mean = st[r * 2], rstd = st[r * 2 + 1]; const u32x4 w = rb[k];
            const f32x4 x0 = ((f32x4){bflo(w.x), bfhi(w.x), bflo(w.y), bfhi(w.y)} - mean) * rstd * rg[0] + rbb[0];
            const f32x4 x1 = ((f32x4){bflo(w.z), bfhi(w.z), bflo(w.w), bfhi(w.w)} - mean) * rstd * rg[1] + rbb[1];
            *(LAS u32x4*)(sb + r * 272 + c16) = pack8(x0, x1);
        }
        u32x4 uc[4];
#pragma unroll
        for (int k = 0; k < 4; ++k) uc[k] = ru[k];
        float bsv[4];
#pragma unroll
        for (int m = 0; m < 4; ++m) bsv[m] = bs[g * 128 + wr * 64 + m * 16 + fr];
        __syncthreads();
        if (u + nblk < 4096) SG_LOAD(u + nblk);
        f32x4 acc[4][2];
#pragma unroll
        for (int m = 0; m < 4; ++m)
#pragma unroll
            for (int n = 0; n < 2; ++n) acc[m][n] = (f32x4){0.f, 0.f, 0.f, 0.f};
#pragma unroll
        for (int ks = 0; ks < 4; ++ks) {
            bf16x8 af[4], bfv[2];
#pragma unroll
            for (int m = 0; m < 4; ++m) af[m] = *(LAS bf16x8*)(sa + (wr * 64 + m * 16 + fr) * 272 + ks * 64 + fq * 16);
#pragma unroll
            for (int n = 0; n < 2; ++n) {
                const LAS unsigned short* bp = (const LAS unsigned short*)(sb + (ks * 32 + fq * 8) * 272 + (wc * 32 + n * 16 + fr) * 2);
#pragma unroll
                for (int j = 0; j < 8; ++j) bfv[n][j] = (short)bp[j * 136];
            }
#pragma unroll
            for (int m = 0; m < 4; ++m)
#pragma unroll
                for (int n = 0; n < 2; ++n) acc[m][n] = __builtin_amdgcn_mfma_f32_16x16x32_bf16(bfv[n], af[m], acc[m][n], 0, 0, 0);
        }
        __syncthreads();
#pragma unroll
        for (int m = 0; m < 4; ++m) { const int r = wr * 64 + m * 16 + fr; const float b = bsv[m];
#pragma unroll
            for (int n = 0; n < 2; ++n) { const f32x4 v = acc[m][n]; u32x2 o; o.x = pk2(v.x + b, v.y + b); o.y = pk2(v.z + b, v.w + b); *(LAS u32x2*)(sa + r * 272 + (wc * 32 + n * 16 + fq * 4) * 2) = o; } }
        __syncthreads();
#pragma unroll
        for (int k = 0; k < 4; ++k) {
            const int idx = k * NTHR + tid, r = idx >> 4, c8 = (idx & 15) * 8;
            const u32x4 ov = *(LAS u32x4*)(sa + r * 272 + c8 * 2), uw = uc[k];
            u32x4 z; z.x = pk2(bflo(uw.x) * bflo(ov.x), bfhi(uw.x) * bfhi(ov.x)); z.y = pk2(bflo(uw.y) * bflo(ov.y), bfhi(uw.y) * bfhi(ov.y));
            z.z = pk2(bflo(uw.z) * bflo(ov.z), bfhi(uw.z) * bfhi(ov.z)); z.w = pk2(bflo(uw.w) * bflo(ov.w), bfhi(uw.w) * bfhi(ov.w));
            *(u32x4*)(z1 + (size_t)(R0 + r) * SW + g * 256 + nt * 128 + c8) = z;
        }
        __syncthreads();
    }
#undef SG_LOAD
}

template <class F> struct EpiP8 {
    static constexpr int PERM = 1; F f;
    __device__ __forceinline__ void operator()(const f32x4 (&acc)[2][2][4][2], const pg::Unit& u, int wr, int wc, int fr, int fq) const {
#pragma unroll
        for (int ai = 0; ai < 2; ++ai)
#pragma unroll
            for (int m = 0; m < 4; ++m)
#pragma unroll
                for (int bj = 0; bj < 2; ++bj) f(u, ai * 128 + wr * 64 + m * 16 + fr, bj * 128 + wc * 32 + 8 * fq, acc[ai][bj][m][0], acc[ai][bj][m][1]);
    }
};
template <class F> struct EpiP4 {
    static constexpr int PERM = 0; F f;
    __device__ __forceinline__ void operator()(const f32x4 (&acc)[2][2][4][2], const pg::Unit& u, int wr, int wc, int fr, int fq) const {
#pragma unroll
        for (int ai = 0; ai < 2; ++ai)
#pragma unroll
            for (int m = 0; m < 4; ++m)
#pragma unroll
                for (int bj = 0; bj < 2; ++bj)
#pragma unroll
                    for (int n = 0; n < 2; ++n) f(u, ai * 128 + wr * 64 + m * 16 + fr, bj * 128 + wc * 32 + 16 * n + 4 * fq, acc[ai][bj][m][n]);
    }
};
template <class F> __device__ __forceinline__ EpiP8<F> make_p8(F f) { return EpiP8<F>{f}; }
template <class F> __device__ __forceinline__ EpiP4<F> make_p4(F f) { return EpiP4<F>{f}; }
__device__ __forceinline__ f32x4 gelu4(f32x4 v) { return (f32x4){gelu_t(v.x), gelu_t(v.y), gelu_t(v.z), gelu_t(v.w)}; }

__device__ __forceinline__ void stg_sync() { asm volatile("s_waitcnt lgkmcnt(0)" ::: "memory"); __builtin_amdgcn_s_barrier(); asm volatile("" ::: "memory"); }
template <class RowPtr>
__device__ __forceinline__ void stg_step512(LAS unsigned char* stg, int wr, int wc, int fr, int fq, int o0, int o1, u32x4 p0, u32x4 p1, RowPtr rp) {
    LAS unsigned char* w = stg + (wr * 16 + fr) * 528;
    *(LAS u32x4*)(w + o0) = p0; *(LAS u32x4*)(w + o1) = p1;
    stg_sync();
    const int tid = (wr * 4 + wc) * 64 + fq * 16 + fr;
#pragma unroll
    for (int k = 0; k < 2; ++k) { const int idx = k * 512 + tid, rl = idx >> 5, c = idx & 31; const u32x4 v = *(LAS u32x4*)(stg + rl * 528 + c * 16); *(u32x4*)(rp(rl) + c * 16) = v; }
    stg_sync();
}
template <class RowPtr>
__device__ __forceinline__ void stg_step256(LAS unsigned char* stg, int wr, int wc, int fr, int fq, u32x4 p0, RowPtr rp) {
    *(LAS u32x4*)(stg + (wr * 16 + fr) * 272 + wc * 64 + fq * 16) = p0;
    stg_sync();
    const int tid = (wr * 4 + wc) * 64 + fq * 16 + fr, rl = tid >> 4, c = tid & 15;
    const u32x4 v = *(LAS u32x4*)(stg + rl * 272 + c * 16); *(u32x4*)(rp(rl) + c * 16) = v;
    stg_sync();
}
template <class Xf, class RowPtr> struct EpiStage {
    static constexpr int PERM = 1; LAS unsigned char* stg; Xf xf; RowPtr rowptr;
    __device__ __forceinline__ void operator()(const f32x4 (&acc)[2][2][4][2], const pg::Unit& u, int wr, int wc, int fr, int fq) const {
#pragma unroll
        for (int ai = 0; ai < 2; ++ai)
#pragma unroll
            for (int m = 0; m < 4; ++m) {
                const u32x4 p0 = xf(u, 0, wc, fq, acc[ai][0][m][0], acc[ai][0][m][1]), p1 = xf(u, 1, wc, fq, acc[ai][1][m][0], acc[ai][1][m][1]);
                stg_step512(stg, wr, wc, fr, fq, wc * 64 + fq * 16, 256 + wc * 64 + fq * 16, p0, p1,
                            [&](int rl) { return rowptr(u, ai * 128 + (rl >> 4) * 64 + m * 16 + (rl & 15)); });
            }
    }
};
template <class Xf, class RowPtr> __device__ __forceinline__ EpiStage<Xf, RowPtr> make_stage(LAS unsigned char* stg, Xf xf, RowPtr rp) { return EpiStage<Xf, RowPtr>{stg, xf, rp}; }
template <class Xf, class RowPtr> struct EpiDirect {
    static constexpr int PERM = 2; Xf xf; RowPtr rowptr;
    __device__ __forceinline__ void operator()(const f32x4 (&acc)[2][2][4][2], const pg::Unit& u, int wr, int wc, int fr, int fq) const {
#pragma unroll
        for (int ai = 0; ai < 2; ++ai)
#pragma unroll
            for (int m = 0; m < 4; ++m) {
                unsigned char* rp = rowptr(u, ai * 128 + wr * 64 + m * 16 + fr) + (64 * wc + 8 * fq) * 2;
                *(u32x4*)rp = xf(u, 0, wc, fq, acc[ai][0][m][0], acc[ai][0][m][1]);
                *(u32x4*)(rp + 64) = xf(u, 1, wc, fq, acc[ai][1][m][0], acc[ai][1][m][1]);
            }
    }
};
template <class Xf, class RowPtr> __device__ __forceinline__ EpiDirect<Xf, RowPtr> make_direct(Xf xf, RowPtr rp) { return EpiDirect<Xf, RowPtr>{xf, rp}; }

struct SchedIn0 {
    const char* A; const char* B; int G, c;
    __device__ __forceinline__ bool next(int i, pg::Unit& u) const {
        const int L = i * G + c; if (L >= 1300) return false;
        if (L < 1280) { const int wgid = pg::xcd_remap(L, 1280); u.pm = (wgid / 80) * 8 + (wgid % 80) % 8; u.pn = (wgid % 80) / 8; }
        else { const int q = L - 1280; u.pm = 128 + q / 5; u.pn = 5 + q % 5; }
        u.e = 0; u.rows = nullptr; u.a = A + (size_t)u.pm * 256 * D * 2; u.b = B + (size_t)u.pn * 256 * D * 2; return true;
    }
};
__device__ __forceinline__ void phase_inproj0_pg(const Params& p, LAS unsigned char* lds, int bid, int nblk) {
    unsigned char* ws = p.ws;
    unsigned char* gate0 = ws + B_GATE0; unsigned char* upre = ws + B_UPRE;
    SchedIn0 S{(const char*)(ws + OFF_HX), (const char*)(ws + W_AIN), nblk, bid};
    auto E = make_direct(
        [=](const pg::Unit& u, int bj, int wc, int fq, f32x4 v0, f32x4 v1) { return u.pn < 5 ? pack8(gelu4(v0), gelu4(v1)) : pack8(v0, v1); },
        [=](const pg::Unit& u, int r) { const size_t row = (size_t)u.pm * 256 + r; return u.pn < 5 ? gate0 + (row * RW + u.pn * 256) * 2 : upre + (row * RW + (u.pn - 5) * 256) * 2; });
    pg::gemm<false>(lds, D, D, D, S, E);
    if (bg_idle(1300, nblk, bid)) bg_convert(p, lds, 0, 4);
}
__device__ __forceinline__ void phase_outproj_pg(const Params& p, LAS unsigned char* lds, int bid, int nblk, const bf16_t* Z, int K, const bf16_t* W, const float* modl, unsigned char* dx) {
    pg::SchedPlain S{(const char*)Z, (const char*)W, K, K, 128, 4, 512, nblk, bid};
    auto E = make_direct(
        [=](const pg::Unit& u, int bj, int wc, int fq, f32x4 v0, f32x4 v1) {
            const float* g1 = modl + (size_t)(u.pm >> 5) * 6144 + 2048 + u.pn * 256 + wc * 64 + bj * 32 + 8 * fq;
            return pack8(v0 * *(const f32x4*)g1, v1 * *(const f32x4*)(g1 + 4)); },
        [=](const pg::Unit& u, int r) { return dx + (((size_t)u.pm * 256 + r) * D + u.pn * 256) * 2; });
    pg::gemm<false>(lds, K, K, K, S, E);
}
struct EpiIn1 {
    static constexpr int PERM = 2; unsigned char* uv; float* statp;
    __device__ __forceinline__ void operator()(const f32x4 (&acc)[2][2][4][2], const pg::Unit& u, int wr, int wc, int fr, int fq) const {
#pragma unroll
        for (int ai = 0; ai < 2; ++ai)
#pragma unroll
            for (int m = 0; m < 4; ++m) {
                const size_t row = (size_t)u.pm * 256 + ai * 128 + wr * 64 + m * 16 + fr;
                const u32x4 p0 = pack8(gelu4(acc[ai][0][m][0]), gelu4(acc[ai][0][m][1])), p1 = pack8(gelu4(acc[ai][1][m][0]), gelu4(acc[ai][1][m][1]));
                unsigned char* rp = uv + (row * 4096 + u.pn * 256 + 64 * wc + 8 * fq) * 2;
                *(u32x4*)rp = p0; *(u32x4*)(rp + 64) = p1;
                if (u.pn >= 8) {
                    float s = 0.f, q = 0.f;
#pragma unroll
                    for (int k = 0; k < 8; ++k) { const unsigned w = k < 4 ? p0[k] : p1[k - 4]; const float a = bflo(w), b = bfhi(w); s += a + b; q += a * a + b * b; }
                    s += __shfl_xor(s, 16); q += __shfl_xor(q, 16); s += __shfl_xor(s, 32); q += __shfl_xor(q, 32);
                    if (fq == 0) { float* sp = statp + (row * 32 + (u.pn - 8) * 4 + wc) * 2; sp[0] = s; sp[1] = q; }
                }
            }
    }
};
__device__ __forceinline__ void phase_inproj1_pg(const Params& p, LAS unsigned char* lds, int bid, int nblk) {
    unsigned char* ws = p.ws;
    pg::SchedPlain S{(const char*)(ws + OFF_HX), (const char*)(ws + W_BIN), D, D, 128, 16, 2048, nblk, bid};
    EpiIn1 E{ws + B_UV, (float*)(ws + OFF_STATP)};
    pg::gemm<false>(lds, D, D, D, S, E);
}

constexpr int MOE_T_SS = 131072, MOE_T_S0 = 131072 + 512, MOE_T_E = 131072 + 512 + 4864;
__device__ __forceinline__ int moe_meta(const Params& p, LAS unsigned char* lds) {
    LAS int* ss = (LAS int*)(lds + MOE_T_SS); LAS int* ts0 = (LAS int*)(lds + MOE_T_S0); LAS unsigned char* te = lds + MOE_T_E;
    const int* meta = (const int*)(p.ws + OFF_META);
    const int tid = opq_tid();
    if (tid < 66) ss[tid] = meta[tid];
    __syncthreads();
    const int ntile = ss[65] / TM;
    for (int t = tid; t < ntile; t += NTHR) {
        const int slot0 = t * TM; int e = 0;
        for (int q = 1; q < 65; ++q) e = (ss[q] <= slot0) ? q : e;
        ts0[t] = slot0; te[t] = (unsigned char)e;
    }
    __syncthreads();
    return ntile;
}
template <int NPN, bool GATHER>
struct SchedMoe {
    const char* A; const char* W; const int* tokof; const int* ident; LAS unsigned char* lds; int lda, wrows, wk, nunits, G, c;
    __device__ __forceinline__ bool next(int i, pg::Unit& u) const {
        const int L = i * G + c; if (L >= nunits) return false;
        const int wgid = pg::xcd_remap(L, nunits), tile = wgid / NPN;
        const int slot0 = __builtin_amdgcn_readfirstlane(((LAS int*)(lds + MOE_T_S0))[tile]);
        const int e = __builtin_amdgcn_readfirstlane((int)(lds + MOE_T_E)[tile]);
        const int ss64 = __builtin_amdgcn_readfirstlane(((LAS int*)(lds + MOE_T_SS))[64]);
        u.pm = slot0; u.pn = wgid % NPN; u.e = e;
        u.rows = e < 64 ? tokof + slot0 : ident + (slot0 - ss64);
        u.a = GATHER ? A : A + (size_t)slot0 * lda * 2;
        u.b = W + ((size_t)e * wrows + (size_t)u.pn * 256) * wk * 2;
        return true;
    }
};
__device__ __forceinline__ f32x4 silu4(f32x4 v) { return (f32x4){silu(v.x), silu(v.y), silu(v.z), silu(v.w)}; }
struct EpiUp {
    static constexpr int PERM = 1; unsigned char* hh; const float* wof; LAS unsigned char* stg;
    __device__ __forceinline__ void operator()(const f32x4 (&acc)[2][2][4][2], const pg::Unit& u, int wr, int wc, int fr, int fq) const {
        float w[8];
#pragma unroll
        for (int i = 0; i < 8; ++i) w[i] = u.e < 64 ? wof[u.pm + (i >> 2) * 128 + wr * 64 + (i & 3) * 16 + fr] : 1.0f;
#pragma unroll
        for (int ai = 0; ai < 2; ++ai)
#pragma unroll
            for (int m = 0; m < 4; ++m) {
                const float ww = w[ai * 4 + m];
                const u32x4 p0 = pack8(silu4(acc[ai][0][m][0]) * acc[ai][1][m][0] * ww, silu4(acc[ai][0][m][1]) * acc[ai][1][m][1] * ww);
                LAS unsigned char* sbuf = stg + ((ai * 4 + m) & 1) * 8704;
                *(LAS u32x4*)(sbuf + (wr * 16 + fr) * 272 + wc * 64 + fq * 16) = p0;
                stg_sync();
                { const int tid = (wr * 4 + wc) * 64 + fq * 16 + fr, rl = tid >> 4, c = tid & 15;
                  const u32x4 v = *(LAS u32x4*)(sbuf + rl * 272 + c * 16);
                  *(u32x4*)(hh + ((size_t)(u.pm + ai * 128 + (rl >> 4) * 64 + m * 16 + (rl & 15)) * EFF + u.pn * 128) * 2 + c * 16) = v; }
            }
    }
};
__device__ __forceinline__ void phase_moe_up(const Params& p, LAS unsigned char* lds, int bid, int nblk, int l) {
    unsigned char* ws = p.ws;
    const int ntile = moe_meta(p, lds);
    SchedMoe<2, true> S{(const char*)(ws + OFF_HX), (const char*)(ws + W_GU) + (size_t)l * 65 * 512 * 1024 * 2, (const int*)(ws + OFF_TOKOF), (const int*)(ws + OFF_IDENT), lds, D, 512, D, ntile * 2, nblk, bid};
    EpiUp E{ws + B_HH, (const float*)(ws + OFF_WOF), lds + STG_OFF};
    pg::gemm<true>(lds, D, D, D, S, E);
    if (l == 0 && bg_idle(ntile * 2, nblk, bid)) bg_convert(p, lds, 1, 3);
}
struct EpiDown {
    static constexpr int PERM = 1; LAS unsigned char* stg; unsigned char* Y; unsigned char* ys; int ss64;
    __device__ __forceinline__ void operator()(const f32x4 (&acc)[2][2][4][2], const pg::Unit& u, int wr, int wc, int fr, int fq) const {
        const int tid = (wr * 4 + wc) * 64 + fq * 16 + fr, rl = tid >> 4, c = tid & 15;
        unsigned char* base = u.e < 64 ? Y + ((size_t)u.pm * D + u.pn * 256) : ys + ((size_t)(u.pm - ss64) * D + u.pn * 256);
#pragma unroll
        for (int ai = 0; ai < 2; ++ai)
#pragma unroll
            for (int m = 0; m < 4; ++m) {
                LAS unsigned char* sbuf = stg + ((ai * 4 + m) & 1) * 8704;
                LAS unsigned char* w = sbuf + (wr * 16 + fr) * 272 + wc * 32 + fq * 8;
                *(LAS u32x2*)w = (u32x2){pk4_fp8(acc[ai][0][m][0]), pk4_fp8(acc[ai][0][m][1])};
                *(LAS u32x2*)(w + 128) = (u32x2){pk4_fp8(acc[ai][1][m][0]), pk4_fp8(acc[ai][1][m][1])};
                stg_sync();
                const u32x4 v = *(LAS u32x4*)(sbuf + rl * 272 + c * 16);
                *(u32x4*)(base + (size_t)(ai * 128 + (rl >> 4) * 64 + m * 16 + (rl & 15)) * D + c * 16) = v;
            }
    }
};
__device__ __forceinline__ void phase_moe_down(const Params& p, LAS unsigned char* lds, int bid, int nblk, int l) {
    unsigned char* ws = p.ws;
    const int ntile = moe_meta(p, lds);
    const int ss64 = ((LAS int*)(lds + MOE_T_SS))[64];
    SchedMoe<4, false> S{(const char*)(ws + B_HH), (const char*)(ws + W_DN) + (size_t)l * 65 * 1024 * 256 * 2, nullptr, nullptr, lds, EFF, 1024, EFF, ntile * 4, nblk, bid};
    EpiDown E{lds + STG_OFF, ws + B_YY, ws + B_YS, ss64};
    pg::gemm<false>(lds, EFF, EFF, EFF, S, E);
    if (l == 0 && bg_idle(ntile * 4, nblk, bid)) bg_convert(p, lds, 1, 1);
}

typedef _Float16 h16x2 __attribute__((ext_vector_type(2)));
__device__ __forceinline__ unsigned pkh2(float a, float b) { h16x2 v; v.x = (_Float16)a; v.y = (_Float16)b; return __builtin_bit_cast(unsigned, v); }
__device__ __forceinline__ float h2lo(unsigned w) { return (float)__builtin_bit_cast(h16x2, w).x; }
__device__ __forceinline__ float h2hi(unsigned w) { return (float)__builtin_bit_cast(h16x2, w).y; }
template <int CTRL> __device__ __forceinline__ float dppf(float oldv, float v) {
    return __builtin_bit_cast(float, __builtin_amdgcn_update_dpp(__builtin_bit_cast(int, oldv), __builtin_bit_cast(int, v), CTRL, 0xf, 0xf, false));
}
template <bool SHL> __device__ __forceinline__ void scan16(float& A, float& H) {
#define SC_STEP(N) { const float Ap = dppf<(SHL ? 0x100 : 0x110) + N>(1.0f, A); const float Hp = dppf<(SHL ? 0x100 : 0x110) + N>(0.0f, H); H = A * Hp + H; A = A * Ap; }
    SC_STEP(1) SC_STEP(2) SC_STEP(4) SC_STEP(8)
#undef SC_STEP
}
struct SchedGates {
    const char* U; const char* W; int G, c;
    __device__ __forceinline__ bool next(int i, pg::Unit& u) const {
        const int L = i * G + c; if (L >= 2640) return false;
        const int wgid = pg::xcd_remap(L, 2640), pm = wgid / 20, rem = wgid % 20, h = rem >> 2, q = rem & 3;
        u.pm = pm; u.pn = q; u.e = h; u.rows = nullptr;
        u.a = U + ((size_t)pm * 256 * RW + h * 256) * 2; u.b = W + ((size_t)h * 1024 + q * 256) * 256 * 2; return true;
    }
};
struct EpiGates {
    static constexpr int PERM = 0;
    const bf16_t* uu; const float* rbias; const float* ibias; const float* cdec; unsigned char* ab; LAS unsigned char* stg;
    __device__ __forceinline__ void operator()(const f32x4 (&acc)[2][2][4][2], const pg::Unit& u, int wr, int wc, int fr, int fq) const {
        const int ch0 = u.e * 256 + u.pn * 64 + 16 * wc + 4 * fq;
        const f32x4 rb0 = *(const f32x4*)(rbias + ch0), rb1 = *(const f32x4*)(rbias + RW + ch0), ib0 = *(const f32x4*)(ibias + ch0), ib1 = *(const f32x4*)(ibias + RW + ch0);
        const f32x4 cd0 = *(const f32x4*)(cdec + ch0), cd1 = *(const f32x4*)(cdec + RW + ch0);
        u32x2 uws[8];
#pragma unroll
        for (int i = 0; i < 8; ++i) uws[i] = *(const u32x2*)(uu + ((size_t)u.pm * 256 + (i >> 2) * 128 + wr * 64 + (i & 3) * 16 + fr) * RW + ch0);
#pragma unroll
        for (int ai = 0; ai < 2; ++ai)
#pragma unroll
            for (int m = 0; m < 4; ++m) {
                const int rl = ai * 128 + wr * 64 + m * 16 + fr; const size_t R = (size_t)u.pm * 256 + rl;
                const u32x2 uw = uws[ai * 4 + m];
                const float uv[4] = {bflo(uw.x), bfhi(uw.x), bflo(uw.y), bfhi(uw.y)};
                unsigned o[8];
#pragma unroll
                for (int gi = 0; gi < 4; ++gi) {
                    const f32x4 v = acc[ai][gi >> 1][m][gi & 1];
                    const float r0 = sigm(v.x + rb0[gi]), i0 = sigm(v.y + ib0[gi]), r1 = sigm(v.z + rb1[gi]), i1 = sigm(v.w + ib1[gi]);
                    const float la0 = r0 * cd0[gi], la1 = r1 * cd1[gi];
                    float a0 = __expf(la0), a1 = __expf(la1);
                    float m0 = __builtin_amdgcn_sqrtf(fmaxf(1.0f - a0 * a0, 0.0f)), m1 = __builtin_amdgcn_sqrtf(fmaxf(1.0f - a1 * a1, 0.0f));
                    if (u.pm >= 128) { if (rl == 0) m0 = 1.0f; if (rl == CTXL - 1) m1 = 1.0f; }
                    float h0 = m0 * i0 * uv[gi], h1 = m1 * i1 * uv[gi];
#define GS_STEP(N) asm volatile("s_nop 1\n\tv_fmac_f32_dpp %0, %0, %2 row_shr:" #N " row_mask:0xf bank_mask:0xf\n\tv_fmac_f32_dpp %1, %1, %3 row_shl:" #N " row_mask:0xf bank_mask:0xf\n\tv_mul_f32_dpp %2, %2, %2 row_shr:" #N " row_mask:0xf bank_mask:0xf\n\tv_mul_f32_dpp %3, %3, %3 row_shl:" #N " row_mask:0xf bank_mask:0xf" : "+v"(h0), "+v"(h1), "+v"(a0), "+v"(a1));
                    GS_STEP(1) GS_STEP(2) GS_STEP(4) GS_STEP(8)
#undef GS_STEP
                    o[gi * 2] = pkh2(a0, h0); o[gi * 2 + 1] = pkh2(a1, h1);
                }
                u32x4* dst = (u32x4*)(ab + (R * RW + ch0) * 8);
                dst[0] = (u32x4){o[0], o[1], o[2], o[3]}; dst[1] = (u32x4){o[4], o[5], o[6], o[7]};
            }
    }
};
__device__ __forceinline__ void phase_gates_pg(const Params& p, LAS unsigned char* lds, int bid, int nblk) {
    unsigned char* ws = p.ws;
    SchedGates S{(const char*)(ws + B_UU), (const char*)(ws + W_GATE), nblk, bid};
    EpiGates E{(const bf16_t*)(ws + B_UU), p.in[12], p.in[14], (const float*)(ws + OFF_CDEC), ws + B_AB, lds + STG_OFF};
    pg::gemm<false>(lds, 256, RW, 256, S, E);
    if (bg_idle(2640, nblk, bid)) bg_convert(p, lds, 0, 2);
}
__device__ __forceinline__ void phase_scan_sb(const Params& p, int bid, int nblk) {
    unsigned char* ws = p.ws;
    const unsigned* ab = (const unsigned*)(ws + B_AB); float* sbc = (float*)(ws + OFF_AGG);
    const int gt = bid * NTHR + opq_tid(), ngt = nblk * NTHR;
    for (int i = gt; i < 2 * 132 * RW; i += ngt) {
        const int d = i / (132 * RW), sb = (i / RW) % 132, ch = i % RW;
        float A = 1.0f, H = 0.0f;
#pragma unroll 16
        for (int j = 0; j < 16; ++j) {
            const int k = d == 0 ? j : 15 - j; const size_t row = (size_t)sb * 256 + 16 * k + (d == 0 ? 15 : 0);
            const unsigned w = ab[(row * RW + ch) * 2 + d];
            H = h2lo(w) * H + h2hi(w); A *= h2lo(w);
        }
        sbc[(size_t)i * 2] = A; sbc[(size_t)i * 2 + 1] = H;
    }
}
__device__ __forceinline__ void phase_scan_carry(const Params& p, int bid, int nblk) {
    unsigned char* ws = p.ws;
    const unsigned* ab = (const unsigned*)(ws + B_AB); const float* sbc = (const float*)(ws + OFF_AGG); float* car = (float*)(ws + B_CAR);
    const int gt = bid * NTHR + opq_tid(), ngt = nblk * NTHR;
    for (int i = gt; i < 2 * 128 * RW; i += ngt) {
        const int d = i / (128 * RW), sb = (i / RW) % 128, ch = i % RW, b = sb >> 5, sl = sb & 31;
        float c = sbc[((size_t)(d * 132 + 128 + b) * RW + ch) * 2 + 1];
        const int nprev = d == 0 ? sl : 31 - sl;
        for (int j = 0; j < nprev; ++j) {
            const int s2 = d == 0 ? b * 32 + j : b * 32 + 31 - j;
            const float* q = sbc + ((size_t)(d * 132 + s2) * RW + ch) * 2;
            c = q[0] * c + q[1];
        }
#pragma unroll 16
        for (int j = 0; j < 16; ++j) {
            const int k = d == 0 ? j : 15 - j; const size_t row = (size_t)sb * 256 + 16 * k + (d == 0 ? 15 : 0);
            car[((size_t)d * 2048 + sb * 16 + k) * RW + ch] = c;
            const unsigned w = ab[(row * RW + ch) * 2 + d];
            c = h2lo(w) * c + h2hi(w);
        }
    }
}
__device__ __forceinline__ void phase_scan_apply(const Params& p, int bid, int nblk) {
    unsigned char* ws = p.ws;
    const unsigned char* ab = ws + B_AB; const float* car = (const float*)(ws + B_CAR); const bf16_t* gate0 = (const bf16_t*)(ws + B_GATE0); bf16_t* z0 = (bf16_t*)(ws + B_Z0);
    const int gt = bid * NTHR + opq_tid(), ngt = nblk * NTHR;
    for (int item = gt; item < 2048 * 320; item += ngt) {
        const int blk = item / 320, c4 = (item % 320) * 4;
        const f32x4 cf = *(const f32x4*)(car + (size_t)blk * RW + c4), cb = *(const f32x4*)(car + ((size_t)2048 + blk) * RW + c4);
#pragma unroll 8
        for (int r = 0; r < 16; ++r) {
            const size_t e = ((size_t)blk * 16 + r) * RW + c4;
            const u32x4 w0 = *(const u32x4*)(ab + e * 8), w1 = *(const u32x4*)(ab + e * 8 + 16);
            const u32x2 g = *(const u32x2*)(gate0 + e);
            const float y0 = (h2hi(w0.x) + h2lo(w0.x) * cf.x) + (h2hi(w0.y) + h2lo(w0.y) * cb.x);
            const float y1 = (h2hi(w0.z) + h2lo(w0.z) * cf.y) + (h2hi(w0.w) + h2lo(w0.w) * cb.y);
            const float y2 = (h2hi(w1.x) + h2lo(w1.x) * cf.z) + (h2hi(w1.y) + h2lo(w1.y) * cb.z);
            const float y3 = (h2hi(w1.z) + h2lo(w1.z) * cf.w) + (h2hi(w1.w) + h2lo(w1.w) * cb.w);
            u32x2 o; o.x = pk2(bflo(g.x) * y0, bfhi(g.x) * y1); o.y = pk2(bflo(g.y) * y2, bfhi(g.y) * y3);
            *(u32x2*)(z0 + e) = o;
        }
    }
}

#define XB_TMO      128
#define XB_XCNT(j)  (256  + 64 * (j))
#define XB_XSUB(j)  (1280 + 64 * (j))
#define XB_XGEN(j)  (2304 + 64 * (j))
#define XB_TOP      3328
#define XB_TOPGEN   3392
#define XCD_BAR_WORDS 3456
#define XB_SPIN_CAP (1u << 18)
__device__ __forceinline__ unsigned xb_ld(unsigned* p)              { return __hip_atomic_load(p, __ATOMIC_RELAXED, __HIP_MEMORY_SCOPE_AGENT); }
__device__ __forceinline__ unsigned xb_add(unsigned* p, unsigned v) { return __hip_atomic_fetch_add(p, v, __ATOMIC_RELAXED, __HIP_MEMORY_SCOPE_AGENT); }
__device__ __forceinline__ unsigned xb_xcc_id() { return (unsigned)__builtin_amdgcn_s_getreg((3 << 11) | 20) & 0xFu; }
#define XB_SPIN(cond, bar) do { unsigned _sp = 0; while (cond) { __builtin_amdgcn_s_sleep(1); \
    if ((++_sp & 255u) == 0u) { if (xb_ld(&(bar)[XB_TMO])) break; if (_sp > XB_SPIN_CAP) { atomicAdd(&(bar)[XB_TMO], 1u); break; } } } } while (0)
struct XcdBarrier { unsigned* bar; unsigned x; volatile LAS unsigned* st; };
__device__ __forceinline__ XcdBarrier xcd_barrier_post(unsigned* bar, volatile LAS unsigned* st) {
    XcdBarrier b; b.bar = bar; b.x = xb_xcc_id(); b.st = st;
    if (threadIdx.x == 0) (void)xb_add(&bar[XB_XCNT(b.x)], 1u);
    return b;
}
__device__ __forceinline__ void xcd_barrier_complete(unsigned* bar, unsigned x, unsigned& nloc, unsigned& nx) {
    const unsigned G = gridDim.x * gridDim.y * gridDim.z;
    unsigned sum, cnt, mine, sp = 0u;
    for (;;) {
        sum = 0u; cnt = 0u; mine = 0u;
#pragma unroll
        for (unsigned j = 0; j < 16; ++j) { const unsigned c = xb_ld(&bar[XB_XCNT(j)]); sum += c; cnt += (c > 0u) ? 1u : 0u; mine = (j == x) ? c : mine; }
        if (sum == G) break;
        __builtin_amdgcn_s_sleep(1);
        if ((++sp & 255u) == 0u) { if (xb_ld(&bar[XB_TMO])) break; if (sp > XB_SPIN_CAP) { atomicAdd(&bar[XB_TMO], 1u); break; } }
    }
    nloc = mine > 0u ? mine : 1u; nx = cnt > 0u ? cnt : 1u;
}
__device__ __forceinline__ void xcd_barrier(const XcdBarrier& b) {
    asm volatile("s_waitcnt vmcnt(0)" ::: "memory");
    __syncthreads();
    if (threadIdx.x == 0) {
        unsigned* bar = b.bar;
        __builtin_amdgcn_s_waitcnt(0);
        unsigned nloc = b.st[0], nx = b.st[1];
        if (nloc == 0u) { xcd_barrier_complete(bar, b.x, nloc, nx); b.st[0] = nloc; b.st[1] = nx; }
        const unsigned old = xb_add(&bar[XB_XSUB(b.x)], 1u);
        const unsigned gen = old / nloc;
        if (old + 1u == (gen + 1u) * nloc) {
            __builtin_amdgcn_fence(__ATOMIC_RELEASE, "agent");
            asm volatile("s_waitcnt vmcnt(0)" ::: "memory");
            const unsigned og = xb_add(&bar[XB_TOP], 1u);
            const unsigned tg = og / nx;
            if (og + 1u == (tg + 1u) * nx) xb_add(&bar[XB_TOPGEN], 1u);
            else XB_SPIN(xb_ld(&bar[XB_TOPGEN]) == tg, bar);
            __builtin_amdgcn_fence(__ATOMIC_ACQUIRE, "agent");
            xb_add(&bar[XB_XGEN(b.x)], 1u);
            asm volatile("s_waitcnt vmcnt(0)" ::: "memory");
        } else {
            XB_SPIN(xb_ld(&bar[XB_XGEN(b.x)]) == gen, bar);
            __builtin_amdgcn_fence(__ATOMIC_ACQUIRE, "agent");
            asm volatile("s_waitcnt vmcnt(0)" ::: "memory");
        }
    }
    __syncthreads();
}

#ifndef PROBE_G
#define PROBE_G 0
#endif
#define PH(g, call) do { unsigned long long _t0 = 0; if (PROBE_G == (g)) _t0 = __builtin_amdgcn_s_memrealtime(); call; xcd_barrier(xb); if (PROBE_G == (g)) tacc += __builtin_amdgcn_s_memrealtime() - _t0; } while (0)
__global__ void __launch_bounds__(NTHR) mk_fwd(Params p) {
    extern __shared__ __attribute__((aligned(16))) unsigned char lds_raw[];
    LAS unsigned char* lds = (LAS unsigned char*)lds_raw;
    cg::grid_group grid = cg::this_grid();
    const int bid = blockIdx.x, nblk = gridDim.x;
    unsigned char* ws = p.ws;
    const float* mod0 = (const float*)(ws + OFF_MOD); const float* mod1 = mod0 + 5 * 6144;
    unsigned long long tacc = 0;
    { volatile LAS unsigned* st0 = (volatile LAS unsigned*)(lds + LDS_BYTES - 16); if (threadIdx.x < 4) st0[threadIdx.x] = 0u; }
    __syncthreads();
    XcdBarrier xb = xcd_barrier_post((unsigned*)ws, (volatile LAS unsigned*)(lds + LDS_BYTES - 16));
    { unsigned long long _t0 = 0; if (PROBE_G == 1) _t0 = __builtin_amdgcn_s_memrealtime();
      phase0(p, lds, bid, nblk);
      grid.sync();
      if (PROBE_G == 1) tacc += __builtin_amdgcn_s_memrealtime() - _t0; }
    PH(2, (row_phase<0, false, false>(p, bid, nblk, p.in[6], mod0, 0, 1024, nullptr, nullptr)));
    PH(6, phase_inproj0_pg(p, lds, bid, nblk));
    PH(12, phase_conv(p, bid, nblk));
    PH(7, phase_gates_pg(p, lds, bid, nblk));
    PH(3, phase_scan_sb(p, bid, nblk));
    PH(3, phase_scan_carry(p, bid, nblk));
    PH(13, phase_scan_apply(p, bid, nblk));
    PH(6, phase_outproj_pg(p, lds, bid, nblk, (const bf16_t*)(ws + B_Z0), RW, (const bf16_t*)(ws + W_AOUT), mod0, ws + B_DX0));
    PH(4, phase_normroute(p, lds, bid, nblk, 0, p.in[7], mod0, (const bf16_t*)(ws + B_DX0)));
    PH(10, phase_scatter(p, lds, bid, nblk, 0));
    PH(8, phase_moe_up(p, lds, bid, nblk, 0));
    PH(9, phase_moe_down(p, lds, bid, nblk, 0));
    PH(2, (row_phase<2, false, false>(p, bid, nblk, p.in[6] + D, mod1, 0, 1024, mod0, nullptr)));
    PH(6, phase_inproj1_pg(p, lds, bid, nblk));
    PH(11, phase_sgu(p, lds, bid, nblk));
    PH(6, phase_outproj_pg(p, lds, bid, nblk, (const bf16_t*)(ws + B_Z1), SW, (const bf16_t*)(ws + W_BOUT), mod1, ws + B_DX1));
    PH(4, phase_normroute(p, lds, bid, nblk, 1, p.in[7] + D, mod1, (const bf16_t*)(ws + B_DX1)));
    PH(10, phase_scatter(p, lds, bid, nblk, 1));
    PH(8, phase_moe_up(p, lds, bid, nblk, 1));
    PH(9, phase_moe_down(p, lds, bid, nblk, 1));
    { unsigned long long _t0 = 0; if (PROBE_G == 2) _t0 = __builtin_amdgcn_s_memrealtime();
      row_phase<2, false, true>(p, bid, nblk, p.in[29], mod1, 0, 0, mod1, nullptr);
      if (PROBE_G == 2) tacc += __builtin_amdgcn_s_memrealtime() - _t0; }
    if (PROBE_G != 0 && bid == 0 && threadIdx.x == 0) {
        const unsigned long long t0 = __builtin_amdgcn_s_memrealtime();
        while (__builtin_amdgcn_s_memrealtime() - t0 < 3ull * tacc) __builtin_amdgcn_s_sleep(20);
    }
}

extern "C" void kernel_launch(void* const* d_in, const int* in_sizes, int n_in, void* d_out, int out_size, void* d_ws, size_t ws_size, hipStream_t stream) {
    static int grid_blocks = 0;
    if (grid_blocks == 0) {
        if (n_in != 30 || out_size != NTOK * D || ws_size < WS_NEED) { fprintf(stderr, "kernel_launch: unexpected shapes (n_in %d out %d ws %zu need %zu)\n", n_in, out_size, ws_size, (size_t)WS_NEED); grid_blocks = -1; return; }
        int dev = 0, cus = 0, per_cu = 0;
        (void)hipGetDevice(&dev);
        (void)hipDeviceGetAttribute(&cus, hipDeviceAttributeMultiprocessorCount, dev);
        if (hipFuncSetAttribute((const void*)mk_fwd, hipFuncAttributeMaxDynamicSharedMemorySize, LDS_BYTES) != hipSuccess) { fprintf(stderr, "kernel_launch: hipFuncSetAttribute failed\n"); grid_blocks = -1; return; }
        (void)hipOccupancyMaxActiveBlocksPerMultiprocessor(&per_cu, mk_fwd, NTHR, LDS_BYTES);
        if (per_cu < 1) per_cu = 1;
        if (per_cu > 2) per_cu = 2;
        grid_blocks = cus * per_cu;
        fprintf(stderr, "kernel_launch: cus %d per_cu %d grid %d\n", cus, per_cu, grid_blocks);
    }
    if (grid_blocks < 0) return;
    if (hipMemsetAsync(d_ws, 0, 65536, stream) != hipSuccess) { fprintf(stderr, "kernel_launch: memset failed\n"); return; }
    Params p{};
    for (int i = 0; i < 30; ++i) p.in[i] = (const float*)d_in[i];
    p.out = (float*)d_out; p.ws = (unsigned char*)d_ws;
    void* args[] = {&p};
    hipError_t e = hipLaunchCooperativeKernel((void*)mk_fwd, dim3(grid_blocks), dim3(NTHR), args, LDS_BYTES, stream);
    if (e != hipSuccess) fprintf(stderr, "cooperative launch failed: %s (grid %d)\n", hipGetErrorString(e), grid_blocks);
}
```

```cpp
#include <hip/hip_runtime.h>
#include <hip/hip_cooperative_groups.h>
#include <cstdio>
#include <cstdint>
namespace cg = cooperative_groups;

#define LAS __attribute__((address_space(3)))
typedef unsigned short bf16_t;
typedef short bf16x8 __attribute__((ext_vector_type(8)));
typedef float f32x4 __attribute__((ext_vector_type(4)));
typedef unsigned u32x4 __attribute__((ext_vector_type(4)));
typedef unsigned u32x2 __attribute__((ext_vector_type(2)));

constexpr int D = 1024, NB = 4, SEQ = 8192, NTOK = NB * SEQ, CTXL = 256, NCTX = NB * CTXL, NROW = NTOK + NCTX;
constexpr int RW = 1280;
constexpr int SW = 2048;
constexpr int NE = 64, TOPK = 8, EFF = 256;
constexpr int TM = 256;
constexpr int NSLOT = 278528;
constexpr int NTHR = 512;
constexpr int STG_OFF = 139264;
constexpr int LDS_BYTES = 157248;

constexpr size_t MiB = (size_t)1 << 20;
constexpr size_t OFF_MOD = 1 * MiB;
constexpr size_t OFF_POS = OFF_MOD + 262144;
constexpr size_t OFF_CDEC = OFF_POS + 262144;
constexpr size_t OFF_CNT = OFF_CDEC + 16384;
constexpr size_t OFF_META = OFF_CNT + 65536;
constexpr size_t OFF_IDENT = OFF_META + 4096 + 45056;
constexpr size_t OFF_AGG = 2 * MiB;
constexpr size_t OFF_CARRY = 8 * MiB;
constexpr size_t OFF_EIDX = 11 * MiB;
constexpr size_t OFF_GATEW = 12 * MiB;
constexpr size_t OFF_SLOTOF = 13 * MiB;
constexpr size_t OFF_TOKOF = 14 * MiB;
constexpr size_t OFF_WOF = 16 * MiB;
constexpr size_t OFF_CNTW2 = 17 * MiB + 512 * 1024;
constexpr size_t OFF_W = 18 * MiB;
constexpr size_t W_AIN = OFF_W;
constexpr size_t W_AOUT = W_AIN + (size_t)2560 * 1024 * 2;
constexpr size_t W_GATE = W_AOUT + (size_t)1024 * 1280 * 2;
constexpr size_t W_BIN = W_GATE + (size_t)5 * 1024 * 256 * 2;
constexpr size_t W_BOUT = W_BIN + (size_t)4096 * 1024 * 2;
constexpr size_t W_S = W_BOUT + (size_t)1024 * 2048 * 2;
constexpr size_t W_RT = W_S + (size_t)8 * 128 * 128 * 2;
constexpr size_t W_GU = W_RT + (size_t)2 * 128 * 3072 * 2;
constexpr size_t W_DN = W_GU + (size_t)2 * 65 * 512 * 1024 * 2;
constexpr size_t W_END = W_DN + (size_t)2 * 65 * 1024 * 256 * 2;
constexpr size_t OFF_HX = 237 * MiB;
constexpr size_t OFF_BIG = OFF_HX + 66 * MiB;
constexpr size_t OFF_STATP = OFF_BIG + 320 * MiB;
constexpr size_t B_GATE0 = OFF_BIG;
constexpr size_t B_UPRE = OFF_BIG + 80 * MiB;
constexpr size_t B_UU = OFF_BIG + 163 * MiB;
constexpr size_t B_Z0 = OFF_BIG + 246 * MiB;
constexpr size_t B_AB = OFF_BIG + 326 * MiB;
constexpr size_t B_CAR = OFF_BIG + 80 * MiB;
constexpr size_t B_DX0 = OFF_BIG + 326 * MiB;
constexpr size_t B_DX1 = OFF_BIG + 256 * MiB;
constexpr size_t B_UV = OFF_BIG;
constexpr size_t B_VNT = OFF_BIG + 256 * MiB;
constexpr size_t B_Z1 = OFF_BIG + 384 * MiB;
constexpr size_t B_HLO = OFF_BIG;
constexpr size_t B_HH = OFF_BIG;
constexpr size_t B_YY = OFF_BIG + 160 * MiB;
constexpr size_t B_YS = OFF_BIG + 448 * MiB;
constexpr size_t B_XR = OFF_BIG + 656 * MiB;
constexpr size_t WS_NEED = OFF_BIG + 720 * MiB;
static_assert(W_END <= OFF_HX, "weights overflow");
static_assert((size_t)(NSLOT + NTOK) * 256 * 2 <= 160 * MiB, "H overflow");
static_assert((size_t)NSLOT * 1024 * 2 <= 544 * MiB, "Y overflow");
static_assert(WS_NEED <= 1024 * MiB, "ws overflow");
constexpr long LO_DELTA = (long)((B_HLO - OFF_HX) / 2);

__device__ __forceinline__ unsigned f2bf(float f) { unsigned u = __builtin_bit_cast(unsigned, f); return (u + 0x7fffu + ((u >> 16) & 1u)) >> 16; }
__device__ __forceinline__ unsigned pk2(float lo, float hi) { unsigned r; asm volatile("v_cvt_pk_bf16_f32 %0, %1, %2" : "=v"(r) : "v"(lo), "v"(hi)); return r; }
__device__ __forceinline__ float bf2f(unsigned b) { return __builtin_bit_cast(float, b << 16); }
__device__ __forceinline__ float bflo(unsigned w) { return __builtin_bit_cast(float, w << 16); }
__device__ __forceinline__ float bfhi(unsigned w) { return __builtin_bit_cast(float, w & 0xffff0000u); }
__device__ __forceinline__ float sigm(float x) { return __builtin_amdgcn_rcpf(1.0f + __expf(-x)); }
__device__ __forceinline__ float silu(float x) { return x * __builtin_amdgcn_rcpf(1.0f + __expf(-x)); }
__device__ __forceinline__ float gelu_t(float x) { const float y = 1.5957691216057308f * (x + 0.044715f * x * x * x); return x * __builtin_amdgcn_rcpf(1.0f + __expf(-y)); }
template <int CTRL> __device__ __forceinline__ float dpp_mv(float v) { return __builtin_bit_cast(float, __builtin_amdgcn_update_dpp(__builtin_bit_cast(int, v), __builtin_bit_cast(int, v), CTRL, 0xf, 0xf, false)); }
template <int CTRL> __device__ __forceinline__ int dpp_mvi(int v) { return __builtin_amdgcn_update_dpp(v, v, CTRL, 0xf, 0xf, false); }
__device__ __forceinline__ float wave_sum(float v) {
    v += dpp_mv<0xB1>(v); v += dpp_mv<0x4E>(v); v += dpp_mv<0x141>(v); v += dpp_mv<0x140>(v);
    const int b = __builtin_bit_cast(int, v);
    return (__builtin_bit_cast(float, __builtin_amdgcn_readlane(b, 0)) + __builtin_bit_cast(float, __builtin_amdgcn_readlane(b, 16)))
         + (__builtin_bit_cast(float, __builtin_amdgcn_readlane(b, 32)) + __builtin_bit_cast(float, __builtin_amdgcn_readlane(b, 48)));
}
__device__ __forceinline__ float max8(float v) { v = fmaxf(v, dpp_mv<0xB1>(v)); v = fmaxf(v, dpp_mv<0x4E>(v)); return fmaxf(v, dpp_mv<0x141>(v)); }
__device__ __forceinline__ int min8(int v) { v = min(v, dpp_mvi<0xB1>(v)); v = min(v, dpp_mvi<0x4E>(v)); return min(v, dpp_mvi<0x141>(v)); }

__device__ __forceinline__ int opq_tid() { int t = threadIdx.x; asm volatile("" : "+v"(t)); return t; }
__device__ __forceinline__ u32x4 pack8(f32x4 a, f32x4 b) { u32x4 w; w.x = pk2(a.x, a.y); w.y = pk2(a.z, a.w); w.z = pk2(b.x, b.y); w.w = pk2(b.z, b.w); return w; }
__device__ __forceinline__ unsigned pk4_fp8(f32x4 v) { int w = 0; w = __builtin_amdgcn_cvt_pk_fp8_f32(v.x, v.y, w, false); w = __builtin_amdgcn_cvt_pk_fp8_f32(v.z, v.w, w, true); return (unsigned)w; }
__device__ __forceinline__ f32x4 up4_fp8(unsigned w) { return (f32x4){__builtin_amdgcn_cvt_f32_fp8((int)w, 0), __builtin_amdgcn_cvt_f32_fp8((int)w, 1), __builtin_amdgcn_cvt_f32_fp8((int)w, 2), __builtin_amdgcn_cvt_f32_fp8((int)w, 3)}; }
struct Params { const float* in[30]; float* out; unsigned char* ws; };

struct KDef { __device__ __forceinline__ long operator()(int kt) const { return (long)kt * 32; } };

template <class KOffA, class Epi>
__device__ __forceinline__ void gemm_tile(const bf16_t* arow, const bf16_t* brow, int nk, KOffA koffa, Epi epi, LAS unsigned char* lds) {
    const int tid = opq_tid(), lane = tid & 63, wid = tid >> 6, wr = wid >> 2, wc = wid & 3, fr = lane & 15, fq = lane >> 4;
    const int sw = (tid >> 2) * 80 + (tid & 3) * 16;
    f32x4 acc[4][2];
#pragma unroll
    for (int m = 0; m < 4; ++m)
#pragma unroll
        for (int n = 0; n < 2; ++n) acc[m][n] = (f32x4){0.f, 0.f, 0.f, 0.f};
    u32x4 ra = *(const u32x4*)(arow + koffa(0));
    u32x4 rb = *(const u32x4*)(brow);
    const int aoff = (wr * 64 + fr) * 80 + fq * 16, boff = 10240 + (wc * 32 + fr) * 80 + fq * 16;
    for (int kt = 0; kt < nk; ++kt) {
        LAS unsigned char* buf = lds + (kt & 1) * 20480;
        *(LAS u32x4*)(buf + sw) = ra;
        *(LAS u32x4*)(buf + 10240 + sw) = rb;
        __syncthreads();
        if (kt + 1 < nk) { ra = *(const u32x4*)(arow + koffa(kt + 1)); rb = *(const u32x4*)(brow + (long)(kt + 1) * 32); }
        bf16x8 af[4], bfv[2];
#pragma unroll
        for (int m = 0; m < 4; ++m) af[m] = *(LAS bf16x8*)(buf + aoff + m * 1280);
#pragma unroll
        for (int n = 0; n < 2; ++n) bfv[n] = *(LAS bf16x8*)(buf + boff + n * 1280);
#pragma unroll
        for (int m = 0; m < 4; ++m)
#pragma unroll
            for (int n = 0; n < 2; ++n) acc[m][n] = __builtin_amdgcn_mfma_f32_16x16x32_bf16(bfv[n], af[m], acc[m][n], 0, 0, 0);
    }
    __syncthreads();
#pragma unroll
    for (int m = 0; m < 4; ++m)
#pragma unroll
        for (int n = 0; n < 2; ++n) epi(wr * 64 + m * 16 + fr, wc * 32 + n * 16 + fq * 4, acc[m][n]);
}

namespace pg {
constexpr int BM = 256, BK = 64, HALF = 128, HTB = HALF * BK * 2, STAGE_BYTES = 8 * HTB;
__device__ __forceinline__ int lds_byte(int r, int c) { const int st = (r >> 4) * 2 + (c >> 5), rr = r & 15, cc = c & 31, ob = rr * 64 + cc * 2; return st * 1024 + (ob ^ (((ob >> 9) & 1) << 5)); }
__device__ __forceinline__ void stage_rc(int b, int& R, int& C) { const int st = b / 1024, sb = b % 1024, swz = sb ^ (((sb >> 9) & 1) << 5); R = (st >> 1) * 16 + swz / 64; C = (st & 1) * 32 + (swz % 64) / 2; }
__device__ __forceinline__ int perm32(int rho) { const int n = rho >> 4, i = rho & 15; return 8 * (i >> 2) + 4 * n + (i & 3); }
__device__ __forceinline__ int xcd_remap(int L, int nwg) { const int q = nwg / 8, r = nwg % 8, xcd = L % 8, off = L / 8; return (xcd < r ? xcd * (q + 1) : r * (q + 1) + (xcd - r) * q) + off; }

struct Unit { const char* a; const char* b; const int* rows; int pm, pn, e; };

template <bool GATHER, class Sched, class Epi>
__device__ __forceinline__ void gemm(LAS unsigned char* lds, const int K, const int lda, const int ldb, const Sched& S, const Epi& E) {
    const int tid = opq_tid(), wid = __builtin_amdgcn_readfirstlane(tid >> 6), lane = tid & 63, wr = wid >> 2, wc = wid & 3, fr = lane & 15, fq = lane >> 4;
    const int nt = K / BK;
    int RA[2]; unsigned ca2[2], voffB[2][2];
#pragma unroll
    for (int i = 0; i < 2; ++i) { int R, C; stage_rc(tid * 16 + i * 8192, R, C);
        RA[i] = R; ca2[i] = (unsigned)C * 2u;
#pragma unroll
        for (int h = 0; h < 2; ++h) {
            const int Rb = (int)Epi::PERM == 2 ? 64 * (R >> 5) + 32 * h + perm32(R & 31) : HALF * h + ((int)Epi::PERM == 1 ? ((R & ~31) + perm32(R & 31)) : R);
            voffB[h][i] = (unsigned)(Rb * ldb + C) * 2u; } }
    const unsigned lda2 = (unsigned)lda * 2u;
    const size_t kstep = (size_t)(BK * 2);
    const unsigned ldsw = (unsigned)wid * 1024u;
    const int aoff = lds_byte(wr * 64 + fr, fq * 8), boff = lds_byte(wc * 32 + fr, fq * 8);
    unsigned vc[2][2], vn[2][2];
#define PG_SA(b, h) (((b) * 2 + (h)) * HTB)
#define PG_SB(b, h) ((4 + (b) * 2 + (h)) * HTB)
#define PG_GL(bufoff, gp0, gp1) do { \
        __builtin_amdgcn_global_load_lds((const unsigned*)(gp0), (LAS unsigned*)(lds + (bufoff) + ldsw), 16, 0, 0); \
        __builtin_amdgcn_global_load_lds((const unsigned*)(gp1), (LAS unsigned*)(lds + (bufoff) + ldsw + 8192), 16, 0, 0); } while (0)
#define PG_STB(bufoff, gbase, h) PG_GL(bufoff, (const char*)(gbase) + voffB[h][0], (const char*)(gbase) + voffB[h][1])
#define PG_STA(bufoff, gbase, V, h) PG_GL(bufoff, (const char*)(gbase) + V[h][0], (const char*)(gbase) + V[h][1])
#define PG_LDA(dst, b, h) do { _Pragma("unroll") for (int m = 0; m < 4; ++m) _Pragma("unroll") for (int k = 0; k < 2; ++k) dst[m][k] = *(const LAS bf16x8*)(lds + PG_SA(b, h) + aoff + m * 2048 + k * 1024); } while (0)
#define PG_LDB(dst, b, h) do { _Pragma("unroll") for (int n = 0; n < 2; ++n) _Pragma("unroll") for (int k = 0; k < 2; ++k) dst[n][k] = *(const LAS bf16x8*)(lds + PG_SB(b, h) + boff + n * 2048 + k * 1024); } while (0)
#define PG_MMA(ai, bj, At, Bt) do { __builtin_amdgcn_s_setprio(1); _Pragma("unroll") for (int m = 0; m < 4; ++m) _Pragma("unroll") for (int n = 0; n < 2; ++n) _Pragma("unroll") for (int k = 0; k < 2; ++k) \
        acc[ai][bj][m][n] = __builtin_amdgcn_mfma_f32_16x16x32_bf16(Bt[n][k], At[m][k], acc[ai][bj][m][n], 0, 0, 0); __builtin_amdgcn_s_setprio(0); } while (0)
#define PG_WAIT_V(n) asm volatile("s_waitcnt vmcnt(" #n ")" ::: "memory")
#define PG_WAIT_L(n) asm volatile("s_waitcnt lgkmcnt(" #n ")" ::: "memory")
#define PG_BAR __builtin_amdgcn_s_barrier()
#define PG_SCHED __builtin_amdgcn_sched_barrier(0)
#define PG_SETOFF(V, U) do { _Pragma("unroll") for (int h = 0; h < 2; ++h) _Pragma("unroll") for (int i = 0; i < 2; ++i) \
        V[h][i] = (GATHER ? (unsigned)(U).rows[RA[i] + HALF * h] : (unsigned)(RA[i] + HALF * h)) * lda2 + ca2[i]; } while (0)
    Unit cur, nxt; int ui = 0;
    if (!S.next(0, cur)) return;
    PG_SETOFF(vc, cur);
    f32x4 acc[2][2][4][2];
#pragma unroll
    for (int a = 0; a < 2; ++a)
#pragma unroll
        for (int b = 0; b < 2; ++b)
#pragma unroll
            for (int m = 0; m < 4; ++m)
#pragma unroll
                for (int n = 0; n < 2; ++n) acc[a][b][m][n] = (f32x4){0.f, 0.f, 0.f, 0.f};
    bf16x8 At[4][2], B0[2][2], B1[2][2];
    const char* cA = cur.a; const char* cB = cur.b;
    PG_STB(PG_SB(0, 0), cB, 0); PG_STB(PG_SB(0, 1), cB, 1); PG_STA(PG_SA(0, 0), cA, vc, 0); PG_STA(PG_SA(0, 1), cA, vc, 1);
    if (wr == 1) PG_BAR;
    PG_WAIT_V(2); PG_BAR;
    PG_STB(PG_SB(1, 0), cB + kstep, 0); PG_STA(PG_SA(1, 0), cA + kstep, vc, 0); PG_STB(PG_SB(1, 1), cB + kstep, 1);
    PG_WAIT_V(6); PG_BAR;
#define PG_PAIR(a1, a2, b2, a3, b3, SWAP) do { \
        PG_LDB(B0, 0, 0); PG_LDB(B1, 0, 1); PG_SCHED; PG_LDA(At, 0, 0); PG_STA(PG_SA(1, 1), a1, vc, 1); \
        if (GATHER) { if (SWAP) { vc[0][0] = vn[0][0]; vc[0][1] = vn[0][1]; vc[1][0] = vn[1][0]; vc[1][1] = vn[1][1]; } } \
        PG_WAIT_V(8); PG_WAIT_L(0); PG_BAR; PG_MMA(0, 0, At, B0); PG_MMA(0, 1, At, B1); PG_BAR; PG_SCHED; \
        PG_LDA(At, 0, 1); PG_STB(PG_SB(0, 0), b2, 0); PG_STB(PG_SB(0, 1), b2, 1); PG_STA(PG_SA(0, 0), a2, vc, 0); \
        PG_WAIT_V(8); PG_WAIT_L(0); PG_BAR; PG_MMA(1, 0, At, B0); PG_MMA(1, 1, At, B1); PG_BAR; PG_SCHED; \
        PG_LDB(B0, 1, 0); PG_LDB(B1, 1, 1); PG_SCHED; PG_LDA(At, 1, 0); PG_STA(PG_SA(0, 1), a2, vc, 1); \
        PG_WAIT_V(8); PG_WAIT_L(0); PG_BAR; PG_MMA(0, 0, At, B0); PG_MMA(0, 1, At, B1); PG_BAR; PG_SCHED; \
        PG_LDA(At, 1, 1); PG_STB(PG_SB(1, 0), b3, 0); PG_STB(PG_SB(1, 1), b3, 1); PG_STA(PG_SA(1, 0), a3, vc, 0); \
        PG_WAIT_V(8); PG_WAIT_L(0); PG_BAR; PG_MMA(1, 0, At, B0); PG_MMA(1, 1, At, B1); PG_BAR; PG_SCHED; } while (0)
    for (;;) {
        const bool has_next = S.next(ui + 1, nxt);
        const char* nA = has_next ? nxt.a : cA; const char* nB = has_next ? nxt.b : cB;
        if (GATHER) { if (has_next) { PG_SETOFF(vn, nxt); } }
#pragma nounroll
        for (int t = 0; t < nt; t += 2) {
            const bool last = (t == nt - 2);
            const char* a1 = cA + (size_t)(t + 1) * kstep;
            const char* a2 = last ? nA : cA + (size_t)(t + 2) * kstep; const char* b2 = last ? nB : cB + (size_t)(t + 2) * kstep;
            const char* a3 = a2 + kstep; const char* b3 = b2 + kstep;
            PG_PAIR(a1, a2, b2, a3, b3, (last && has_next));
        }
        if (wr == 0) PG_BAR;
        { int efr = fr, efq = fq; asm volatile("" : "+v"(efr), "+v"(efq)); E(acc, cur, wr, wc, efr, efq); }
        if (!has_next) break;
#pragma unroll
        for (int a = 0; a < 2; ++a)
#pragma unroll
            for (int b = 0; b < 2; ++b)
#pragma unroll
                for (int m = 0; m < 4; ++m)
#pragma unroll
                    for (int n = 0; n < 2; ++n) acc[a][b][m][n] = (f32x4){0.f, 0.f, 0.f, 0.f};
        cur = nxt; cA = nA; cB = nB; ++ui;
        if (wr == 1) PG_BAR;
    }
    PG_WAIT_V(0);
    PG_BAR;
#undef PG_SA
#undef PG_SB
#undef PG_GL
#undef PG_STB
#undef PG_STA
#undef PG_LDA
#undef PG_LDB
#undef PG_MMA
#undef PG_WAIT_V
#undef PG_WAIT_L
#undef PG_BAR
#undef PG_SCHED
#undef PG_SETOFF
#undef PG_PAIR
}

struct SchedPlain {
    const char* A; const char* B; int lda, ldb, nM, nN, nwg, G, c;
    __device__ __forceinline__ bool next(int i, Unit& u) const {
        const long L = (long)i * G + c; if (L >= nwg) return false;
        const int wgid = xcd_remap((int)L, nwg);
        const int nig = 8 * nN, gid = wgid / nig, fm = gid * 8, gsz = (nM - fm) < 8 ? (nM - fm) : 8;
        u.pm = fm + ((wgid % nig) % gsz); u.pn = (wgid % nig) / gsz; u.e = 0; u.rows = nullptr;
        u.a = A + (size_t)u.pm * BM * lda * 2; u.b = B + (size_t)u.pn * BM * ldb * 2; return true;
    }
};
}

__device__ __forceinline__ void tr_item(const float* W, int N, int k0, int n0, bf16_t* WT, int ldt, int mode, int rmul, int radd, LAS float* scr, int lane) {
    f32x4 t[16];
#pragma unroll
    for (int i = 0; i < 16; ++i) t[i] = *(const f32x4*)(W + (size_t)(k0 + (lane >> 4) + 4 * i) * N + n0 + (lane & 15) * 4);
#pragma unroll
    for (int i = 0; i < 16; ++i) { LAS float* d = scr + ((lane >> 4) + 4 * i) * 65 + (lane & 15) * 4; d[0] = t[i].x; d[1] = t[i].y; d[2] = t[i].z; d[3] = t[i].w; }
    asm volatile("s_waitcnt lgkmcnt(0)" ::: "memory");
    const int c = lane & 7;
#pragma unroll
    for (int j = 0; j < 8; ++j) {
        const int n = (lane >> 3) + 8 * j; const LAS float* s = scr + (8 * c) * 65 + n;
        u32x4 o; o.x = pk2(s[0 * 65], s[1 * 65]); o.y = pk2(s[2 * 65], s[3 * 65]); o.z = pk2(s[4 * 65], s[5 * 65]); o.w = pk2(s[6 * 65], s[7 * 65]);
        const int ng = n0 + n;
        const int drow = mode == 1 ? (((ng & 255) >> 7) * 256 + (ng >> 8) * 128 + (ng & 127))
                       : mode == 2 ? ((ng >> 6) * 256 + ((ng >> 1) & 1) * 128 + ((ng >> 4) & 3) * 32 + (ng & 1) * 16 + ((ng >> 2) & 3) * 4 + radd) : ng * rmul + radd;
        *(u32x4*)(WT + (size_t)drow * ldt + k0 + 8 * c) = o;
    }
    asm volatile("s_waitcnt lgkmcnt(0)" ::: "memory");
}

__device__ __forceinline__ void phase0(const Params& p, LAS unsigned char* lds, int bid, int nblk) {
    const int tid = opq_tid(), lane = tid & 63, wid = tid >> 6;
    unsigned char* ws = p.ws;
    const int gt = bid * NTHR + tid, ngt = nblk * NTHR;
    float* pos = (float*)(ws + OFF_POS);
    for (int i = gt; i < 128 * 512; i += ngt) {
        const int r = i >> 9, c = i & 511, q = c & 255;
        const float omega = 1.0f / exp2f((float)q * (13.287712379549449f / 256.0f));
        const float ang = (float)r * omega;
        pos[i] = c < 256 ? __sinf(ang) : __cosf(ang);
    }
    float* cdec = (float*)(ws + OFF_CDEC);
    for (int i = gt; i < 2 * RW; i += ngt) cdec[i] = -8.0f * log1pf(expf(-p.in[15][i]));
    { int* ident = (int*)(ws + OFF_IDENT); for (int i = gt; i < NTOK; i += ngt) ident[i] = i; }
    {
        bf16_t* ws_s = (bf16_t*)(ws + W_S);
        for (int i = gt; i < 8 * 128 * 128; i += ngt) ws_s[i] = (bf16_t)f2bf(p.in[20][i]);
        bf16_t* wrt = (bf16_t*)(ws + W_RT);
        for (int i = gt; i < 2 * 1024 * 64; i += ngt) {
            const int l = i >> 16, k = (i >> 6) & 1023, e = i & 63;
            const float w = p.in[23][i];
            const unsigned hi = f2bf(w); const unsigned lo = f2bf(w - bf2f(hi));
            bf16_t* row = wrt + ((size_t)(l * 128 + e)) * 3072;
            row[k] = (bf16_t)hi; row[1024 + k] = (bf16_t)hi; row[2048 + k] = (bf16_t)lo;
        }
        unsigned* wz = (unsigned*)wrt;
        for (int i = gt; i < 2 * 64 * 1536; i += ngt) { const int l = i / (64 * 1536), r = i % (64 * 1536); wz[(size_t)(l * 128 + 64) * 1536 + r] = 0u; }
    }
    for (int it = bid; it < 192; it += nblk) {
        LAS float* sv = (LAS float*)lds;
        LAS float* red = (LAS float*)(lds + 20480);
        for (int i = tid; i < 5 * 1024; i += NTHR) { const float cv = i < 4096 ? p.in[1][i] : p.in[3][i - 4096]; sv[i] = silu(cv); }
        __syncthreads();
        const int l = it / 96, col0 = (it % 96) * 64;
        const float* w = p.in[4] + (size_t)l * 1024 * 6144 + col0 + lane;
        float a0 = 0.f, a1 = 0.f, a2 = 0.f, a3 = 0.f, a4 = 0.f;
        const int kb = wid * 128;
#pragma unroll 8
        for (int k = kb; k < kb + 128; ++k) {
            const float wv = w[(size_t)k * 6144];
            a0 += sv[k] * wv; a1 += sv[1024 + k] * wv; a2 += sv[2048 + k] * wv; a3 += sv[3072 + k] * wv; a4 += sv[4096 + k] * wv;
        }
        red[(wid * 5 + 0) * 64 + lane] = a0; red[(wid * 5 + 1) * 64 + lane] = a1; red[(wid * 5 + 2) * 64 + lane] = a2;
        red[(wid * 5 + 3) * 64 + lane] = a3; red[(wid * 5 + 4) * 64 + lane] = a4;
        __syncthreads();
        if (tid < 320) {
            const int v = tid >> 6, ln = tid & 63; float s = 0.f;
#pragma unroll
            for (int w8 = 0; w8 < 8; ++w8) s += red[(w8 * 5 + v) * 64 + ln];
            ((float*)(ws + OFF_MOD))[(size_t)(l * 5 + v) * 6144 + col0 + ln] = s + p.in[5][l * 6144 + col0 + ln];
        }
        __syncthreads();
    }
    LAS float* scr = (LAS float*)(lds + wid * 16640);
    const int gw = bid * 8 + wid, ngw = nblk * 8;
    constexpr int I_AIN = 16 * 40, I_AOUT = 20 * 16, I_GATE = 20 * 16, I_BIN = 16 * 64, I_BOUT = 32 * 16;
    constexpr int NITEMS = I_AIN + I_AOUT + I_GATE + I_BIN + I_BOUT;
    for (int it = gw; it < NITEMS; it += ngw) {
        int r = it;
        if (r < I_AIN) { const int kb = r / 40, nb = r % 40; tr_item(p.in[8], 2560, kb * 64, nb * 64, (bf16_t*)(ws + W_AIN), 1024, 0, 1, 0, scr, lane); continue; }
        r -= I_AIN;
        if (r < I_AOUT) { const int kb = r / 16, nb = r % 16; tr_item(p.in[16], 1024, kb * 64, nb * 64, (bf16_t*)(ws + W_AOUT), 1280, 0, 1, 0, scr, lane); continue; }
        r -= I_AOUT;
        if (r < I_GATE) {
            const int mi = r >> 4, q = r & 15, kb = q >> 2, nb = q & 3, h = mi % 5, dg = mi / 5, d = dg >> 1, g = dg & 1;
            const float* src = (g ? p.in[13] : p.in[11]) + (size_t)(d * 5 + h) * 65536;
            tr_item(src, 256, kb * 64, nb * 64, (bf16_t*)(ws + W_GATE) + (size_t)h * 1024 * 256, 256, 2, 4, d * 2 + g, scr, lane); continue; }
        r -= I_GATE;
        if (r < I_BIN) { const int kb = r / 64, nb = r % 64; tr_item(p.in[17], 4096, kb * 64, nb * 64, (bf16_t*)(ws + W_BIN), 1024, 0, 1, 0, scr, lane); continue; }
        r -= I_BIN;
        { const int kb = r / 16, nb = r % 16; tr_item(p.in[22], 1024, kb * 64, nb * 64, (bf16_t*)(ws + W_BOUT), 2048, 0, 1, 0, scr, lane); }
    }
}

constexpr int BG_TILES = 65 * 128 + 65 * 64, BG_CHUNKS = BG_TILES / 8;
__device__ __forceinline__ void bg_tile(const Params& p, int l, int t, LAS float* scr, int lane) {
    unsigned char* ws = p.ws;
    if (t < 65 * 128) { const int e = t >> 7, q = t & 127, kb = q >> 3, nb = q & 7, le = l * 65 + e;
        const float* src = e < 64 ? p.in[25] + (size_t)(l * 64 + e) * 1024 * 512 : p.in[27] + (size_t)l * 1024 * 512;
        tr_item(src, 512, kb * 64, nb * 64, (bf16_t*)(ws + W_GU) + (size_t)le * 512 * 1024, 1024, 1, 1, 0, scr, lane);
    } else { const int r = t - 65 * 128, e = r >> 6, q = r & 63, kb = q >> 4, nb = q & 15, le = l * 65 + e;
        const float* src = e < 64 ? p.in[26] + (size_t)(l * 64 + e) * 256 * 1024 : p.in[28] + (size_t)l * 256 * 1024;
        tr_item(src, 1024, kb * 64, nb * 64, (bf16_t*)(ws + W_DN) + (size_t)le * 1024 * 256, 256, 0, 1, 0, scr, lane); }
}
__device__ __forceinline__ void bg_convert(const Params& p, LAS unsigned char* lds, int l, int maxchunks) {
    const int tid = opq_tid(), lane = tid & 63, wid = tid >> 6;
    unsigned* q = (unsigned*)(p.ws + 32768) + l * 64;
    LAS int* slot = (LAS int*)(lds + LDS_BYTES - 64);
    LAS float* scr = (LAS float*)(lds + wid * 16640);
    for (int n = 0; n < maxchunks; ++n) {
        if (tid == 0) *slot = (int)atomicAdd(q, 1u);
        __syncthreads();
        const int c = *slot;
        __syncthreads();
        if (c >= BG_CHUNKS) break;
        bg_tile(p, l, c * 8 + wid, scr, lane);
    }
    __syncthreads();
}
__device__ __forceinline__ bool bg_idle(int nunits, int G, int c) { return (nunits - c + G - 1) / G < (nunits + G - 1) / G; }

template <int MODE, bool WRITE_LO, bool FINAL>
__device__ __forceinline__ void row_phase(const Params& p, int bid, int nblk, const float* gnorm, const float* modl  , int off_sh, int off_sc,
                                           const float* modprev  , const bf16_t* dx  ) {
    const int tid = opq_tid(), lane = tid & 63, wid = tid >> 6;
    unsigned char* ws = p.ws;
    float* xout = p.out;
    bf16_t* xres = (bf16_t*)(ws + B_XR);
    bf16_t* hx = (bf16_t*)(ws + OFF_HX);
    bf16_t* hlo = (bf16_t*)(ws + B_HLO);
    const float* pos = (const float*)(ws + OFF_POS);
    const int* slotof = (const int*)(ws + OFF_SLOTOF);
    const bf16_t* Y = (const bf16_t*)(ws + B_YY);
    const int nrows = MODE == 0 ? NROW : NTOK;
    for (int row = bid * 8 + wid; row < nrows; row += nblk * 8) {
        f32x4 v[4];
        int mv;
        if (MODE == 0) {
            if (row < NTOK) {
                mv = row >> 13; const int t = row & (SEQ - 1);
                const f32x4* xr = (const f32x4*)(p.in[0] + (size_t)row * D) + lane;
                const f32x4* pr = (const f32x4*)(pos + (size_t)(t >> 6) * 512) + lane;
                const f32x4* pc = (const f32x4*)(pos + (size_t)(t & 63) * 512) + lane;
                v[0] = xr[0] + pr[0]; v[1] = xr[64] + pr[64]; v[2] = xr[128] + pc[0]; v[3] = xr[192] + pc[64];
                u32x2* xo = (u32x2*)(xres + (size_t)row * D) + lane;
#pragma unroll
                for (int j = 0; j < 4; ++j) xo[64 * j] = (u32x2){pk2(v[j].x, v[j].y), pk2(v[j].z, v[j].w)};
            } else {
                mv = 4;
                const f32x4* xr = (const f32x4*)(p.in[2] + (size_t)(row - NTOK) * D) + lane;
#pragma unroll
                for (int j = 0; j < 4; ++j) v[j] = xr[64 * j];
            }
        } else {
            mv = row >> 13;
            u32x2* xo = (u32x2*)(xres + (size_t)row * D) + lane;
#pragma unroll
            for (int j = 0; j < 4; ++j) { const u32x2 w = xo[64 * j]; v[j] = (f32x4){bflo(w.x), bfhi(w.x), bflo(w.y), bfhi(w.y)}; }
            if (MODE == 1) {
                const u32x2* dr = (const u32x2*)(dx + (size_t)row * D) + lane;
#pragma unroll
                for (int j = 0; j < 4; ++j) { const u32x2 w = dr[64 * j]; v[j].x += bflo(w.x); v[j].y += bfhi(w.x); v[j].z += bflo(w.y); v[j].w += bfhi(w.y); xo[64 * j] = (u32x2){pk2(v[j].x, v[j].y), pk2(v[j].z, v[j].w)}; }
            }
            if (MODE == 2) {
                f32x4 s[4];
                {
                    const unsigned* yr = (const unsigned*)(ws + B_YS + (size_t)row * D) + lane;
#pragma unroll
                    for (int j = 0; j < 4; ++j) s[j] = up4_fp8(yr[64 * j]);
                }
#pragma unroll
                for (int k = 0; k < TOPK; ++k) {
                    const int slot = slotof[row * 8 + k];
                    const unsigned* yr = (const unsigned*)(ws + B_YY + (size_t)slot * D) + lane;
#pragma unroll
                    for (int j = 0; j < 4; ++j) s[j] = s[j] + up4_fp8(yr[64 * j]);
                }
                const f32x4* g2 = (const f32x4*)(modprev + (size_t)mv * 6144 + 5120) + lane;
#pragma unroll
                for (int j = 0; j < 4; ++j) { v[j] = v[j] + g2[64 * j] * s[j]; if (!FINAL) xo[64 * j] = (u32x2){pk2(v[j].x, v[j].y), pk2(v[j].z, v[j].w)}; }
            }
        }
        float ss = 0.f;
#pragma unroll
        for (int j = 0; j < 4; ++j) ss += (v[j].x * v[j].x + v[j].y * v[j].y) + (v[j].z * v[j].z + v[j].w * v[j].w);
        ss = wave_sum(ss);
        const float rinv = 1.0f / sqrtf(ss * (1.0f / D) + 1e-6f);
        const f32x4* gn = (const f32x4*)gnorm + lane;
        if (FINAL) {
            f32x4* xo = (f32x4*)(xout + (size_t)row * D) + lane;
#pragma unroll
            for (int j = 0; j < 4; ++j) xo[64 * j] = v[j] * rinv * gn[64 * j];
        } else {
            const f32x4* sh = (const f32x4*)(modl + (size_t)mv * 6144 + off_sh) + lane;
            const f32x4* sc = (const f32x4*)(modl + (size_t)mv * 6144 + off_sc) + lane;
            u32x2* ho = (u32x2*)(hx + (size_t)row * D) + lane;
            u32x2* lo = (u32x2*)(hlo + (size_t)row * D) + lane;
#pragma unroll
            for (int j = 0; j < 4; ++j) {
                const f32x4 y = v[j] * rinv * gn[64 * j] * (sc[64 * j] + 1.0f) + sh[64 * j];
                u32x2 w; w.x = pk2(y.x, y.y); w.y = pk2(y.z, y.w);
                ho[64 * j] = w;
                if (WRITE_LO) { u32x2 q; q.x = pk2(y.x - bflo(w.x), y.y - bfhi(w.x)); q.y = pk2(y.z - bflo(w.y), y.w - bfhi(w.y)); lo[64 * j] = q; }
            }
        }
    }
}

__device__ __forceinline__ void phase_inproj0(const Params& p, LAS unsigned char* lds, int bid, int nblk) {
    unsigned char* ws = p.ws;
    const bf16_t* hx = (const bf16_t*)(ws + OFF_HX); const bf16_t* W = (const bf16_t*)(ws + W_AIN);
    bf16_t* gate0 = (bf16_t*)(ws + B_GATE0); bf16_t* upre = (bf16_t*)(ws + B_UPRE);
    const int tid = opq_tid(), srow = tid >> 2, skc = (tid & 3) * 8;
    constexpr int NU = 256 * 20 + 8 * 10;
    for (int u = bid; u < NU; u += nblk) {
        int mt, nt;
        if (u < 5120) { mt = u / 20; nt = u % 20; } else { const int q = u - 5120; mt = 256 + q / 10; nt = 10 + q % 10; }
        const bf16_t* arow = hx + (size_t)(mt * 128 + srow) * D + skc;
        const bf16_t* brow = W + (size_t)(nt * 128 + srow) * D + skc;
        gemm_tile(arow, brow, 32, KDef(), [=](int r, int c, f32x4 v) {
            const int row = mt * 128 + r, col = nt * 128 + c;
            if (col < RW) { u32x2 w; w.x = pk2(gelu_t(v.x), gelu_t(v.y)); w.y = pk2(gelu_t(v.z), gelu_t(v.w)); *(u32x2*)(gate0 + (size_t)row * RW + col) = w; }
            else { u32x2 w; w.x = pk2(v.x, v.y); w.y = pk2(v.z, v.w); *(u32x2*)(upre + (size_t)row * RW + (col - RW)) = w; }
        }, lds);
    }
}

__device__ __forceinline__ void phase_conv(const Params& p, int bid, int nblk) {
    unsigned char* ws = p.ws;
    const bf16_t* upre = (const bf16_t*)(ws + B_UPRE); bf16_t* uu = (bf16_t*)(ws + B_UU);
    const float* cw = p.in[9]; const float* cb = p.in[10];
    const int gt = bid * NTHR + opq_tid(), ngt = nblk * NTHR;
    for (int item = gt; item < (NROW / 16) * 160; item += ngt) {
        const int rb = item / 160, cg8 = (item % 160) * 8, R0 = rb * 16;
        int t0, T;
        if (R0 < NTOK) { t0 = R0 & (SEQ - 1); T = SEQ; } else { t0 = (R0 - NTOK) & (CTXL - 1); T = CTXL; }
        f32x4 wa[4], wb[4];
#pragma unroll
        for (int k = 0; k < 4; ++k) { wa[k] = *(const f32x4*)(cw + k * RW + cg8); wb[k] = *(const f32x4*)(cw + k * RW + cg8 + 4); }
        const f32x4 ba = *(const f32x4*)(cb + cg8), bb = *(const f32x4*)(cb + cg8 + 4);
        u32x4 raw[19];
#pragma unroll
        for (int j = 0; j < 19; ++j) { const int tt = t0 + j - 2; raw[j] = (tt >= 0 && tt < T) ? *(const u32x4*)(upre + (size_t)(R0 + j - 2) * RW + cg8) : (u32x4){0u, 0u, 0u, 0u}; }
#pragma unroll
        for (int r = 0; r < 16; ++r) {
            f32x4 oa = ba, ob = bb;
#pragma unroll
            for (int k = 0; k < 4; ++k) { const u32x4 w = raw[r + k];
                oa = oa + wa[k] * (f32x4){bflo(w.x), bfhi(w.x), bflo(w.y), bfhi(w.y)}; ob = ob + wb[k] * (f32x4){bflo(w.z), bfhi(w.z), bflo(w.w), bfhi(w.w)}; }
            *(u32x4*)(uu + (size_t)(R0 + r) * RW + cg8) = pack8(oa, ob);
        }
    }
}

__device__ __forceinline__ void phase_outproj(const Params& p, LAS unsigned char* lds, int bid, int nblk, const bf16_t* Z, int K, const bf16_t* W, const float* modl) {
    float* xres = p.out;
    const int tid = opq_tid(), srow = tid >> 2, skc = (tid & 3) * 8;
    for (int u = bid; u < 256 * 8; u += nblk) {
        const int mt = u >> 3, nt = u & 7;
        const bf16_t* arow = Z + (size_t)(mt * 128 + srow) * K + skc;
        const bf16_t* brow = W + (size_t)(nt * 128 + srow) * K + skc;
        gemm_tile(arow, brow, K / 32, KDef(), [=](int r, int c, f32x4 v) {
            const int row = mt * 128 + r, col = nt * 128 + c;
            const f32x4 g1 = *(const f32x4*)(modl + (size_t)(row >> 13) * 6144 + 2048 + col);
            f32x4* xo = (f32x4*)(xres + (size_t)row * D + col);
            *xo = *xo + g1 * v;
        }, lds);
    }
}

__device__ __forceinline__ float rdlane(float v, int l) { return __builtin_bit_cast(float, __builtin_amdgcn_readlane(__builtin_bit_cast(int, v), l)); }
__device__ __forceinline__ float xmax(float v, int m) { return fmaxf(v, __shfl_xor(v, m)); }
__device__ __forceinline__ void phase_router(const Params& p, LAS unsigned char* lds, int bid, int nblk, int l) {
    unsigned char* ws = p.ws;
    const bf16_t* hx = (const bf16_t*)(ws + OFF_HX); const bf16_t* W = (const bf16_t*)(ws + W_RT) + (size_t)l * 128 * 3072;
    int* eidx = (int*)(ws + OFF_EIDX); float* gatew = (float*)(ws + OFF_GATEW); int* cnt = (int*)(ws + OFF_CNT); int* cntw = (int*)(ws + OFF_CNTW2);
    const int tid = opq_tid(), lane = tid & 63, wid = tid >> 6, fr = lane & 15, fq = lane >> 4;
    const float rbl = p.in[24][l * 64 + lane];
    LAS float* part = (LAS float*)lds;
    LAS float* L = (LAS float*)(lds + 69632);
    LAS int* cw = (LAS int*)(lds + 69632 + 8320);
    bf16x8 Bh[4][4], Bl[4][4];
#pragma unroll
    for (int s = 0; s < 4; ++s)
#pragma unroll
        for (int nb = 0; nb < 4; ++nb) { const bf16_t* wp = W + (size_t)(16 * nb + fr) * 3072 + 128 * wid + 32 * s + 8 * fq; Bh[s][nb] = *(const bf16x8*)wp; Bl[s][nb] = *(const bf16x8*)(wp + 2048); }
    bf16x8 Ah[2][4], Al[2][4];
#define RT_LOADA(ROW0) do { _Pragma("unroll") for (int g = 0; g < 2; ++g) _Pragma("unroll") for (int s = 0; s < 4; ++s) { \
        const bf16_t* ap = hx + (size_t)((ROW0) + 16 * g + fr) * D + 128 * wid + 32 * s + 8 * fq; Ah[g][s] = *(const bf16x8*)ap; Al[g][s] = *(const bf16x8*)(ap + LO_DELTA); } } while (0)
    if (bid < 256) RT_LOADA(bid * 128);
    for (int tile = bid; tile < 256; tile += nblk) {
        int cnt_e = 0;
        for (int it = 0; it < 4; ++it) {
            const int row0 = tile * 128 + it * 32;
            f32x4 acc[2][4];
#pragma unroll
            for (int g = 0; g < 2; ++g)
#pragma unroll
                for (int nb = 0; nb < 4; ++nb) acc[g][nb] = (f32x4){0.f, 0.f, 0.f, 0.f};
#pragma unroll
            for (int g = 0; g < 2; ++g)
#pragma unroll
                for (int s = 0; s < 4; ++s)
#pragma unroll
                    for (int nb = 0; nb < 4; ++nb) {
                        acc[g][nb] = __builtin_amdgcn_mfma_f32_16x16x32_bf16(Bh[s][nb], Ah[g][s], acc[g][nb], 0, 0, 0);
                        acc[g][nb] = __builtin_amdgcn_mfma_f32_16x16x32_bf16(Bh[s][nb], Al[g][s], acc[g][nb], 0, 0, 0);
                        acc[g][nb] = __builtin_amdgcn_mfma_f32_16x16x32_bf16(Bl[s][nb], Ah[g][s], acc[g][nb], 0, 0, 0);
                    }
            {
                const int nrow0 = it < 3 ? row0 + 32 : (tile + nblk) * 128;
                if (nrow0 < NTOK) RT_LOADA(nrow0);
            }
#pragma unroll
            for (int g = 0; g < 2; ++g)
#pragma unroll
                for (int nb = 0; nb < 4; ++nb) *(LAS f32x4*)(part + ((wid * 32 + 16 * g + fr) * 68 + 16 * nb + 4 * fq)) = acc[g][nb];
            __syncthreads();
            {
                const int r = tid >> 4, e0 = (tid & 15) * 4;
                f32x4 s = (f32x4){0.f, 0.f, 0.f, 0.f};
#pragma unroll
                for (int w = 0; w < 8; ++w) s = s + *(LAS f32x4*)(part + ((w * 32 + r) * 68 + e0));
                LAS float* o = L + r * 65 + e0; o[0] = s.x; o[1] = s.y; o[2] = s.z; o[3] = s.w;
            }
            __syncthreads();
#pragma unroll 1
            for (int j = 0; j < 4; ++j) {
                const int r = 4 * wid + j, tok = row0 + r;
                const float sc = sigm(L[r * 65 + lane]), sel = sc + rbl;
                const float m1 = xmax(xmax(xmax(sel, 1), 2), 4);
                int cand = sel == m1 ? lane : 64; cand = min(cand, __shfl_xor(cand, 1)); cand = min(cand, __shfl_xor(cand, 2)); cand = min(cand, __shfl_xor(cand, 4));
                const float s2 = lane == cand ? -__builtin_inff() : sel;
                const float gs = m1 + xmax(xmax(xmax(s2, 1), 2), 4);
                const int g = lane >> 3; int rank = 0;
#pragma unroll
                for (int gp = 0; gp < 8; ++gp) { const float o = rdlane(gs, gp * 8); rank += (o > gs || (o == gs && gp < g)) ? 1 : 0; }
                const bool keep = rank < 4;
                const unsigned bits = __builtin_bit_cast(unsigned, sel), srt = (bits & 0x80000000u) ? ~bits : (bits | 0x80000000u);
                const unsigned key = keep ? ((srt & ~63u) | (unsigned)(63 - lane)) : 0u;
                LAS unsigned* kb = (LAS unsigned*)(lds + 80000) + wid * 64;
                kb[lane] = key;
                int er = 0;
#pragma unroll
                for (int q4 = 0; q4 < 16; ++q4) { const u32x4 k4 = *(LAS u32x4*)(kb + 4 * q4); er += (k4.x > key ? 1 : 0) + (k4.y > key ? 1 : 0) + (k4.z > key ? 1 : 0) + (k4.w > key ? 1 : 0); }
                const bool chosen = keep && er < 8;
                const float ssum = wave_sum(chosen ? sc : 0.0f);
                if (chosen) { eidx[tok * 8 + er] = lane | (cnt_e << 8); gatew[tok * 8 + er] = sc * (2.5f / ssum); }
                cnt_e += chosen ? 1 : 0;
            }
        }
        cntw[(tile * 8 + wid) * 64 + lane] = cnt_e;
        cw[wid * 64 + lane] = cnt_e;
        __syncthreads();
        if (tid < 64) { int c = 0;
#pragma unroll
            for (int w = 0; w < 8; ++w) c += cw[w * 64 + tid];
            cnt[tile * 64 + tid] = c; }
        __syncthreads();
    }
}

__device__ __forceinline__ void phase_normroute(const Params& p, LAS unsigned char* lds, int bid, int nblk, int l, const float* gnorm, const float* modl, const bf16_t* dx) {
    unsigned char* ws = p.ws;
    bf16_t* xres = (bf16_t*)(ws + B_XR); bf16_t* hx = (bf16_t*)(ws + OFF_HX);
    const bf16_t* W = (const bf16_t*)(ws + W_RT) + (size_t)l * 128 * 3072;
    int* eidx = (int*)(ws + OFF_EIDX); float* gatew = (float*)(ws + OFF_GATEW); int* cnt = (int*)(ws + OFF_CNT); int* cntw = (int*)(ws + OFF_CNTW2);
    const int tid = opq_tid(), lane = tid & 63, wid = tid >> 6, fr = lane & 15, fq = lane >> 4;
    const float rbl = p.in[24][l * 64 + lane];
    LAS unsigned char* ahi = lds;
    LAS unsigned char* alo = lds + 33024;
    LAS float* part = (LAS float*)(lds + 66048);
    LAS float* L = (LAS float*)(lds + 66048 + 34816);
    LAS unsigned* kbase = (LAS unsigned*)(lds + 66048 + 34816 + 4224);
    LAS int* cw = (LAS int*)(lds + 66048 + 34816 + 4224 + 2048);
    bf16x8 Bh[4][4], Bl[4][4];
#pragma unroll
    for (int s = 0; s < 4; ++s)
#pragma unroll
        for (int nb = 0; nb < 4; ++nb) { const bf16_t* wp = W + (size_t)(16 * nb + fr) * 3072 + 128 * wid + 32 * s + 8 * fq; Bh[s][nb] = *(const bf16x8*)wp; Bl[s][nb] = *(const bf16x8*)(wp + 2048); }
    const f32x4* gn = (const f32x4*)gnorm + lane;
    u32x2 xa[2][4], da[2][4];
#define NR_LOAD(ROW0) do { _Pragma("unroll") for (int q = 0; q < 2; ++q) { const size_t r_ = (size_t)(ROW0) + 2 * wid + q; _Pragma("unroll") for (int j = 0; j < 4; ++j) { \
        xa[q][j] = ((const u32x2*)(xres + r_ * D) + lane)[64 * j]; da[q][j] = ((const u32x2*)(dx + r_ * D) + lane)[64 * j]; } } } while (0)
    if (bid < 256) NR_LOAD(bid * 128);
    for (int tile = bid; tile < 256; tile += nblk) {
        int cnt_e = 0;
        const int mv = tile >> 6;
        f32x4 ca[4];
#pragma unroll
        for (int j = 0; j < 4; ++j) ca[j] = gn[64 * j] * (((const f32x4*)(modl + (size_t)mv * 6144 + 4096) + lane)[64 * j] + 1.0f);
        const f32x4* sh = (const f32x4*)(modl + (size_t)mv * 6144 + 3072) + lane;
        for (int grp = 0; grp < 8; ++grp) {
            const int row0 = tile * 128 + grp * 16;
#pragma unroll
            for (int q = 0; q < 2; ++q) {
                const int rl = 2 * wid + q; const size_t row = (size_t)row0 + rl;
                f32x4 v[4]; float ss = 0.f;
#pragma unroll
                for (int j = 0; j < 4; ++j) { const u32x2 a = xa[q][j], b = da[q][j];
                    v[j] = (f32x4){bflo(a.x) + bflo(b.x), bfhi(a.x) + bfhi(b.x), bflo(a.y) + bflo(b.y), bfhi(a.y) + bfhi(b.y)};
                    ((u32x2*)(xres + row * D) + lane)[64 * j] = (u32x2){pk2(v[j].x, v[j].y), pk2(v[j].z, v[j].w)};
                    ss += (v[j].x * v[j].x + v[j].y * v[j].y) + (v[j].z * v[j].z + v[j].w * v[j].w); }
                ss = wave_sum(ss);
                const float rinv = 1.0f / sqrtf(ss * (1.0f / D) + 1e-6f);
#pragma unroll
                for (int j = 0; j < 4; ++j) {
                    const f32x4 y = v[j] * rinv * ca[j] + sh[64 * j];
                    u32x2 w; w.x = pk2(y.x, y.y); w.y = pk2(y.z, y.w);
                    ((u32x2*)(hx + row * D) + lane)[64 * j] = w;
                    u32x2 ql; ql.x = pk2(y.x - bflo(w.x), y.y - bfhi(w.x)); ql.y = pk2(y.z - bflo(w.y), y.w - bfhi(w.y));
                    *(LAS u32x2*)(ahi + rl * 2064 + (lane + 64 * j) * 8) = w; *(LAS u32x2*)(alo + rl * 2064 + (lane + 64 * j) * 8) = ql;
                }
            }
            __syncthreads();
            {
                const int nrow0 = grp < 7 ? row0 + 16 : (tile + nblk) * 128;
                if (nrow0 < NTOK) NR_LOAD(nrow0);
            }
            f32x4 acc[4];
#pragma unroll
            for (int nb = 0; nb < 4; ++nb) acc[nb] = (f32x4){0.f, 0.f, 0.f, 0.f};
#pragma unroll
            for (int s = 0; s < 4; ++s) {
                const int ko = fr * 2064 + (128 * wid + 32 * s + 8 * fq) * 2;
                const bf16x8 Ah = *(LAS bf16x8*)(ahi + ko), Al = *(LAS bf16x8*)(alo + ko);
#pragma unroll
                for (int nb = 0; nb < 4; ++nb) {
                    acc[nb] = __builtin_amdgcn_mfma_f32_16x16x32_bf16(Bh[s][nb], Ah, acc[nb], 0, 0, 0);
                    acc[nb] = __builtin_amdgcn_mfma_f32_16x16x32_bf16(Bh[s][nb], Al, acc[nb], 0, 0, 0);
                    acc[nb] = __builtin_amdgcn_mfma_f32_16x16x32_bf16(Bl[s][nb], Ah, acc[nb], 0, 0, 0);
                }
            }
#pragma unroll
            for (int nb = 0; nb < 4; ++nb) *(LAS f32x4*)(part + ((wid * 16 + fr) * 68 + 16 * nb + 4 * fq)) = acc[nb];
            __syncthreads();
            if (tid < 256) {
                const int r = tid >> 4, e0 = (tid & 15) * 4;
                f32x4 s = (f32x4){0.f, 0.f, 0.f, 0.f};
#pragma unroll
                for (int w = 0; w < 8; ++w) s = s + *(LAS f32x4*)(part + ((w * 16 + r) * 68 + e0));
                LAS float* o = L + r * 65 + e0; o[0] = s.x; o[1] = s.y; o[2] = s.z; o[3] = s.w;
            }
            __syncthreads();
#pragma unroll 1
            for (int j = 0; j < 2; ++j) {
                const int r = 2 * wid + j, tok = row0 + r;
                const float scv = sigm(L[r * 65 + lane]), sel = scv + rbl;
                const float m1 = max8(sel);
                const int cand = min8(sel == m1 ? lane : 64);
                const float s2 = lane == cand ? -__builtin_inff() : sel;
                const float gs = m1 + max8(s2);
                const int g = lane >> 3; int rank = 0;
#pragma unroll
                for (int gp = 0; gp < 8; ++gp) { const float o = rdlane(gs, gp * 8); rank += (o > gs || (o == gs && gp < g)) ? 1 : 0; }
                const bool keep = rank < 4;
                const unsigned bits = __builtin_bit_cast(unsigned, sel), srt = (bits & 0x80000000u) ? ~bits : (bits | 0x80000000u);
                const unsigned key = keep ? ((srt & ~63u) | (unsigned)(63 - lane)) : 0u;
                LAS unsigned* kb = kbase + wid * 64;
                kb[lane] = key;
                int er = 0;
#pragma unroll
                for (int q4 = 0; q4 < 16; ++q4) { const u32x4 k4 = *(LAS u32x4*)(kb + 4 * q4); er += (k4.x > key ? 1 : 0) + (k4.y > key ? 1 : 0) + (k4.z > key ? 1 : 0) + (k4.w > key ? 1 : 0); }
                const bool chosen = keep && er < 8;
                const float ssum = wave_sum(chosen ? scv : 0.0f);
                if (chosen) { eidx[tok * 8 + er] = lane | (cnt_e << 8); gatew[tok * 8 + er] = scv * (2.5f / ssum); }
                cnt_e += chosen ? 1 : 0;
            }
        }
        cntw[(tile * 8 + wid) * 64 + lane] = cnt_e;
        cw[wid * 64 + lane] = cnt_e;
        __syncthreads();
        if (tid < 64) { int c = 0;
#pragma unroll
            for (int w = 0; w < 8; ++w) c += cw[w * 64 + tid];
            cnt[tile * 64 + tid] = c; }
        __syncthreads();
    }
#undef NR_LOAD
}

__device__ __forceinline__ void phase_scatter(const Params& p, LAS unsigned char* lds, int bid, int nblk, int l) {
    unsigned char* ws = p.ws;
    const int* eidx = (const int*)(ws + OFF_EIDX); const float* gatew = (const float*)(ws + OFF_GATEW); const int* cnt = (const int*)(ws + OFF_CNT); const int* cntw = (const int*)(ws + OFF_CNTW2);
    int* slotof = (int*)(ws + OFF_SLOTOF); int* tokof = (int*)(ws + OFF_TOKOF); float* wof = (float*)(ws + OFF_WOF); int* meta = (int*)(ws + OFF_META);
    const int tid = opq_tid();
    LAS int* ps = (LAS int*)lds;
    LAS int* tot = (LAS int*)(lds + 2048);
    LAS int* sst = (LAS int*)(lds + 2048 + 256);
    LAS int* base = (LAS int*)(lds + 4096);
    LAS int* cl = (LAS int*)(lds + 8192);
    for (int i = tid; i < 256 * 64; i += NTHR) cl[i] = cnt[i];
    __syncthreads();
    {
        const int e = tid & 63, part = tid >> 6; int s = 0;
#pragma unroll 8
        for (int r = part * 32; r < part * 32 + 32; ++r) s += cl[r * 64 + e];
        ps[part * 64 + e] = s;
    }
    __syncthreads();
    if (tid < 64) { int s = 0; for (int q = 0; q < 8; ++q) s += ps[q * 64 + tid]; tot[tid] = s; }
    __syncthreads();
    if (tid == 0) { int a = 0; for (int e = 0; e < 64; ++e) { sst[e] = a; a += (tot[e] + TM - 1) / TM * TM; } sst[64] = a; sst[65] = a + NTOK; }
    __syncthreads();
    for (int tile = bid; tile < 256; tile += nblk) {
        {
            const int e = tid & 63, part = tid >> 6; int s = 0;
#pragma unroll 8
            for (int r = part * 32; r < part * 32 + 32; ++r) s += r < tile ? cl[r * 64 + e] : 0;
            ps[part * 64 + e] = s;
        }
        __syncthreads();
        {
            const int e = tid & 63, w = tid >> 6; int b = sst[e];
#pragma unroll
            for (int q = 0; q < 8; ++q) b += ps[q * 64 + e];
#pragma unroll
            for (int q = 0; q < 8; ++q) b += q < w ? cntw[(tile * 8 + q) * 64 + e] : 0;
            base[w * 64 + e] = b;
        }
        __syncthreads();
#pragma unroll
        for (int i = 0; i < 2; ++i) {
            const int a = tid + NTHR * i, r = a >> 3, tok = tile * 128 + r, w = (r & 15) >> 1;
            const int code = eidx[tile * 1024 + a], e = code & 63, lr = code >> 8;
            const int slot = base[w * 64 + e] + lr;
            tokof[slot] = tok; wof[slot] = gatew[tile * 1024 + a]; slotof[tile * 1024 + a] = slot;
        }
        if (tile == 0) {
            if (tid < 64) for (int s = sst[tid] + tot[tid]; s < sst[tid + 1]; ++s) { tokof[s] = 0; wof[s] = 0.0f; }
            if (tid < 66) meta[tid] = sst[tid];
        }
        __syncthreads();
    }
    bg_convert(p, lds, l, 1 << 30);
}

__device__ __forceinline__ void phase_inproj1(const Params& p, LAS unsigned char* lds, int bid, int nblk) {
    unsigned char* ws = p.ws;
    const bf16_t* hx = (const bf16_t*)(ws + OFF_HX); const bf16_t* W = (const bf16_t*)(ws + W_BIN); bf16_t* uv = (bf16_t*)(ws + B_UV);
    const int tid = opq_tid(), srow = tid >> 2, skc = (tid & 3) * 8;
    for (int u = bid; u < 256 * 32; u += nblk) {
        const int mt = u >> 5, nt = u & 31;
        const bf16_t* arow = hx + (size_t)(mt * 128 + srow) * D + skc;
        const bf16_t* brow = W + (size_t)(nt * 128 + srow) * D + skc;
        gemm_tile(arow, brow, 32, KDef(), [=](int r, int c, f32x4 v) {
            u32x2 w; w.x = pk2(gelu_t(v.x), gelu_t(v.y)); w.y = pk2(gelu_t(v.z), gelu_t(v.w));
            *(u32x2*)(uv + (size_t)(mt * 128 + r) * 4096 + nt * 128 + c) = w;
        }, lds);
    }
}

__device__ __forceinline__ void phase_sgu(const Params& p, LAS unsigned char* lds, int bid, int nblk) {
    unsigned char* ws = p.ws;
    const bf16_t* Wsb = (const bf16_t*)(ws + W_S); const bf16_t* uv = (const bf16_t*)(ws + B_UV); const float* statp = (const float*)(ws + OFF_STATP);
    bf16_t* z1 = (bf16_t*)(ws + B_Z1); const float* bs = p.in[21]; const float* lng = p.in[18]; const float* lnb = p.in[19];
    const int tid = opq_tid(), lane = tid & 63, wid = tid >> 6, wr = wid >> 2, wc = wid & 3, fr = lane & 15, fq = lane >> 4;
    LAS unsigned char* sa = lds;
    LAS unsigned char* sb = lds + 34816;
    LAS float* st = (LAS float*)(lds + 69632);
    u32x4 ra[4], rb[4], ru[4]; f32x4 rg[2], rbb[2]; float rm = 0.f, rr = 0.f;
#define SG_LOAD(U) do { const int chunk_ = (U) >> 4, g_ = ((U) >> 1) & 7, nt_ = (U) & 1; _Pragma("unroll") for (int k = 0; k < 4; ++k) { const int idx = k * NTHR + tid, r = idx >> 4, c8 = (idx & 15) * 8; \
        ra[k] = *(const u32x4*)(Wsb + (size_t)(g_ * 128 + r) * 128 + c8); rb[k] = *(const u32x4*)(uv + (size_t)(chunk_ * 128 + r) * 4096 + 2048 + g_ * 256 + nt_ * 128 + c8); \
        ru[k] = *(const u32x4*)(uv + (size_t)(chunk_ * 128 + r) * 4096 + g_ * 256 + nt_ * 128 + c8); } \
        { const int ch_ = g_ * 256 + nt_ * 128 + (tid & 15) * 8; rg[0] = *(const f32x4*)(lng + ch_); rg[1] = *(const f32x4*)(lng + ch_ + 4); rbb[0] = *(const f32x4*)(lnb + ch_); rbb[1] = *(const f32x4*)(lnb + ch_ + 4); } \
        if (tid < 128) { const f32x4* sp = (const f32x4*)(statp + (size_t)(chunk_ * 128 + tid) * 64); float S_ = 0.f, Q_ = 0.f; \
            _Pragma("unroll") for (int k = 0; k < 16; ++k) { const f32x4 t_ = sp[k]; S_ += t_.x + t_.z; Q_ += t_.y + t_.w; } \
            rm = S_ * (1.0f / SW); rr = 1.0f / sqrtf(fmaxf(Q_ * (1.0f / SW) - rm * rm, 0.0f) + 1e-6f); } } while (0)
    if (bid < 4096) SG_LOAD(bid);
    for (int u = bid; u < 256 * 16; u += nblk) {
        const int chunk = u >> 4, g = (u >> 1) & 7, nt = u & 1, R0 = chunk * 128;
        if (tid < 128) { st[tid * 2] = rm; st[tid * 2 + 1] = rr; }
        __syncthreads();
#pragma unroll
        for (int k = 0; k < 4; ++k) {
            const int idx = k * NTHR + tid, r = idx >> 4, c16 = (idx & 15) * 16;
            *(LAS u32x4*)(sa + r * 272 + c16) = ra[k];
            const float mean = st[r * 2], rstd = st[r * 2 + 1]; const u32x4 w = rb[k];
            const f32x4 x0 = ((f32x4){bflo(w.x), bfhi(w.x), bflo(w.y), bfhi(w.y)} - mean) * rstd * rg[0] + rbb[0];
            const f32x4 x1 = ((f32x4){bflo(w.z), bfhi(w.z), bflo(w.w), bfhi(w.w)} - mean) * rstd * rg[1] + rbb[1];
            *(LAS u32x4*)(sb + r * 272 + c16) = pack8(x0, x1);
        }
        u32x4 uc[4];
#pragma unroll
        for (int k = 0; k < 4; ++k) uc[k] = ru[k];
        float bsv[4];
#pragma unroll
        for (int m = 0; m < 4; ++m) bsv[m] = bs[g * 128 + wr * 64 + m * 16 + fr];
        __syncthreads();
        if (u + nblk < 4096) SG_LOAD(u + nblk);
        f32x4 acc[4][2];
#pragma unroll
        for (int m = 0; m < 4; ++m)
#pragma unroll
            for (int n = 0; n < 2; ++n) acc[m][n] = (f32x4){0.f, 0.f, 0.f, 0.f};
#pragma unroll
        for (int ks = 0; ks < 4; ++ks) {
            bf16x8 af[4], bfv[2];
#pragma unroll
            for (int m = 0; m < 4; ++m) af[m] = *(LAS bf16x8*)(sa + (wr * 64 + m * 16 + fr) * 272 + ks * 64 + fq * 16);
#pragma unroll
            for (int n = 0; n < 2; ++n) {
                const LAS unsigned short* bp = (const LAS unsigned short*)(sb + (ks * 32 + fq * 8) * 272 + (wc * 32 + n * 16 + fr) * 2);
#pragma unroll
                for (int j = 0; j < 8; ++j) bfv[n][j] = (short)bp[j * 136];
            }
#pragma unroll
            for (int m = 0; m < 4; ++m)
#pragma unroll
                for (int n = 0; n < 2; ++n) acc[m][n] = __builtin_amdgcn_mfma_f32_16x16x32_bf16(bfv[n], af[m], acc[m][n], 0, 0, 0);
        }
        __syncthreads();
#pragma unroll
        for (int m = 0; m < 4; ++m) { const int r = wr * 64 + m * 16 + fr; const float b = bsv[m];
#pragma unroll
            for (int n = 0; n < 2; ++n) { const f32x4 v = acc[m][n]; u32x2 o; o.x = pk2(v.x + b, v.y + b); o.y = pk2(v.z + b, v.w + b); *(LAS u32x2*)(sa + r * 272 + (wc * 32 + n * 16 + fq * 4) * 2) = o; } }
        __syncthreads();
#pragma unroll
        for (int k = 0; k < 4; ++k) {
            const int idx = k * NTHR + tid, r = idx >> 4, c8 = (idx & 15) * 8;
            const u32x4 ov = *(LAS u32x4*)(sa + r * 272 + c8 * 2), uw = uc[k];
            u32x4 z; z.x = pk2(bflo(uw.x) * bflo(ov.x), bfhi(uw.x) * bfhi(ov.x)); z.y = pk2(bflo(uw.y) * bflo(ov.y), bfhi(uw.y) * bfhi(ov.y));
            z.z = pk2(bflo(uw.z) * bflo(ov.z), bfhi(uw.z) * bfhi(ov.z)); z.w = pk2(bflo(uw.w) * bflo(ov.w), bfhi(uw.w) * bfhi(ov.w));
            *(u32x4*)(z1 + (size_t)(R0 + r) * SW + g * 256 + nt * 128 + c8) = z;
        }
        __syncthreads();
    }
#undef SG_LOAD
}

template <class F> struct EpiP8 {
    static constexpr int PERM = 1; F f;
    __device__ __forceinline__ void operator()(const f32x4 (&acc)[2][2][4][2], const pg::Unit& u, int wr, int wc, int fr, int fq) const {
#pragma unroll
        for (int ai = 0; ai < 2; ++ai)
#pragma unroll
            for (int m = 0; m < 4; ++m)
#pragma unroll
                for (int bj = 0; bj < 2; ++bj) f(u, ai * 128 + wr * 64 + m * 16 + fr, bj * 128 + wc * 32 + 8 * fq, acc[ai][bj][m][0], acc[ai][bj][m][1]);
    }
};
template <class F> struct EpiP4 {
    static constexpr int PERM = 0; F f;
    __device__ __forceinline__ void operator()(const f32x4 (&acc)[2][2][4][2], const pg::Unit& u, int wr, int wc, int fr, int fq) const {
#pragma unroll
        for (int ai = 0; ai < 2; ++ai)
#pragma unroll
            for (int m = 0; m < 4; ++m)
#pragma unroll
                for (int bj = 0; bj < 2; ++bj)
#pragma unroll
                    for (int n = 0; n < 2; ++n) f(u, ai * 128 + wr * 64 + m * 16 + fr, bj * 128 + wc * 32 + 16 * n + 4 * fq, acc[ai][bj][m][n]);
    }
};
template <class F> __device__ __forceinline__ EpiP8<F> make_p8(F f) { return EpiP8<F>{f}; }
template <class F> __device__ __forceinline__ EpiP4<F> make_p4(F f) { return EpiP4<F>{f}; }
__device__ __forceinline__ f32x4 gelu4(f32x4 v) { return (f32x4){gelu_t(v.x), gelu_t(v.y), gelu_t(v.z), gelu_t(v.w)}; }

__device__ __forceinline__ void stg_sync() { asm volatile("s_waitcnt lgkmcnt(0)" ::: "memory"); __builtin_amdgcn_s_barrier(); asm volatile("" ::: "memory"); }
template <class RowPtr>
__device__ __forceinline__ void stg_step512(LAS unsigned char* stg, int wr, int wc, int fr, int fq, int o0, int o1, u32x4 p0, u32x4 p1, RowPtr rp) {
    LAS unsigned char* w = stg + (wr * 16 + fr) * 528;
    *(LAS u32x4*)(w + o0) = p0; *(LAS u32x4*)(w + o1) = p1;
    stg_sync();
    const int tid = (wr * 4 + wc) * 64 + fq * 16 + fr;
#pragma unroll
    for (int k = 0; k < 2; ++k) { const int idx = k * 512 + tid, rl = idx >> 5, c = idx & 31; const u32x4 v = *(LAS u32x4*)(stg + rl * 528 + c * 16); *(u32x4*)(rp(rl) + c * 16) = v; }
    stg_sync();
}
template <class RowPtr>
__device__ __forceinline__ void stg_step256(LAS unsigned char* stg, int wr, int wc, int fr, int fq, u32x4 p0, RowPtr rp) {
    *(LAS u32x4*)(stg + (wr * 16 + fr) * 272 + wc * 64 + fq * 16) = p0;
    stg_sync();
    const int tid = (wr * 4 + wc) * 64 + fq * 16 + fr, rl = tid >> 4, c = tid & 15;
    const u32x4 v = *(LAS u32x4*)(stg + rl * 272 + c * 16); *(u32x4*)(rp(rl) + c * 16) = v;
    stg_sync();
}
template <class Xf, class RowPtr> struct EpiStage {
    static constexpr int PERM = 1; LAS unsigned char* stg; Xf xf; RowPtr rowptr;
    __device__ __forceinline__ void operator()(const f32x4 (&acc)[2][2][4][2], const pg::Unit& u, int wr, int wc, int fr, int fq) const {
#pragma unroll
        for (int ai = 0; ai < 2; ++ai)
#pragma unroll
            for (int m = 0; m < 4; ++m) {
                const u32x4 p0 = xf(u, 0, wc, fq, acc[ai][0][m][0], acc[ai][0][m][1]), p1 = xf(u, 1, wc, fq, acc[ai][1][m][0], acc[ai][1][m][1]);
                stg_step512(stg, wr, wc, fr, fq, wc * 64 + fq * 16, 256 + wc * 64 + fq * 16, p0, p1,
                            [&](int rl) { return rowptr(u, ai * 128 + (rl >> 4) * 64 + m * 16 + (rl & 15)); });
            }
    }
};
template <class Xf, class RowPtr> __device__ __forceinline__ EpiStage<Xf, RowPtr> make_stage(LAS unsigned char* stg, Xf xf, RowPtr rp) { return EpiStage<Xf, RowPtr>{stg, xf, rp}; }
template <class Xf, class RowPtr> struct EpiDirect {
    static constexpr int PERM = 2; Xf xf; RowPtr rowptr;
    __device__ __forceinline__ void operator()(const f32x4 (&acc)[2][2][4][2], const pg::Unit& u, int wr, int wc, int fr, int fq) const {
#pragma unroll
        for (int ai = 0; ai < 2; ++ai)
#pragma unroll
            for (int m = 0; m < 4; ++m) {
                unsigned char* rp = rowptr(u, ai * 128 + wr * 64 + m * 16 + fr) + (64 * wc + 8 * fq) * 2;
                *(u32x4*)rp = xf(u, 0, wc, fq, acc[ai][0][m][0], acc[ai][0][m][1]);
                *(u32x4*)(rp + 64) = xf(u, 1, wc, fq, acc[ai][1][m][0], acc[ai][1][m][1]);
            }
    }
};
template <class Xf, class RowPtr> __device__ __forceinline__ EpiDirect<Xf, RowPtr> make_direct(Xf xf, RowPtr rp) { return EpiDirect<Xf, RowPtr>{xf, rp}; }

struct SchedIn0 {
    const char* A; const char* B; int G, c;
    __device__ __forceinline__ bool next(int i, pg::Unit& u) const {
        const int L = i * G + c; if (L >= 1300) return false;
        if (L < 1280) { const int wgid = pg::xcd_remap(L, 1280); u.pm = (wgid / 80) * 8 + (wgid % 80) % 8; u.pn = (wgid % 80) / 8; }
        else { const int q = L - 1280; u.pm = 128 + q / 5; u.pn = 5 + q % 5; }
        u.e = 0; u.rows = nullptr; u.a = A + (size_t)u.pm * 256 * D * 2; u.b = B + (size_t)u.pn * 256 * D * 2; return true;
    }
};
__device__ __forceinline__ void phase_inproj0_pg(const Params& p, LAS unsigned char* lds, int bid, int nblk) {
    unsigned char* ws = p.ws;
    unsigned char* gate0 = ws + B_GATE0; unsigned char* upre = ws + B_UPRE;
    SchedIn0 S{(const char*)(ws + OFF_HX), (const char*)(ws + W_AIN), nblk, bid};
    auto E = make_direct(
        [=](const pg::Unit& u, int bj, int wc, int fq, f32x4 v0, f32x4 v1) { return u.pn < 5 ? pack8(gelu4(v0), gelu4(v1)) : pack8(v0, v1); },
        [=](const pg::Unit& u, int r) { const size_t row = (size_t)u.pm * 256 + r; return u.pn < 5 ? gate0 + (row * RW + u.pn * 256) * 2 : upre + (row * RW + (u.pn - 5) * 256) * 2; });
    pg::gemm<false>(lds, D, D, D, S, E);
    if (bg_idle(1300, nblk, bid)) bg_convert(p, lds, 0, 4);
}
__device__ __forceinline__ void phase_outproj_pg(const Params& p, LAS unsigned char* lds, int bid, int nblk, const bf16_t* Z, int K, const bf16_t* W, const float* modl, unsigned char* dx) {
    pg::SchedPlain S{(const char*)Z, (const char*)W, K, K, 128, 4, 512, nblk, bid};
    auto E = make_direct(
        [=](const pg::Unit& u, int bj, int wc, int fq, f32x4 v0, f32x4 v1) {
            const float* g1 = modl + (size_t)(u.pm >> 5) * 6144 + 2048 + u.pn * 256 + wc * 64 + bj * 32 + 8 * fq;
            return pack8(v0 * *(const f32x4*)g1, v1 * *(const f32x4*)(g1 + 4)); },
        [=](const pg::Unit& u, int r) { return dx + (((size_t)u.pm * 256 + r) * D + u.pn * 256) * 2; });
    pg::gemm<false>(lds, K, K, K, S, E);
}
struct EpiIn1 {
    static constexpr int PERM = 2; unsigned char* uv; float* statp;
    __device__ __forceinline__ void operator()(const f32x4 (&acc)[2][2][4][2], const pg::Unit& u, int wr, int wc, int fr, int fq) const {
#pragma unroll
        for (int ai = 0; ai < 2; ++ai)
#pragma unroll
            for (int m = 0; m < 4; ++m) {
                const size_t row = (size_t)u.pm * 256 + ai * 128 + wr * 64 + m * 16 + fr;
                const u32x4 p0 = pack8(gelu4(acc[ai][0][m][0]), gelu4(acc[ai][0][m][1])), p1 = pack8(gelu4(acc[ai][1][m][0]), gelu4(acc[ai][1][m][1]));
                unsigned char* rp = uv + (row * 4096 + u.pn * 256 + 64 * wc + 8 * fq) * 2;
                *(u32x4*)rp = p0; *(u32x4*)(rp + 64) = p1;
                if (u.pn >= 8) {
                    float s = 0.f, q = 0.f;
#pragma unroll
                    for (int k = 0; k < 8; ++k) { const unsigned w = k < 4 ? p0[k] : p1[k - 4]; const float a = bflo(w), b = bfhi(w); s += a + b; q += a * a + b * b; }
                    s += __shfl_xor(s, 16); q += __shfl_xor(q, 16); s += __shfl_xor(s, 32); q += __shfl_xor(q, 32);
                    if (fq == 0) { float* sp = statp + (row * 32 + (u.pn - 8) * 4 + wc) * 2; sp[0] = s; sp[1] = q; }
                }
            }
    }
};
__device__ __forceinline__ void phase_inproj1_pg(const Params& p, LAS unsigned char* lds, int bid, int nblk) {
    unsigned char* ws = p.ws;
    pg::SchedPlain S{(const char*)(ws + OFF_HX), (const char*)(ws + W_BIN), D, D, 128, 16, 2048, nblk, bid};
    EpiIn1 E{ws + B_UV, (float*)(ws + OFF_STATP)};
    pg::gemm<false>(lds, D, D, D, S, E);
}

constexpr int MOE_T_SS = 131072, MOE_T_S0 = 131072 + 512, MOE_T_E = 131072 + 512 + 4864;
__device__ __forceinline__ int moe_meta(const Params& p, LAS unsigned char* lds) {
    LAS int* ss = (LAS int*)(lds + MOE_T_SS); LAS int* ts0 = (LAS int*)(lds + MOE_T_S0); LAS unsigned char* te = lds + MOE_T_E;
    const int* meta = (const int*)(p.ws + OFF_META);
    const int tid = opq_tid();
    if (tid < 66) ss[tid] = meta[tid];
    __syncthreads();
    const int ntile = ss[65] / TM;
    for (int t = tid; t < ntile; t += NTHR) {
        const int slot0 = t * TM; int e = 0;
        for (int q = 1; q < 65; ++q) e = (ss[q] <= slot0) ? q : e;
        ts0[t] = slot0; te[t] = (unsigned char)e;
    }
    __syncthreads();
    return ntile;
}
template <int NPN, bool GATHER>
struct SchedMoe {
    const char* A; const char* W; const int* tokof; const int* ident; LAS unsigned char* lds; int lda, wrows, wk, nunits, G, c;
    __device__ __forceinline__ bool next(int i, pg::Unit& u) const {
        const int L = i * G + c; if (L >= nunits) return false;
        const int wgid = pg::xcd_remap(L, nunits), tile = wgid / NPN;
        const int slot0 = __builtin_amdgcn_readfirstlane(((LAS int*)(lds + MOE_T_S0))[tile]);
        const int e = __builtin_amdgcn_readfirstlane((int)(lds + MOE_T_E)[tile]);
        const int ss64 = __builtin_amdgcn_readfirstlane(((LAS int*)(lds + MOE_T_SS))[64]);
        u.pm = slot0; u.pn = wgid % NPN; u.e = e;
        u.rows = e < 64 ? tokof + slot0 : ident + (slot0 - ss64);
        u.a = GATHER ? A : A + (size_t)slot0 * lda * 2;
        u.b = W + ((size_t)e * wrows + (size_t)u.pn * 256) * wk * 2;
        return true;
    }
};
__device__ __forceinline__ f32x4 silu4(f32x4 v) { return (f32x4){silu(v.x), silu(v.y), silu(v.z), silu(v.w)}; }
struct EpiUp {
    static constexpr int PERM = 1; unsigned char* hh; const float* wof; LAS unsigned char* stg;
    __device__ __forceinline__ void operator()(const f32x4 (&acc)[2][2][4][2], const pg::Unit& u, int wr, int wc, int fr, int fq) const {
        float w[8];
#pragma unroll
        for (int i = 0; i < 8; ++i) w[i] = u.e < 64 ? wof[u.pm + (i >> 2) * 128 + wr * 64 + (i & 3) * 16 + fr] : 1.0f;
#pragma unroll
        for (int ai = 0; ai < 2; ++ai)
#pragma unroll
            for (int m = 0; m < 4; ++m) {
                const float ww = w[ai * 4 + m];
                const u32x4 p0 = pack8(silu4(acc[ai][0][m][0]) * acc[ai][1][m][0] * ww, silu4(acc[ai][0][m][1]) * acc[ai][1][m][1] * ww);
                LAS unsigned char* sbuf = stg + ((ai * 4 + m) & 1) * 8704;
                *(LAS u32x4*)(sbuf + (wr * 16 + fr) * 272 + wc * 64 + fq * 16) = p0;
                stg_sync();
                { const int tid = (wr * 4 + wc) * 64 + fq * 16 + fr, rl = tid >> 4, c = tid & 15;
                  const u32x4 v = *(LAS u32x4*)(sbuf + rl * 272 + c * 16);
                  *(u32x4*)(hh + ((size_t)(u.pm + ai * 128 + (rl >> 4) * 64 + m * 16 + (rl & 15)) * EFF + u.pn * 128) * 2 + c * 16) = v; }
            }
    }
};
__device__ __forceinline__ void phase_moe_up(const Params& p, LAS unsigned char* lds, int bid, int nblk, int l) {
    unsigned char* ws = p.ws;
    const int ntile = moe_meta(p, lds);
    SchedMoe<2, true> S{(const char*)(ws + OFF_HX), (const char*)(ws + W_GU) + (size_t)l * 65 * 512 * 1024 * 2, (const int*)(ws + OFF_TOKOF), (const int*)(ws + OFF_IDENT), lds, D, 512, D, ntile * 2, nblk, bid};
    EpiUp E{ws + B_HH, (const float*)(ws + OFF_WOF), lds + STG_OFF};
    pg::gemm<true>(lds, D, D, D, S, E);
    if (l == 0 && bg_idle(ntile * 2, nblk, bid)) bg_convert(p, lds, 1, 3);
}
struct EpiDown {
    static constexpr int PERM = 1; LAS unsigned char* stg; unsigned char* Y; unsigned char* ys; int ss64;
    __device__ __forceinline__ void operator()(const f32x4 (&acc)[2][2][4][2], const pg::Unit& u, int wr, int wc, int fr, int fq) const {
        const int tid = (wr * 4 + wc) * 64 + fq * 16 + fr, rl = tid >> 4, c = tid & 15;
        unsigned char* base = u.e < 64 ? Y + ((size_t)u.pm * D + u.pn * 256) : ys + ((size_t)(u.pm - ss64) * D + u.pn * 256);
#pragma unroll
        for (int ai = 0; ai < 2; ++ai)
#pragma unroll
            for (int m = 0; m < 4; ++m) {
                LAS unsigned char* sbuf = stg + ((ai * 4 + m) & 1) * 8704;
                LAS unsigned char* w = sbuf + (wr * 16 + fr) * 272 + wc * 32 + fq * 8;
                *(LAS u32x2*)w = (u32x2){pk4_fp8(acc[ai][0][m][0]), pk4_fp8(acc[ai][0][m][1])};
                *(LAS u32x2*)(w + 128) = (u32x2){pk4_fp8(acc[ai][1][m][0]), pk4_fp8(acc[ai][1][m][1])};
                stg_sync();
                const u32x4 v = *(LAS u32x4*)(sbuf + rl * 272 + c * 16);
                *(u32x4*)(base + (size_t)(ai * 128 + (rl >> 4) * 64 + m * 16 + (rl & 15)) * D + c * 16) = v;
            }
    }
};
__device__ __forceinline__ void phase_moe_down(const Params& p, LAS unsigned char* lds, int bid, int nblk, int l) {
    unsigned char* ws = p.ws;
    const int ntile = moe_meta(p, lds);
    const int ss64 = ((LAS int*)(lds + MOE_T_SS))[64];
    SchedMoe<4, false> S{(const char*)(ws + B_HH), (const char*)(ws + W_DN) + (size_t)l * 65 * 1024 * 256 * 2, nullptr, nullptr, lds, EFF, 1024, EFF, ntile * 4, nblk, bid};
    EpiDown E{lds + STG_OFF, ws + B_YY, ws + B_YS, ss64};
    pg::gemm<false>(lds, EFF, EFF, EFF, S, E);
    if (l == 0 && bg_idle(ntile * 4, nblk, bid)) bg_convert(p, lds, 1, 1);
}

typedef _Float16 h16x2 __attribute__((ext_vector_type(2)));
__device__ __forceinline__ unsigned pkh2(float a, float b) { h16x2 v; v.x = (_Float16)a; v.y = (_Float16)b; return __builtin_bit_cast(unsigned, v); }
__device__ __forceinline__ float h2lo(unsigned w) { return (float)__builtin_bit_cast(h16x2, w).x; }
__device__ __forceinline__ float h2hi(unsigned w) { return (float)__builtin_bit_cast(h16x2, w).y; }
template <int CTRL> __device__ __forceinline__ float dppf(float oldv, float v) {
    return __builtin_bit_cast(float, __builtin_amdgcn_update_dpp(__builtin_bit_cast(int, oldv), __builtin_bit_cast(int, v), CTRL, 0xf, 0xf, false));
}
template <bool SHL> __device__ __forceinline__ void scan16(float& A, float& H) {
#define SC_STEP(N) { const float Ap = dppf<(SHL ? 0x100 : 0x110) + N>(1.0f, A); const float Hp = dppf<(SHL ? 0x100 : 0x110) + N>(0.0f, H); H = A * Hp + H; A = A * Ap; }
    SC_STEP(1) SC_STEP(2) SC_STEP(4) SC_STEP(8)
#undef SC_STEP
}
struct SchedGates {
    const char* U; const char* W; int G, c;
    __device__ __forceinline__ bool next(int i, pg::Unit& u) const {
        const int L = i * G + c; if (L >= 2640) return false;
        const int wgid = pg::xcd_remap(L, 2640), pm = wgid / 20, rem = wgid % 20, h = rem >> 2, q = rem & 3;
        u.pm = pm; u.pn = q; u.e = h; u.rows = nullptr;
        u.a = U + ((size_t)pm * 256 * RW + h * 256) * 2; u.b = W + ((size_t)h * 1024 + q * 256) * 256 * 2; return true;
    }
};
struct EpiGates {
    static constexpr int PERM = 0;
    const bf16_t* uu; const float* rbias; const float* ibias; const float* cdec; unsigned char* ab; LAS unsigned char* stg;
    __device__ __forceinline__ void operator()(const f32x4 (&acc)[2][2][4][2], const pg::Unit& u, int wr, int wc, int fr, int fq) const {
        const int ch0 = u.e * 256 + u.pn * 64 + 16 * wc + 4 * fq;
        const f32x4 rb0 = *(const f32x4*)(rbias + ch0), rb1 = *(const f32x4*)(rbias + RW + ch0), ib0 = *(const f32x4*)(ibias + ch0), ib1 = *(const f32x4*)(ibias + RW + ch0);
        const f32x4 cd0 = *(const f32x4*)(cdec + ch0), cd1 = *(const f32x4*)(cdec + RW + ch0);
        u32x2 uws[8];
#pragma unroll
        for (int i = 0; i < 8; ++i) uws[i] = *(const u32x2*)(uu + ((size_t)u.pm * 256 + (i >> 2) * 128 + wr * 64 + (i & 3) * 16 + fr) * RW + ch0);
#pragma unroll
        for (int ai = 0; ai < 2; ++ai)
#pragma unroll
            for (int m = 0; m < 4; ++m) {
                const int rl = ai * 128 + wr * 64 + m * 16 + fr; const size_t R = (size_t)u.pm * 256 + rl;
                const u32x2 uw = uws[ai * 4 + m];
                const float uv[4] = {bflo(uw.x), bfhi(uw.x), bflo(uw.y), bfhi(uw.y)};
                unsigned o[8];
#pragma unroll
                for (int gi = 0; gi < 4; ++gi) {
                    const f32x4 v = acc[ai][gi >> 1][m][gi & 1];
                    const float r0 = sigm(v.x + rb0[gi]), i0 = sigm(v.y + ib0[gi]), r1 = sigm(v.z + rb1[gi]), i1 = sigm(v.w + ib1[gi]);
                    const float la0 = r0 * cd0[gi], la1 = r1 * cd1[gi];
                    float a0 = __expf(la0), a1 = __expf(la1);
                    float m0 = __builtin_amdgcn_sqrtf(fmaxf(1.0f - a0 * a0, 0.0f)), m1 = __builtin_amdgcn_sqrtf(fmaxf(1.0f - a1 * a1, 0.0f));
                    if (u.pm >= 128) { if (rl == 0) m0 = 1.0f; if (rl == CTXL - 1) m1 = 1.0f; }
                    float h0 = m0 * i0 * uv[gi], h1 = m1 * i1 * uv[gi];
#define GS_STEP(N) asm volatile("s_nop 1\n\tv_fmac_f32_dpp %0, %0, %2 row_shr:" #N " row_mask:0xf bank_mask:0xf\n\tv_fmac_f32_dpp %1, %1, %3 row_shl:" #N " row_mask:0xf bank_mask:0xf\n\tv_mul_f32_dpp %2, %2, %2 row_shr:" #N " row_mask:0xf bank_mask:0xf\n\tv_mul_f32_dpp %3, %3, %3 row_shl:" #N " row_mask:0xf bank_mask:0xf" : "+v"(h0), "+v"(h1), "+v"(a0), "+v"(a1));
                    GS_STEP(1) GS_STEP(2) GS_STEP(4) GS_STEP(8)
#undef GS_STEP
                    o[gi * 2] = pkh2(a0, h0); o[gi * 2 + 1] = pkh2(a1, h1);
                }
                u32x4* dst = (u32x4*)(ab + (R * RW + ch0) * 8);
                dst[0] = (u32x4){o[0], o[1], o[2], o[3]}; dst[1] = (u32x4){o[4], o[5], o[6], o[7]};
            }
    }
};
__device__ __forceinline__ void phase_gates_pg(const Params& p, LAS unsigned char* lds, int bid, int nblk) {
    unsigned char* ws = p.ws;
    SchedGates S{(const char*)(ws + B_UU), (const char*)(ws + W_GATE), nblk, bid};
    EpiGates E{(const bf16_t*)(ws + B_UU), p.in[12], p.in[14], (const float*)(ws + OFF_CDEC), ws + B_AB, lds + STG_OFF};
    pg::gemm<false>(lds, 256, RW, 256, S, E);
    if (bg_idle(2640, nblk, bid)) bg_convert(p, lds, 0, 2);
}
__device__ __forceinline__ void phase_scan_sb(const Params& p, int bid, int nblk) {
    unsigned char* ws = p.ws;
    const unsigned* ab = (const unsigned*)(ws + B_AB); float* sbc = (float*)(ws + OFF_AGG);
    const int gt = bid * NTHR + opq_tid(), ngt = nblk * NTHR;
    for (int i = gt; i < 2 * 132 * RW; i += ngt) {
        const int d = i / (132 * RW), sb = (i / RW) % 132, ch = i % RW;
        float A = 1.0f, H = 0.0f;
#pragma unroll 16
        for (int j = 0; j < 16; ++j) {
            const int k = d == 0 ? j : 15 - j; const size_t row = (size_t)sb * 256 + 16 * k + (d == 0 ? 15 : 0);
            const unsigned w = ab[(row * RW + ch) * 2 + d];
            H = h2lo(w) * H + h2hi(w); A *= h2lo(w);
        }
        sbc[(size_t)i * 2] = A; sbc[(size_t)i * 2 + 1] = H;
    }
}
__device__ __forceinline__ void phase_scan_carry(const Params& p, int bid, int nblk) {
    unsigned char* ws = p.ws;
    const unsigned* ab = (const unsigned*)(ws + B_AB); const float* sbc = (const float*)(ws + OFF_AGG); float* car = (float*)(ws + B_CAR);
    const int gt = bid * NTHR + opq_tid(), ngt = nblk * NTHR;
    for (int i = gt; i < 2 * 128 * RW; i += ngt) {
        const int d = i / (128 * RW), sb = (i / RW) % 128, ch = i % RW, b = sb >> 5, sl = sb & 31;
        float c = sbc[((size_t)(d * 132 + 128 + b) * RW + ch) * 2 + 1];
        const int nprev = d == 0 ? sl : 31 - sl;
        for (int j = 0; j < nprev; ++j) {
            const int s2 = d == 0 ? b * 32 + j : b * 32 + 31 - j;
            const float* q = sbc + ((size_t)(d * 132 + s2) * RW + ch) * 2;
            c = q[0] * c + q[1];
        }
#pragma unroll 16
        for (int j = 0; j < 16; ++j) {
            const int k = d == 0 ? j : 15 - j; const size_t row = (size_t)sb * 256 + 16 * k + (d == 0 ? 15 : 0);
            car[((size_t)d * 2048 + sb * 16 + k) * RW + ch] = c;
            const unsigned w = ab[(row * RW + ch) * 2 + d];
            c = h2lo(w) * c + h2hi(w);
        }
    }
}
__device__ __forceinline__ void phase_scan_apply(const Params& p, int bid, int nblk) {
    unsigned char* ws = p.ws;
    const unsigned char* ab = ws + B_AB; const float* car = (const float*)(ws + B_CAR); const bf16_t* gate0 = (const bf16_t*)(ws + B_GATE0); bf16_t* z0 = (bf16_t*)(ws + B_Z0);
    const int gt = bid * NTHR + opq_tid(), ngt = nblk * NTHR;
    for (int item = gt; item < 2048 * 320; item += ngt) {
        const int blk = item / 320, c4 = (item % 320) * 4;
        const f32x4 cf = *(const f32x4*)(car + (size_t)blk * RW + c4), cb = *(const f32x4*)(car + ((size_t)2048 + blk) * RW + c4);
#pragma unroll 8
        for (int r = 0; r < 16; ++r) {
            const size_t e = ((size_t)blk * 16 + r) * RW + c4;
            const u32x4 w0 = *(const u32x4*)(ab + e * 8), w1 = *(const u32x4*)(ab + e * 8 + 16);
            const u32x2 g = *(const u32x2*)(gate0 + e);
            const float y0 = (h2hi(w0.x) + h2lo(w0.x) * cf.x) + (h2hi(w0.y) + h2lo(w0.y) * cb.x);
            const float y1 = (h2hi(w0.z) + h2lo(w0.z) * cf.y) + (h2hi(w0.w) + h2lo(w0.w) * cb.y);
            const float y2 = (h2hi(w1.x) + h2lo(w1.x) * cf.z) + (h2hi(w1.y) + h2lo(w1.y) * cb.z);
            const float y3 = (h2hi(w1.z) + h2lo(w1.z) * cf.w) + (h2hi(w1.w) + h2lo(w1.w) * cb.w);
            u32x2 o; o.x = pk2(bflo(g.x) * y0, bfhi(g.x) * y1); o.y = pk2(bflo(g.y) * y2, bfhi(g.y) * y3);
            *(u32x2*)(z0 + e) = o;
        }
    }
}

#define XB_TMO      128
#define XB_XCNT(j)  (256  + 64 * (j))
#define XB_XSUB(j)  (1280 + 64 * (j))
#define XB_XGEN(j)  (2304 + 64 * (j))
#define XB_TOP      3328
#define XB_TOPGEN   3392
#define XCD_BAR_WORDS 3456
#define XB_SPIN_CAP (1u << 18)
__device__ __forceinline__ unsigned xb_ld(unsigned* p)              { return __hip_atomic_load(p, __ATOMIC_RELAXED, __HIP_MEMORY_SCOPE_AGENT); }
__device__ __forceinline__ unsigned xb_add(unsigned* p, unsigned v) { return __hip_atomic_fetch_add(p, v, __ATOMIC_RELAXED, __HIP_MEMORY_SCOPE_AGENT); }
__device__ __forceinline__ unsigned xb_xcc_id() { return (unsigned)__builtin_amdgcn_s_getreg((3 << 11) | 20) & 0xFu; }
#define XB_SPIN(cond, bar) do { unsigned _sp = 0; while (cond) { __builtin_amdgcn_s_sleep(1); \
    if ((++_sp & 255u) == 0u) { if (xb_ld(&(bar)[XB_TMO])) break; if (_sp > XB_SPIN_CAP) { atomicAdd(&(bar)[XB_TMO], 1u); break; } } } } while (0)
struct XcdBarrier { unsigned* bar; unsigned x; volatile LAS unsigned* st; };
__device__ __forceinline__ XcdBarrier xcd_barrier_post(unsigned* bar, volatile LAS unsigned* st) {
    XcdBarrier b; b.bar = bar; b.x = xb_xcc_id(); b.st = st;
    if (threadIdx.x == 0) (void)xb_add(&bar[XB_XCNT(b.x)], 1u);
    return b;
}
__device__ __forceinline__ void xcd_barrier_complete(unsigned* bar, unsigned x, unsigned& nloc, unsigned& nx) {
    const unsigned G = gridDim.x * gridDim.y * gridDim.z;
    unsigned sum, cnt, mine, sp = 0u;
    for (;;) {
        sum = 0u; cnt = 0u; mine = 0u;
#pragma unroll
        for (unsigned j = 0; j < 16; ++j) { const unsigned c = xb_ld(&bar[XB_XCNT(j)]); sum += c; cnt += (c > 0u) ? 1u : 0u; mine = (j == x) ? c : mine; }
        if (sum == G) break;
        __builtin_amdgcn_s_sleep(1);
        if ((++sp & 255u) == 0u) { if (xb_ld(&bar[XB_TMO])) break; if (sp > XB_SPIN_CAP) { atomicAdd(&bar[XB_TMO], 1u); break; } }
    }
    nloc = mine > 0u ? mine : 1u; nx = cnt > 0u ? cnt : 1u;
}
__device__ __forceinline__ void xcd_barrier(const XcdBarrier& b) {
    asm volatile("s_waitcnt vmcnt(0)" ::: "memory");
    __syncthreads();
    if (threadIdx.x == 0) {
        unsigned* bar = b.bar;
        __builtin_amdgcn_s_waitcnt(0);
        unsigned nloc = b.st[0], nx = b.st[1];
        if (nloc == 0u) { xcd_barrier_complete(bar, b.x, nloc, nx); b.st[0] = nloc; b.st[1] = nx; }
        const unsigned old = xb_add(&bar[XB_XSUB(b.x)], 1u);
        const unsigned gen = old / nloc;
        if (old + 1u == (gen + 1u) * nloc) {
            __builtin_amdgcn_fence(__ATOMIC_RELEASE, "agent");
            asm volatile("s_waitcnt vmcnt(0)" ::: "memory");
            const unsigned og = xb_add(&bar[XB_TOP], 1u);
            const unsigned tg = og / nx;
            if (og + 1u == (tg + 1u) * nx) xb_add(&bar[XB_TOPGEN], 1u);
            else XB_SPIN(xb_ld(&bar[XB_TOPGEN]) == tg, bar);
            __builtin_amdgcn_fence(__ATOMIC_ACQUIRE, "agent");
            xb_add(&bar[XB_XGEN(b.x)], 1u);
            asm volatile("s_waitcnt vmcnt(0)" ::: "memory");
        } else {
            XB_SPIN(xb_ld(&bar[XB_XGEN(b.x)]) == gen, bar);
            __builtin_amdgcn_fence(__ATOMIC_ACQUIRE, "agent");
            asm volatile("s_waitcnt vmcnt(0)" ::: "memory");
        }
    }
    __syncthreads();
}

#ifndef PROBE_G
#define PROBE_G 0
#endif
#define PH(g, call) do { unsigned long long _t0 = 0; if (PROBE_G == (g)) _t0 = __builtin_amdgcn_s_memrealtime(); call; xcd_barrier(xb); if (PROBE_G == (g)) tacc += __builtin_amdgcn_s_memrealtime() - _t0; } while (0)
__global__ void __launch_bounds__(NTHR) mk_fwd(Params p) {
    extern __shared__ __attribute__((aligned(16))) unsigned char lds_raw[];
    LAS unsigned char* lds = (LAS unsigned char*)lds_raw;
    cg::grid_group grid = cg::this_grid();
    const int bid = blockIdx.x, nblk = gridDim.x;
    unsigned char* ws = p.ws;
    const float* mod0 = (const float*)(ws + OFF_MOD); const float* mod1 = mod0 + 5 * 6144;
    unsigned long long tacc = 0;
    { volatile LAS unsigned* st0 = (volatile LAS unsigned*)(lds + LDS_BYTES - 16); if (threadIdx.x < 4) st0[threadIdx.x] = 0u; }
    __syncthreads();
    XcdBarrier xb = xcd_barrier_post((unsigned*)ws, (volatile LAS unsigned*)(lds + LDS_BYTES - 16));
    { unsigned long long _t0 = 0; if (PROBE_G == 1) _t0 = __builtin_amdgcn_s_memrealtime();
      phase0(p, lds, bid, nblk);
      if (p.ws == nullptr) grid.sync();
      xcd_barrier(xb);
      if (PROBE_G == 1) tacc += __builtin_amdgcn_s_memrealtime() - _t0; }
    PH(2, (row_phase<0, false, false>(p, bid, nblk, p.in[6], mod0, 0, 1024, nullptr, nullptr)));
    PH(6, phase_inproj0_pg(p, lds, bid, nblk));
    PH(12, phase_conv(p, bid, nblk));
    PH(7, phase_gates_pg(p, lds, bid, nblk));
    PH(3, phase_scan_sb(p, bid, nblk));
    PH(3, phase_scan_carry(p, bid, nblk));
    PH(13, phase_scan_apply(p, bid, nblk));
    PH(6, phase_outproj_pg(p, lds, bid, nblk, (const bf16_t*)(ws + B_Z0), RW, (const bf16_t*)(ws + W_AOUT), mod0, ws + B_DX0));
    PH(4, phase_normroute(p, lds, bid, nblk, 0, p.in[7], mod0, (const bf16_t*)(ws + B_DX0)));
    PH(10, phase_scatter(p, lds, bid, nblk, 0));
    PH(8, phase_moe_up(p, lds, bid, nblk, 0));
    PH(9, phase_moe_down(p, lds, bid, nblk, 0));
    PH(2, (row_phase<2, false, false>(p, bid, nblk, p.in[6] + D, mod1, 0, 1024, mod0, nullptr)));
    PH(6, phase_inproj1_pg(p, lds, bid, nblk));
    PH(11, phase_sgu(p, lds, bid, nblk));
    PH(6, phase_outproj_pg(p, lds, bid, nblk, (const bf16_t*)(ws + B_Z1), SW, (const bf16_t*)(ws + W_BOUT), mod1, ws + B_DX1));
    PH(4, phase_normroute(p, lds, bid, nblk, 1, p.in[7] + D, mod1, (const bf16_t*)(ws + B_DX1)));
    PH(10, phase_scatter(p, lds, bid, nblk, 1));
    PH(8, phase_moe_up(p, lds, bid, nblk, 1));
    PH(9, phase_moe_down(p, lds, bid, nblk, 1));
    { unsigned long long _t0 = 0; if (PROBE_G == 2) _t0 = __builtin_amdgcn_s_memrealtime();
      row_phase<2, false, true>(p, bid, nblk, p.in[29], mod1, 0, 0, mod1, nullptr);
      if (PROBE_G == 2) tacc += __builtin_amdgcn_s_memrealtime() - _t0; }
    if (PROBE_G != 0 && bid == 0 && threadIdx.x == 0) {
        const unsigned long long t0 = __builtin_amdgcn_s_memrealtime();
        while (__builtin_amdgcn_s_memrealtime() - t0 < 3ull * tacc) __builtin_amdgcn_s_sleep(20);
    }
}

extern "C" void kernel_launch(void* const* d_in, const int* in_sizes, int n_in, void* d_out, int out_size, void* d_ws, size_t ws_size, hipStream_t stream) {
    static int grid_blocks = 0;
    if (grid_blocks == 0) {
        if (n_in != 30 || out_size != NTOK * D || ws_size < WS_NEED) { fprintf(stderr, "kernel_launch: unexpected shapes (n_in %d out %d ws %zu need %zu)\n", n_in, out_size, ws_size, (size_t)WS_NEED); grid_blocks = -1; return; }
        int dev = 0, cus = 0, per_cu = 0;
        (void)hipGetDevice(&dev);
        (void)hipDeviceGetAttribute(&cus, hipDeviceAttributeMultiprocessorCount, dev);
        if (hipFuncSetAttribute((const void*)mk_fwd, hipFuncAttributeMaxDynamicSharedMemorySize, LDS_BYTES) != hipSuccess) { fprintf(stderr, "kernel_launch: hipFuncSetAttribute failed\n"); grid_blocks = -1; return; }
        (void)hipOccupancyMaxActiveBlocksPerMultiprocessor(&per_cu, mk_fwd, NTHR, LDS_BYTES);
        if (per_cu < 1) per_cu = 1;
        if (per_cu > 2) per_cu = 2;
        grid_blocks = cus * per_cu;
        fprintf(stderr, "kernel_launch: cus %d per_cu %d grid %d\n", cus, per_cu, grid_blocks);
    }
    if (grid_blocks < 0) return;
    if (hipMemsetAsync(d_ws, 0, 65536, stream) != hipSuccess) { fprintf(stderr, "kernel_launch: memset failed\n"); return; }
    Params p{};
    for (int i = 0; i < 30; ++i) p.in[i] = (const float*)d_in[i];
    p.out = (float*)d_out; p.ws = (unsigned char*)d_ws;
    void* args[] = {&p};
    hipError_t e = hipLaunchCooperativeKernel((void*)mk_fwd, dim3(grid_blocks), dim3(NTHR), args, LDS_BYTES, stream);
    if (e != hipSuccess) fprintf(stderr, "cooperative launch failed: %s (grid %d)\n", hipGetErrorString(e), grid_blocks);
}
```

```cpp
#include <hip/hip_runtime.h>
#include <hip/hip_cooperative_groups.h>
#include <cstdio>
#include <cstdint>
namespace cg = cooperative_groups;

#define LAS __attribute__((address_space(3)))
typedef unsigned short bf16_t;
typedef short bf16x8 __attribute__((ext_vector_type(8)));
typedef float f32x4 __attribute__((ext_vector_type(4)));
typedef unsigned u32x4 __attribute__((ext_vector_type(4)));
typedef unsigned u32x2 __attribute__((ext_vector_type(2)));

constexpr int D = 1024, NB = 4, SEQ = 8192, NTOK = NB * SEQ, CTXL = 256, NCTX = NB * CTXL, NROW = NTOK + NCTX;
constexpr int RW = 1280;
constexpr int SW = 2048;
constexpr int NE = 64, TOPK = 8, EFF = 256;
constexpr int TM = 256;
constexpr int NSLOT = 278528;
constexpr int NTHR = 512;
constexpr int STG_OFF = 139264;
constexpr int LDS_BYTES = 157248;

constexpr size_t MiB = (size_t)1 << 20;
constexpr size_t OFF_MOD = 1 * MiB;
constexpr size_t OFF_POS = OFF_MOD + 262144;
constexpr size_t OFF_CDEC = OFF_POS + 262144;
constexpr size_t OFF_CNT = OFF_CDEC + 16384;
constexpr size_t OFF_META = OFF_CNT + 65536;
constexpr size_t OFF_IDENT = OFF_META + 4096 + 45056;
constexpr size_t OFF_AGG = 2 * MiB;
constexpr size_t OFF_CARRY = 8 * MiB;
constexpr size_t OFF_EIDX = 11 * MiB;
constexpr size_t OFF_GATEW = 12 * MiB;
constexpr size_t OFF_SLOTOF = 13 * MiB;
constexpr size_t OFF_TOKOF = 14 * MiB;
constexpr size_t OFF_WOF = 16 * MiB;
constexpr size_t OFF_CNTW2 = 17 * MiB + 512 * 1024;
constexpr size_t OFF_W = 18 * MiB;
constexpr size_t W_AIN = OFF_W;
constexpr size_t W_AOUT = W_AIN + (size_t)2560 * 1024 * 2;
constexpr size_t W_GATE = W_AOUT + (size_t)1024 * 1280 * 2;
constexpr size_t W_BIN = W_GATE + (size_t)5 * 1024 * 256 * 2;
constexpr size_t W_BOUT = W_BIN + (size_t)4096 * 1024 * 2;
constexpr size_t W_S = W_BOUT + (size_t)1024 * 2048 * 2;
constexpr size_t W_RT = W_S + (size_t)8 * 128 * 128 * 2;
constexpr size_t W_GU = W_RT + (size_t)2 * 128 * 3072 * 2;
constexpr size_t W_DN = W_GU + (size_t)2 * 65 * 512 * 1024 * 2;
constexpr size_t W_END = W_DN + (size_t)2 * 65 * 1024 * 256 * 2;
constexpr size_t OFF_HX = 237 * MiB;
constexpr size_t OFF_BIG = OFF_HX + 66 * MiB;
constexpr size_t OFF_STATP = OFF_BIG + 320 * MiB;
constexpr size_t B_GATE0 = OFF_BIG;
constexpr size_t B_UPRE = OFF_BIG + 80 * MiB;
constexpr size_t B_UU = OFF_BIG + 163 * MiB;
constexpr size_t B_Z0 = OFF_BIG + 246 * MiB;
constexpr size_t B_AB = OFF_BIG + 326 * MiB;
constexpr size_t B_CAR = OFF_BIG + 80 * MiB;
constexpr size_t B_DX0 = OFF_BIG + 326 * MiB;
constexpr size_t B_DX1 = OFF_BIG + 256 * MiB;
constexpr size_t B_UV = OFF_BIG;
constexpr size_t B_VNT = OFF_BIG + 256 * MiB;
constexpr size_t B_Z1 = OFF_BIG + 384 * MiB;
constexpr size_t B_HLO = OFF_BIG;
constexpr size_t B_HH = OFF_BIG;
constexpr size_t B_YY = OFF_BIG + 160 * MiB;
constexpr size_t B_YS = OFF_BIG + 448 * MiB;
constexpr size_t B_XR = OFF_BIG + 656 * MiB;
constexpr size_t WS_NEED = OFF_BIG + 720 * MiB;
static_assert(W_END <= OFF_HX, "weights overflow");
static_assert((size_t)(NSLOT + NTOK) * 256 * 2 <= 160 * MiB, "H overflow");
static_assert((size_t)NSLOT * 1024 * 2 <= 544 * MiB, "Y overflow");
static_assert(WS_NEED <= 1024 * MiB, "ws overflow");
constexpr long LO_DELTA = (long)((B_HLO - OFF_HX) / 2);

__device__ __forceinline__ unsigned f2bf(float f) { unsigned u = __builtin_bit_cast(unsigned, f); return (u + 0x7fffu + ((u >> 16) & 1u)) >> 16; }
__device__ __forceinline__ unsigned pk2(float lo, float hi) { unsigned r; asm volatile("v_cvt_pk_bf16_f32 %0, %1, %2" : "=v"(r) : "v"(lo), "v"(hi)); return r; }
__device__ __forceinline__ float bf2f(unsigned b) { return __builtin_bit_cast(float, b << 16); }
__device__ __forceinline__ float bflo(unsigned w) { return __builtin_bit_cast(float, w << 16); }
__device__ __forceinline__ float bfhi(unsigned w) { return __builtin_bit_cast(float, w & 0xffff0000u); }
__device__ __forceinline__ float sigm(float x) { return __builtin_amdgcn_rcpf(1.0f + __expf(-x)); }
__device__ __forceinline__ float silu(float x) { return x * __builtin_amdgcn_rcpf(1.0f + __expf(-x)); }
__device__ __forceinline__ float gelu_t(float x) { const float y = 1.5957691216057308f * (x + 0.044715f * x * x * x); return x * __builtin_amdgcn_rcpf(1.0f + __expf(-y)); }
template <int CTRL> __device__ __forceinline__ float dpp_mv(float v) { return __builtin_bit_cast(float, __builtin_amdgcn_update_dpp(__builtin_bit_cast(int, v), __builtin_bit_cast(int, v), CTRL, 0xf, 0xf, false)); }
template <int CTRL> __device__ __forceinline__ int dpp_mvi(int v) { return __builtin_amdgcn_update_dpp(v, v, CTRL, 0xf, 0xf, false); }
__device__ __forceinline__ float wave_sum(float v) {
    v += dpp_mv<0xB1>(v); v += dpp_mv<0x4E>(v); v += dpp_mv<0x141>(v); v += dpp_mv<0x140>(v);
    const int b = __builtin_bit_cast(int, v);
    return (__builtin_bit_cast(float, __builtin_amdgcn_readlane(b, 0)) + __builtin_bit_cast(float, __builtin_amdgcn_readlane(b, 16)))
         + (__builtin_bit_cast(float, __builtin_amdgcn_readlane(b, 32)) + __builtin_bit_cast(float, __builtin_amdgcn_readlane(b, 48)));
}
__device__ __forceinline__ float max8(float v) { v = fmaxf(v, dpp_mv<0xB1>(v)); v = fmaxf(v, dpp_mv<0x4E>(v)); return fmaxf(v, dpp_mv<0x141>(v)); }
__device__ __forceinline__ int min8(int v) { v = min(v, dpp_mvi<0xB1>(v)); v = min(v, dpp_mvi<0x4E>(v)); return min(v, dpp_mvi<0x141>(v)); }

__device__ __forceinline__ int opq_tid() { int t = threadIdx.x; asm volatile("" : "+v"(t)); return t; }
__device__ __forceinline__ u32x4 pack8(f32x4 a, f32x4 b) { u32x4 w; w.x = pk2(a.x, a.y); w.y = pk2(a.z, a.w); w.z = pk2(b.x, b.y); w.w = pk2(b.z, b.w); return w; }
__device__ __forceinline__ unsigned pk4_fp8(f32x4 v) { int w = 0; w = __builtin_amdgcn_cvt_pk_fp8_f32(v.x, v.y, w, false); w = __builtin_amdgcn_cvt_pk_fp8_f32(v.z, v.w, w, true); return (unsigned)w; }
__device__ __forceinline__ f32x4 up4_fp8(unsigned w) { return (f32x4){__builtin_amdgcn_cvt_f32_fp8((int)w, 0), __builtin_amdgcn_cvt_f32_fp8((int)w, 1), __builtin_amdgcn_cvt_f32_fp8((int)w, 2), __builtin_amdgcn_cvt_f32_fp8((int)w, 3)}; }
struct Params { const float* in[30]; float* out; unsigned char* ws; };

struct KDef { __device__ __forceinline__ long operator()(int kt) const { return (long)kt * 32; } };

template <class KOffA, class Epi>
__device__ __forceinline__ void gemm_tile(const bf16_t* arow, const bf16_t* brow, int nk, KOffA koffa, Epi epi, LAS unsigned char* lds) {
    const int tid = opq_tid(), lane = tid & 63, wid = tid >> 6, wr = wid >> 2, wc = wid & 3, fr = lane & 15, fq = lane >> 4;
    const int sw = (tid >> 2) * 80 + (tid & 3) * 16;
    f32x4 acc[4][2];
#pragma unroll
    for (int m = 0; m < 4; ++m)
#pragma unroll
        for (int n = 0; n < 2; ++n) acc[m][n] = (f32x4){0.f, 0.f, 0.f, 0.f};
    u32x4 ra = *(const u32x4*)(arow + koffa(0));
    u32x4 rb = *(const u32x4*)(brow);
    const int aoff = (wr * 64 + fr) * 80 + fq * 16, boff = 10240 + (wc * 32 + fr) * 80 + fq * 16;
    for (int kt = 0; kt < nk; ++kt) {
        LAS unsigned char* buf = lds + (kt & 1) * 20480;
        *(LAS u32x4*)(buf + sw) = ra;
        *(LAS u32x4*)(buf + 10240 + sw) = rb;
        __syncthreads();
        if (kt + 1 < nk) { ra = *(const u32x4*)(arow + koffa(kt + 1)); rb = *(const u32x4*)(brow + (long)(kt + 1) * 32); }
        bf16x8 af[4], bfv[2];
#pragma unroll
        for (int m = 0; m < 4; ++m) af[m] = *(LAS bf16x8*)(buf + aoff + m * 1280);
#pragma unroll
        for (int n = 0; n < 2; ++n) bfv[n] = *(LAS bf16x8*)(buf + boff + n * 1280);
#pragma unroll
        for (int m = 0; m < 4; ++m)
#pragma unroll
            for (int n = 0; n < 2; ++n) acc[m][n] = __builtin_amdgcn_mfma_f32_16x16x32_bf16(bfv[n], af[m], acc[m][n], 0, 0, 0);
    }
    __syncthreads();
#pragma unroll
    for (int m = 0; m < 4; ++m)
#pragma unroll
        for (int n = 0; n < 2; ++n) epi(wr * 64 + m * 16 + fr, wc * 32 + n * 16 + fq * 4, acc[m][n]);
}

namespace pg {
constexpr int BM = 256, BK = 64, HALF = 128, HTB = HALF * BK * 2, STAGE_BYTES = 8 * HTB;
__device__ __forceinline__ int lds_byte(int r, int c) { const int st = (r >> 4) * 2 + (c >> 5), rr = r & 15, cc = c & 31, ob = rr * 64 + cc * 2; return st * 1024 + (ob ^ (((ob >> 9) & 1) << 5)); }
__device__ __forceinline__ void stage_rc(int b, int& R, int& C) { const int st = b / 1024, sb = b % 1024, swz = sb ^ (((sb >> 9) & 1) << 5); R = (st >> 1) * 16 + swz / 64; C = (st & 1) * 32 + (swz % 64) / 2; }
__device__ __forceinline__ int perm32(int rho) { const int n = rho >> 4, i = rho & 15; return 8 * (i >> 2) + 4 * n + (i & 3); }
__device__ __forceinline__ int xcd_remap(int L, int nwg) { const int q = nwg / 8, r = nwg % 8, xcd = L % 8, off = L / 8; return (xcd < r ? xcd * (q + 1) : r * (q + 1) + (xcd - r) * q) + off; }

struct Unit { const char* a; const char* b; const int* rows; int pm, pn, e; };

template <bool GATHER, class Sched, class Epi>
__device__ __forceinline__ void gemm(LAS unsigned char* lds, const int K, const int lda, const int ldb, const Sched& S, const Epi& E) {
    const int tid = opq_tid(), wid = __builtin_amdgcn_readfirstlane(tid >> 6), lane = tid & 63, wr = wid >> 2, wc = wid & 3, fr = lane & 15, fq = lane >> 4;
    const int nt = K / BK;
    int RA[2]; unsigned ca2[2], voffB[2][2];
#pragma unroll
    for (int i = 0; i < 2; ++i) { int R, C; stage_rc(tid * 16 + i * 8192, R, C);
        RA[i] = R; ca2[i] = (unsigned)C * 2u;
#pragma unroll
        for (int h = 0; h < 2; ++h) {
            const int Rb = (int)Epi::PERM == 2 ? 64 * (R >> 5) + 32 * h + perm32(R & 31) : HALF * h + ((int)Epi::PERM == 1 ? ((R & ~31) + perm32(R & 31)) : R);
            voffB[h][i] = (unsigned)(Rb * ldb + C) * 2u; } }
    const unsigned lda2 = (unsigned)lda * 2u;
    const size_t kstep = (size_t)(BK * 2);
    const unsigned ldsw = (unsigned)wid * 1024u;
    const int aoff = lds_byte(wr * 64 + fr, fq * 8), boff = lds_byte(wc * 32 + fr, fq * 8);
    unsigned vc[2][2], vn[2][2];
#define PG_SA(b, h) (((b) * 2 + (h)) * HTB)
#define PG_SB(b, h) ((4 + (b) * 2 + (h)) * HTB)
#define PG_GL(bufoff, gp0, gp1) do { \
        __builtin_amdgcn_global_load_lds((const unsigned*)(gp0), (LAS unsigned*)(lds + (bufoff) + ldsw), 16, 0, 0); \
        __builtin_amdgcn_global_load_lds((const unsigned*)(gp1), (LAS unsigned*)(lds + (bufoff) + ldsw + 8192), 16, 0, 0); } while (0)
#define PG_STB(bufoff, gbase, h) PG_GL(bufoff, (const char*)(gbase) + voffB[h][0], (const char*)(gbase) + voffB[h][1])
#define PG_STA(bufoff, gbase, V, h) PG_GL(bufoff, (const char*)(gbase) + V[h][0], (const char*)(gbase) + V[h][1])
#define PG_LDA(dst, b, h) do { _Pragma("unroll") for (int m = 0; m < 4; ++m) _Pragma("unroll") for (int k = 0; k < 2; ++k) dst[m][k] = *(const LAS bf16x8*)(lds + PG_SA(b, h) + aoff + m * 2048 + k * 1024); } while (0)
#define PG_LDB(dst, b, h) do { _Pragma("unroll") for (int n = 0; n < 2; ++n) _Pragma("unroll") for (int k = 0; k < 2; ++k) dst[n][k] = *(const LAS bf16x8*)(lds + PG_SB(b, h) + boff + n * 2048 + k * 1024); } while (0)
#define PG_MMA(ai, bj, At, Bt) do { __builtin_amdgcn_s_setprio(1); _Pragma("unroll") for (int m = 0; m < 4; ++m) _Pragma("unroll") for (int n = 0; n < 2; ++n) _Pragma("unroll") for (int k = 0; k < 2; ++k) \
        acc[ai][bj][m][n] = __builtin_amdgcn_mfma_f32_16x16x32_bf16(Bt[n][k], At[m][k], acc[ai][bj][m][n], 0, 0, 0); __builtin_amdgcn_s_setprio(0); } while (0)
#define PG_WAIT_V(n) asm volatile("s_waitcnt vmcnt(" #n ")" ::: "memory")
#define PG_WAIT_L(n) asm volatile("s_waitcnt lgkmcnt(" #n ")" ::: "memory")
#define PG_BAR __builtin_amdgcn_s_barrier()
#define PG_SCHED __builtin_amdgcn_sched_barrier(0)
#define PG_SETOFF(V, U) do { _Pragma("unroll") for (int h = 0; h < 2; ++h) _Pragma("unroll") for (int i = 0; i < 2; ++i) \
        V[h][i] = (GATHER ? (unsigned)(U).rows[RA[i] + HALF * h] : (unsigned)(RA[i] + HALF * h)) * lda2 + ca2[i]; } while (0)
    Unit cur, nxt; int ui = 0;
    if (!S.next(0, cur)) return;
    PG_SETOFF(vc, cur);
    f32x4 acc[2][2][4][2];
#pragma unroll
    for (int a = 0; a < 2; ++a)
#pragma unroll
        for (int b = 0; b < 2; ++b)
#pragma unroll
            for (int m = 0; m < 4; ++m)
#pragma unroll
                for (int n = 0; n < 2; ++n) acc[a][b][m][n] = (f32x4){0.f, 0.f, 0.f, 0.f};
    bf16x8 At[4][2], B0[2][2], B1[2][2];
    const char* cA = cur.a; const char* cB = cur.b;
    PG_STB(PG_SB(0, 0), cB, 0); PG_STB(PG_SB(0, 1), cB, 1); PG_STA(PG_SA(0, 0), cA, vc, 0); PG_STA(PG_SA(0, 1), cA, vc, 1);
    if (wr == 1) PG_BAR;
    PG_WAIT_V(2); PG_BAR;
    PG_STB(PG_SB(1, 0), cB + kstep, 0); PG_STA(PG_SA(1, 0), cA + kstep, vc, 0); PG_STB(PG_SB(1, 1), cB + kstep, 1);
    PG_WAIT_V(6); PG_BAR;
#define PG_PAIR(a1, a2, b2, a3, b3, SWAP) do { \
        PG_LDB(B0, 0, 0); PG_LDB(B1, 0, 1); PG_SCHED; PG_LDA(At, 0, 0); PG_STA(PG_SA(1, 1), a1, vc, 1); \
        if (GATHER) { if (SWAP) { vc[0][0] = vn[0][0]; vc[0][1] = vn[0][1]; vc[1][0] = vn[1][0]; vc[1][1] = vn[1][1]; } } \
        PG_WAIT_V(8); PG_WAIT_L(0); PG_BAR; PG_MMA(0, 0, At, B0); PG_MMA(0, 1, At, B1); PG_BAR; PG_SCHED; \
        PG_LDA(At, 0, 1); PG_STB(PG_SB(0, 0), b2, 0); PG_STB(PG_SB(0, 1), b2, 1); PG_STA(PG_SA(0, 0), a2, vc, 0); \
        PG_WAIT_V(8); PG_WAIT_L(0); PG_BAR; PG_MMA(1, 0, At, B0); PG_MMA(1, 1, At, B1); PG_BAR; PG_SCHED; \
        PG_LDB(B0, 1, 0); PG_LDB(B1, 1, 1); PG_SCHED; PG_LDA(At, 1, 0); PG_STA(PG_SA(0, 1), a2, vc, 1); \
        PG_WAIT_V(8); PG_WAIT_L(0); PG_BAR; PG_MMA(0, 0, At, B0); PG_MMA(0, 1, At, B1); PG_BAR; PG_SCHED; \
        PG_LDA(At, 1, 1); PG_STB(PG_SB(1, 0), b3, 0); PG_STB(PG_SB(1, 1), b3, 1); PG_STA(PG_SA(1, 0), a3, vc, 0); \
        PG_WAIT_V(8); PG_WAIT_L(0); PG_BAR; PG_MMA(1, 0, At, B0); PG_MMA(1, 1, At, B1); PG_BAR; PG_SCHED; } while (0)
    for (;;) {
        const bool has_next = S.next(ui + 1, nxt);
        const char* nA = has_next ? nxt.a : cA; const char* nB = has_next ? nxt.b : cB;
        if (GATHER) { if (has_next) { PG_SETOFF(vn, nxt); } }
#pragma nounroll
        for (int t = 0; t < nt; t += 2) {
            const bool last = (t == nt - 2);
            const char* a1 = cA + (size_t)(t + 1) * kstep;
            const char* a2 = last ? nA : cA + (size_t)(t + 2) * kstep; const char* b2 = last ? nB : cB + (size_t)(t + 2) * kstep;
            const char* a3 = a2 + kstep; const char* b3 = b2 + kstep;
            PG_PAIR(a1, a2, b2, a3, b3, (last && has_next));
        }
        if (wr == 0) PG_BAR;
        { int efr = fr, efq = fq; asm volatile("" : "+v"(efr), "+v"(efq)); E(acc, cur, wr, wc, efr, efq); }
        if (!has_next) break;
#pragma unroll
        for (int a = 0; a < 2; ++a)
#pragma unroll
            for (int b = 0; b < 2; ++b)
#pragma unroll
                for (int m = 0; m < 4; ++m)
#pragma unroll
                    for (int n = 0; n < 2; ++n) acc[a][b][m][n] = (f32x4){0.f, 0.f, 0.f, 0.f};
        cur = nxt; cA = nA; cB = nB; ++ui;
        if (wr == 1) PG_BAR;
    }
    PG_WAIT_V(0);
    PG_BAR;
#undef PG_SA
#undef PG_SB
#undef PG_GL
#undef PG_STB
#undef PG_STA
#undef PG_LDA
#undef PG_LDB
#undef PG_MMA
#undef PG_WAIT_V
#undef PG_WAIT_L
#undef PG_BAR
#undef PG_SCHED
#undef PG_SETOFF
#undef PG_PAIR
}

struct SchedPlain {
    const char* A; const char* B; int lda, ldb, nM, nN, nwg, G, c;
    __device__ __forceinline__ bool next(int i, Unit& u) const {
        const long L = (long)i * G + c; if (L >= nwg) return false;
        const int wgid = xcd_remap((int)L, nwg);
        const int nig = 8 * nN, gid = wgid / nig, fm = gid * 8, gsz = (nM - fm) < 8 ? (nM - fm) : 8;
        u.pm = fm + ((wgid % nig) % gsz); u.pn = (wgid % nig) / gsz; u.e = 0; u.rows = nullptr;
        u.a = A + (size_t)u.pm * BM * lda * 2; u.b = B + (size_t)u.pn * BM * ldb * 2; return true;
    }
};
}

__device__ __forceinline__ void tr_item(const float* W, int N, int k0, int n0, bf16_t* WT, int ldt, int mode, int rmul, int radd, LAS float* scr, int lane) {
    f32x4 t[16];
#pragma unroll
    for (int i = 0; i < 16; ++i) t[i] = *(const f32x4*)(W + (size_t)(k0 + (lane >> 4) + 4 * i) * N + n0 + (lane & 15) * 4);
#pragma unroll
    for (int i = 0; i < 16; ++i) { LAS float* d = scr + ((lane >> 4) + 4 * i) * 65 + (lane & 15) * 4; d[0] = t[i].x; d[1] = t[i].y; d[2] = t[i].z; d[3] = t[i].w; }
    asm volatile("s_waitcnt lgkmcnt(0)" ::: "memory");
    const int c = lane & 7;
#pragma unroll
    for (int j = 0; j < 8; ++j) {
        const int n = (lane >> 3) + 8 * j; const LAS float* s = scr + (8 * c) * 65 + n;
        u32x4 o; o.x = pk2(s[0 * 65], s[1 * 65]); o.y = pk2(s[2 * 65], s[3 * 65]); o.z = pk2(s[4 * 65], s[5 * 65]); o.w = pk2(s[6 * 65], s[7 * 65]);
        const int ng = n0 + n;
        const int drow = mode == 1 ? (((ng & 255) >> 7) * 256 + (ng >> 8) * 128 + (ng & 127))
                       : mode == 2 ? ((ng >> 6) * 256 + ((ng >> 1) & 1) * 128 + ((ng >> 4) & 3) * 32 + (ng & 1) * 16 + ((ng >> 2) & 3) * 4 + radd) : ng * rmul + radd;
        *(u32x4*)(WT + (size_t)drow * ldt + k0 + 8 * c) = o;
    }
    asm volatile("s_waitcnt lgkmcnt(0)" ::: "memory");
}

__device__ __forceinline__ void phase0(const Params& p, LAS unsigned char* lds, int bid, int nblk) {
    const int tid = opq_tid(), lane = tid & 63, wid = tid >> 6;
    unsigned char* ws = p.ws;
    const int gt = bid * NTHR + tid, ngt = nblk * NTHR;
    float* pos = (float*)(ws + OFF_POS);
    for (int i = gt; i < 128 * 512; i += ngt) {
        const int r = i >> 9, c = i & 511, q = c & 255;
        const float omega = 1.0f / exp2f((float)q * (13.287712379549449f / 256.0f));
        const float ang = (float)r * omega;
        pos[i] = c < 256 ? __sinf(ang) : __cosf(ang);
    }
    float* cdec = (float*)(ws + OFF_CDEC);
    for (int i = gt; i < 2 * RW; i += ngt) cdec[i] = -8.0f * log1pf(expf(-p.in[15][i]));
    { int* ident = (int*)(ws + OFF_IDENT); for (int i = gt; i < NTOK; i += ngt) ident[i] = i; }
    {
        bf16_t* ws_s = (bf16_t*)(ws + W_S);
        for (int i = gt; i < 8 * 128 * 128; i += ngt) ws_s[i] = (bf16_t)f2bf(p.in[20][i]);
        bf16_t* wrt = (bf16_t*)(ws + W_RT);
        for (int i = gt; i < 2 * 1024 * 64; i += ngt) {
            const int l = i >> 16, k = (i >> 6) & 1023, e = i & 63;
            const float w = p.in[23][i];
            const unsigned hi = f2bf(w); const unsigned lo = f2bf(w - bf2f(hi));
            bf16_t* row = wrt + ((size_t)(l * 128 + e)) * 3072;
            row[k] = (bf16_t)hi; row[1024 + k] = (bf16_t)hi; row[2048 + k] = (bf16_t)lo;
        }
        unsigned* wz = (unsigned*)wrt;
        for (int i = gt; i < 2 * 64 * 1536; i += ngt) { const int l = i / (64 * 1536), r = i % (64 * 1536); wz[(size_t)(l * 128 + 64) * 1536 + r] = 0u; }
    }
    for (int it = bid; it < 192; it += nblk) {
        LAS float* sv = (LAS float*)lds;
        LAS float* red = (LAS float*)(lds + 20480);
        for (int i = tid; i < 5 * 1024; i += NTHR) { const float cv = i < 4096 ? p.in[1][i] : p.in[3][i - 4096]; sv[i] = silu(cv); }
        __syncthreads();
        const int l = it / 96, col0 = (it % 96) * 64;
        const float* w = p.in[4] + (size_t)l * 1024 * 6144 + col0 + lane;
        float a0 = 0.f, a1 = 0.f, a2 = 0.f, a3 = 0.f, a4 = 0.f;
        const int kb = wid * 128;
        for (int k0 = kb; k0 < kb + 128; k0 += 32) {
            float wv[32];
#pragma unroll
            for (int i = 0; i < 32; ++i) wv[i] = w[(size_t)(k0 + i) * 6144];
#pragma unroll
            for (int i = 0; i < 32; ++i) { const int k = k0 + i;
                a0 += sv[k] * wv[i]; a1 += sv[1024 + k] * wv[i]; a2 += sv[2048 + k] * wv[i]; a3 += sv[3072 + k] * wv[i]; a4 += sv[4096 + k] * wv[i]; }
        }
        red[(wid * 5 + 0) * 64 + lane] = a0; red[(wid * 5 + 1) * 64 + lane] = a1; red[(wid * 5 + 2) * 64 + lane] = a2;
        red[(wid * 5 + 3) * 64 + lane] = a3; red[(wid * 5 + 4) * 64 + lane] = a4;
        __syncthreads();
        if (tid < 320) {
            const int v = tid >> 6, ln = tid & 63; float s = 0.f;
#pragma unroll
            for (int w8 = 0; w8 < 8; ++w8) s += red[(w8 * 5 + v) * 64 + ln];
            ((float*)(ws + OFF_MOD))[(size_t)(l * 5 + v) * 6144 + col0 + ln] = s + p.in[5][l * 6144 + col0 + ln];
        }
        __syncthreads();
    }
    LAS float* scr = (LAS float*)(lds + wid * 16640);
    const int gw = bid * 8 + wid, ngw = nblk * 8;
    constexpr int I_AIN = 16 * 40, I_AOUT = 20 * 16, I_GATE = 20 * 16, I_BIN = 16 * 64, I_BOUT = 32 * 16;
    constexpr int NITEMS = I_AIN + I_AOUT + I_GATE + I_BIN + I_BOUT;
    for (int it = gw; it < NITEMS; it += ngw) {
        int r = it;
        if (r < I_AIN) { const int kb = r / 40, nb = r % 40; tr_item(p.in[8], 2560, kb * 64, nb * 64, (bf16_t*)(ws + W_AIN), 1024, 0, 1, 0, scr, lane); continue; }
        r -= I_AIN;
        if (r < I_AOUT) { const int kb = r / 16, nb = r % 16; tr_item(p.in[16], 1024, kb * 64, nb * 64, (bf16_t*)(ws + W_AOUT), 1280, 0, 1, 0, scr, lane); continue; }
        r -= I_AOUT;
        if (r < I_GATE) {
            const int mi = r >> 4, q = r & 15, kb = q >> 2, nb = q & 3, h = mi % 5, dg = mi / 5, d = dg >> 1, g = dg & 1;
            const float* src = (g ? p.in[13] : p.in[11]) + (size_t)(d * 5 + h) * 65536;
            tr_item(src, 256, kb * 64, nb * 64, (bf16_t*)(ws + W_GATE) + (size_t)h * 1024 * 256, 256, 2, 4, d * 2 + g, scr, lane); continue; }
        r -= I_GATE;
        if (r < I_BIN) { const int kb = r / 64, nb = r % 64; tr_item(p.in[17], 4096, kb * 64, nb * 64, (bf16_t*)(ws + W_BIN), 1024, 0, 1, 0, scr, lane); continue; }
        r -= I_BIN;
        { const int kb = r / 16, nb = r % 16; tr_item(p.in[22], 1024, kb * 64, nb * 64, (bf16_t*)(ws + W_BOUT), 2048, 0, 1, 0, scr, lane); }
    }
}

constexpr int BG_TILES = 65 * 128 + 65 * 64, BG_CHUNKS = BG_TILES / 8;
__device__ __forceinline__ void bg_tile(const Params& p, int l, int t, LAS float* scr, int lane) {
    unsigned char* ws = p.ws;
    if (t < 65 * 128) { const int e = t >> 7, q = t & 127, kb = q >> 3, nb = q & 7, le = l * 65 + e;
        const float* src = e < 64 ? p.in[25] + (size_t)(l * 64 + e) * 1024 * 512 : p.in[27] + (size_t)l * 1024 * 512;
        tr_item(src, 512, kb * 64, nb * 64, (bf16_t*)(ws + W_GU) + (size_t)le * 512 * 1024, 1024, 1, 1, 0, scr, lane);
    } else { const int r = t - 65 * 128, e = r >> 6, q = r & 63, kb = q >> 4, nb = q & 15, le = l * 65 + e;
        const float* src = e < 64 ? p.in[26] + (size_t)(l * 64 + e) * 256 * 1024 : p.in[28] + (size_t)l * 256 * 1024;
        tr_item(src, 1024, kb * 64, nb * 64, (bf16_t*)(ws + W_DN) + (size_t)le * 1024 * 256, 256, 0, 1, 0, scr, lane); }
}
__device__ __forceinline__ void bg_convert(const Params& p, LAS unsigned char* lds, int l, int maxchunks) {
    const int tid = opq_tid(), lane = tid & 63, wid = tid >> 6;
    unsigned* q = (unsigned*)(p.ws + 32768) + l * 64;
    LAS int* slot = (LAS int*)(lds + LDS_BYTES - 64);
    LAS float* scr = (LAS float*)(lds + wid * 16640);
    for (int n = 0; n < maxchunks; ++n) {
        if (tid == 0) *slot = (int)atomicAdd(q, 1u);
        __syncthreads();
        const int c = *slot;
        __syncthreads();
        if (c >= BG_CHUNKS) break;
        bg_tile(p, l, c * 8 + wid, scr, lane);
    }
    __syncthreads();
}
__device__ __forceinline__ bool bg_idle(int nunits, int G, int c) { return (nunits - c + G - 1) / G < (nunits + G - 1) / G; }

template <int MODE, bool WRITE_LO, bool FINAL>
__device__ __forceinline__ void row_phase(const Params& p, int bid, int nblk, const float* gnorm, const float* modl  , int off_sh, int off_sc,
                                           const float* modprev  , const bf16_t* dx  ) {
    const int tid = opq_tid(), lane = tid & 63, wid = tid >> 6;
    unsigned char* ws = p.ws;
    float* xout = p.out;
    bf16_t* xres = (bf16_t*)(ws + B_XR);
    bf16_t* hx = (bf16_t*)(ws + OFF_HX);
    bf16_t* hlo = (bf16_t*)(ws + B_HLO);
    const float* pos = (const float*)(ws + OFF_POS);
    const int* slotof = (const int*)(ws + OFF_SLOTOF);
    const bf16_t* Y = (const bf16_t*)(ws + B_YY);
    const int nrows = MODE == 0 ? NROW : NTOK;
    for (int row = bid * 8 + wid; row < nrows; row += nblk * 8) {
        f32x4 v[4];
        int mv;
        if (MODE == 0) {
            if (row < NTOK) {
                mv = row >> 13; const int t = row & (SEQ - 1);
                const f32x4* xr = (const f32x4*)(p.in[0] + (size_t)row * D) + lane;
                const f32x4* pr = (const f32x4*)(pos + (size_t)(t >> 6) * 512) + lane;
                const f32x4* pc = (const f32x4*)(pos + (size_t)(t & 63) * 512) + lane;
                v[0] = xr[0] + pr[0]; v[1] = xr[64] + pr[64]; v[2] = xr[128] + pc[0]; v[3] = xr[192] + pc[64];
                u32x2* xo = (u32x2*)(xres + (size_t)row * D) + lane;
#pragma unroll
                for (int j = 0; j < 4; ++j) xo[64 * j] = (u32x2){pk2(v[j].x, v[j].y), pk2(v[j].z, v[j].w)};
            } else {
                mv = 4;
                const f32x4* xr = (const f32x4*)(p.in[2] + (size_t)(row - NTOK) * D) + lane;
#pragma unroll
                for (int j = 0; j < 4; ++j) v[j] = xr[64 * j];
            }
        } else {
            mv = row >> 13;
            u32x2* xo = (u32x2*)(xres + (size_t)row * D) + lane;
#pragma unroll
            for (int j = 0; j < 4; ++j) { const u32x2 w = xo[64 * j]; v[j] = (f32x4){bflo(w.x), bfhi(w.x), bflo(w.y), bfhi(w.y)}; }
            if (MODE == 1) {
                const u32x2* dr = (const u32x2*)(dx + (size_t)row * D) + lane;
#pragma unroll
                for (int j = 0; j < 4; ++j) { const u32x2 w = dr[64 * j]; v[j].x += bflo(w.x); v[j].y += bfhi(w.x); v[j].z += bflo(w.y); v[j].w += bfhi(w.y); xo[64 * j] = (u32x2){pk2(v[j].x, v[j].y), pk2(v[j].z, v[j].w)}; }
            }
            if (MODE == 2) {
                f32x4 s[4];
                {
                    const unsigned* yr = (const unsigned*)(ws + B_YS + (size_t)row * D) + lane;
#pragma unroll
                    for (int j = 0; j < 4; ++j) s[j] = up4_fp8(yr[64 * j]);
                }
#pragma unroll
                for (int k = 0; k < TOPK; ++k) {
                    const int slot = slotof[row * 8 + k];
                    const unsigned* yr = (const unsigned*)(ws + B_YY + (size_t)slot * D) + lane;
#pragma unroll
                    for (int j = 0; j < 4; ++j) s[j] = s[j] + up4_fp8(yr[64 * j]);
                }
                const f32x4* g2 = (const f32x4*)(modprev + (size_t)mv * 6144 + 5120) + lane;
#pragma unroll
                for (int j = 0; j < 4; ++j) { v[j] = v[j] + g2[64 * j] * s[j]; if (!FINAL) xo[64 * j] = (u32x2){pk2(v[j].x, v[j].y), pk2(v[j].z, v[j].w)}; }
            }
        }
        float ss = 0.f;
#pragma unroll
        for (int j = 0; j < 4; ++j) ss += (v[j].x * v[j].x + v[j].y * v[j].y) + (v[j].z * v[j].z + v[j].w * v[j].w);
        ss = wave_sum(ss);
        const float rinv = 1.0f / sqrtf(ss * (1.0f / D) + 1e-6f);
        const f32x4* gn = (const f32x4*)gnorm + lane;
        if (FINAL) {
            f32x4* xo = (f32x4*)(xout + (size_t)row * D) + lane;
#pragma unroll
            for (int j = 0; j < 4; ++j) xo[64 * j] = v[j] * rinv * gn[64 * j];
        } else {
            const f32x4* sh = (const f32x4*)(modl + (size_t)mv * 6144 + off_sh) + lane;
            const f32x4* sc = (const f32x4*)(modl + (size_t)mv * 6144 + off_sc) + lane;
            u32x2* ho = (u32x2*)(hx + (size_t)row * D) + lane;
            u32x2* lo = (u32x2*)(hlo + (size_t)row * D) + lane;
#pragma unroll
            for (int j = 0; j < 4; ++j) {
                const f32x4 y = v[j] * rinv * gn[64 * j] * (sc[64 * j] + 1.0f) + sh[64 * j];
                u32x2 w; w.x = pk2(y.x, y.y); w.y = pk2(y.z, y.w);
                ho[64 * j] = w;
                if (WRITE_LO) { u32x2 q; q.x = pk2(y.x - bflo(w.x), y.y - bfhi(w.x)); q.y = pk2(y.z - bflo(w.y), y.w - bfhi(w.y)); lo[64 * j] = q; }
            }
        }
    }
}

__device__ __forceinline__ void phase_inproj0(const Params& p, LAS unsigned char* lds, int bid, int nblk) {
    unsigned char* ws = p.ws;
    const bf16_t* hx = (const bf16_t*)(ws + OFF_HX); const bf16_t* W = (const bf16_t*)(ws + W_AIN);
    bf16_t* gate0 = (bf16_t*)(ws + B_GATE0); bf16_t* upre = (bf16_t*)(ws + B_UPRE);
    const int tid = opq_tid(), srow = tid >> 2, skc = (tid & 3) * 8;
    constexpr int NU = 256 * 20 + 8 * 10;
    for (int u = bid; u < NU; u += nblk) {
        int mt, nt;
        if (u < 5120) { mt = u / 20; nt = u % 20; } else { const int q = u - 5120; mt = 256 + q / 10; nt = 10 + q % 10; }
        const bf16_t* arow = hx + (size_t)(mt * 128 + srow) * D + skc;
        const bf16_t* brow = W + (size_t)(nt * 128 + srow) * D + skc;
        gemm_tile(arow, brow, 32, KDef(), [=](int r, int c, f32x4 v) {
            const int row = mt * 128 + r, col = nt * 128 + c;
            if (col < RW) { u32x2 w; w.x = pk2(gelu_t(v.x), gelu_t(v.y)); w.y = pk2(gelu_t(v.z), gelu_t(v.w)); *(u32x2*)(gate0 + (size_t)row * RW + col) = w; }
            else { u32x2 w; w.x = pk2(v.x, v.y); w.y = pk2(v.z, v.w); *(u32x2*)(upre + (size_t)row * RW + (col - RW)) = w; }
        }, lds);
    }
}

__device__ __forceinline__ void phase_conv(const Params& p, int bid, int nblk) {
    unsigned char* ws = p.ws;
    const bf16_t* upre = (const bf16_t*)(ws + B_UPRE); bf16_t* uu = (bf16_t*)(ws + B_UU);
    const float* cw = p.in[9]; const float* cb = p.in[10];
    const int gt = bid * NTHR + opq_tid(), ngt = nblk * NTHR;
    for (int item = gt; item < (NROW / 16) * 160; item += ngt) {
        const int rb = item / 160, cg8 = (item % 160) * 8, R0 = rb * 16;
        int t0, T;
        if (R0 < NTOK) { t0 = R0 & (SEQ - 1); T = SEQ; } else { t0 = (R0 - NTOK) & (CTXL - 1); T = CTXL; }
        f32x4 wa[4], wb[4];
#pragma unroll
        for (int k = 0; k < 4; ++k) { wa[k] = *(const f32x4*)(cw + k * RW + cg8); wb[k] = *(const f32x4*)(cw + k * RW + cg8 + 4); }
        const f32x4 ba = *(const f32x4*)(cb + cg8), bb = *(const f32x4*)(cb + cg8 + 4);
        u32x4 raw[19];
#pragma unroll
        for (int j = 0; j < 19; ++j) { const int tt = t0 + j - 2; raw[j] = (tt >= 0 && tt < T) ? *(const u32x4*)(upre + (size_t)(R0 + j - 2) * RW + cg8) : (u32x4){0u, 0u, 0u, 0u}; }
#pragma unroll
        for (int r = 0; r < 16; ++r) {
            f32x4 oa = ba, ob = bb;
#pragma unroll
            for (int k = 0; k < 4; ++k) { const u32x4 w = raw[r + k];
                oa = oa + wa[k] * (f32x4){bflo(w.x), bfhi(w.x), bflo(w.y), bfhi(w.y)}; ob = ob + wb[k] * (f32x4){bflo(w.z), bfhi(w.z), bflo(w.w), bfhi(w.w)}; }
            *(u32x4*)(uu + (size_t)(R0 + r) * RW + cg8) = pack8(oa, ob);
        }
    }
}

__device__ __forceinline__ void phase_outproj(const Params& p, LAS unsigned char* lds, int bid, int nblk, const bf16_t* Z, int K, const bf16_t* W, const float* modl) {
    float* xres = p.out;
    const int tid = opq_tid(), srow = tid >> 2, skc = (tid & 3) * 8;
    for (int u = bid; u < 256 * 8; u += nblk) {
        const int mt = u >> 3, nt = u & 7;
        const bf16_t* arow = Z + (size_t)(mt * 128 + srow) * K + skc;
        const bf16_t* brow = W + (size_t)(nt * 128 + srow) * K + skc;
        gemm_tile(arow, brow, K / 32, KDef(), [=](int r, int c, f32x4 v) {
            const int row = mt * 128 + r, col = nt * 128 + c;
            const f32x4 g1 = *(const f32x4*)(modl + (size_t)(row >> 13) * 6144 + 2048 + col);
            f32x4* xo = (f32x4*)(xres + (size_t)row * D + col);
            *xo = *xo + g1 * v;
        }, lds);
    }
}

__device__ __forceinline__ float rdlane(float v, int l) { return __builtin_bit_cast(float, __builtin_amdgcn_readlane(__builtin_bit_cast(int, v), l)); }
__device__ __forceinline__ float xmax(float v, int m) { return fmaxf(v, __shfl_xor(v, m)); }
__device__ __forceinline__ void phase_router(const Params& p, LAS unsigned char* lds, int bid, int nblk, int l) {
    unsigned char* ws = p.ws;
    const bf16_t* hx = (const bf16_t*)(ws + OFF_HX); const bf16_t* W = (const bf16_t*)(ws + W_RT) + (size_t)l * 128 * 3072;
    int* eidx = (int*)(ws + OFF_EIDX); float* gatew = (float*)(ws + OFF_GATEW); int* cnt = (int*)(ws + OFF_CNT); int* cntw = (int*)(ws + OFF_CNTW2);
    const int tid = opq_tid(), lane = tid & 63, wid = tid >> 6, fr = lane & 15, fq = lane >> 4;
    const float rbl = p.in[24][l * 64 + lane];
    LAS float* part = (LAS float*)lds;
    LAS float* L = (LAS float*)(lds + 69632);
    LAS int* cw = (LAS int*)(lds + 69632 + 8320);
    bf16x8 Bh[4][4], Bl[4][4];
#pragma unroll
    for (int s = 0; s < 4; ++s)
#pragma unroll
        for (int nb = 0; nb < 4; ++nb) { const bf16_t* wp = W + (size_t)(16 * nb + fr) * 3072 + 128 * wid + 32 * s + 8 * fq; Bh[s][nb] = *(const bf16x8*)wp; Bl[s][nb] = *(const bf16x8*)(wp + 2048); }
    bf16x8 Ah[2][4], Al[2][4];
#define RT_LOADA(ROW0) do { _Pragma("unroll") for (int g = 0; g < 2; ++g) _Pragma("unroll") for (int s = 0; s < 4; ++s) { \
        const bf16_t* ap = hx + (size_t)((ROW0) + 16 * g + fr) * D + 128 * wid + 32 * s + 8 * fq; Ah[g][s] = *(const bf16x8*)ap; Al[g][s] = *(const bf16x8*)(ap + LO_DELTA); } } while (0)
    if (bid < 256) RT_LOADA(bid * 128);
    for (int tile = bid; tile < 256; tile += nblk) {
        int cnt_e = 0;
        for (int it = 0; it < 4; ++it) {
            const int row0 = tile * 128 + it * 32;
            f32x4 acc[2][4];
#pragma unroll
            for (int g = 0; g < 2; ++g)
#pragma unroll
                for (int nb = 0; nb < 4; ++nb) acc[g][nb] = (f32x4){0.f, 0.f, 0.f, 0.f};
#pragma unroll
            for (int g = 0; g < 2; ++g)
#pragma unroll
                for (int s = 0; s < 4; ++s)
#pragma unroll
                    for (int nb = 0; nb < 4; ++nb) {
                        acc[g][nb] = __builtin_amdgcn_mfma_f32_16x16x32_bf16(Bh[s][nb], Ah[g][s], acc[g][nb], 0, 0, 0);
                        acc[g][nb] = __builtin_amdgcn_mfma_f32_16x16x32_bf16(Bh[s][nb], Al[g][s], acc[g][nb], 0, 0, 0);
                        acc[g][nb] = __builtin_amdgcn_mfma_f32_16x16x32_bf16(Bl[s][nb], Ah[g][s], acc[g][nb], 0, 0, 0);
                    }
            {
                const int nrow0 = it < 3 ? row0 + 32 : (tile + nblk) * 128;
                if (nrow0 < NTOK) RT_LOADA(nrow0);
            }
#pragma unroll
            for (int g = 0; g < 2; ++g)
#pragma unroll
                for (int nb = 0; nb < 4; ++nb) *(LAS f32x4*)(part + ((wid * 32 + 16 * g + fr) * 68 + 16 * nb + 4 * fq)) = acc[g][nb];
            __syncthreads();
            {
                const int r = tid >> 4, e0 = (tid & 15) * 4;
                f32x4 s = (f32x4){0.f, 0.f, 0.f, 0.f};
#pragma unroll
                for (int w = 0; w < 8; ++w) s = s + *(LAS f32x4*)(part + ((w * 32 + r) * 68 + e0));
                LAS float* o = L + r * 65 + e0; o[0] = s.x; o[1] = s.y; o[2] = s.z; o[3] = s.w;
            }
            __syncthreads();
#pragma unroll 1
            for (int j = 0; j < 4; ++j) {
                const int r = 4 * wid + j, tok = row0 + r;
                const float sc = sigm(L[r * 65 + lane]), sel = sc + rbl;
                const float m1 = xmax(xmax(xmax(sel, 1), 2), 4);
                int cand = sel == m1 ? lane : 64; cand = min(cand, __shfl_xor(cand, 1)); cand = min(cand, __shfl_xor(cand, 2)); cand = min(cand, __shfl_xor(cand, 4));
                const float s2 = lane == cand ? -__builtin_inff() : sel;
                const float gs = m1 + xmax(xmax(xmax(s2, 1), 2), 4);
                const int g = lane >> 3; int rank = 0;
#pragma unroll
                for (int gp = 0; gp < 8; ++gp) { const float o = rdlane(gs, gp * 8); rank += (o > gs || (o == gs && gp < g)) ? 1 : 0; }
                const bool keep = rank < 4;
                const unsigned bits = __builtin_bit_cast(unsigned, sel), srt = (bits & 0x80000000u) ? ~bits : (bits | 0x80000000u);
                const unsigned key = keep ? ((srt & ~63u) | (unsigned)(63 - lane)) : 0u;
                LAS unsigned* kb = (LAS unsigned*)(lds + 80000) + wid * 64;
                kb[lane] = key;
                int er = 0;
#pragma unroll
                for (int q4 = 0; q4 < 16; ++q4) { const u32x4 k4 = *(LAS u32x4*)(kb + 4 * q4); er += (k4.x > key ? 1 : 0) + (k4.y > key ? 1 : 0) + (k4.z > key ? 1 : 0) + (k4.w > key ? 1 : 0); }
                const bool chosen = keep && er < 8;
                const float ssum = wave_sum(chosen ? sc : 0.0f);
                if (chosen) { eidx[tok * 8 + er] = lane | (cnt_e << 8); gatew[tok * 8 + er] = sc * (2.5f / ssum); }
                cnt_e += chosen ? 1 : 0;
            }
        }
        cntw[(tile * 8 + wid) * 64 + lane] = cnt_e;
        cw[wid * 64 + lane] = cnt_e;
        __syncthreads();
        if (tid < 64) { int c = 0;
#pragma unroll
            for (int w = 0; w < 8; ++w) c += cw[w * 64 + tid];
            cnt[tile * 64 + tid] = c; }
        __syncthreads();
    }
}

__device__ __forceinline__ void phase_normroute(const Params& p, LAS unsigned char* lds, int bid, int nblk, int l, const float* gnorm, const float* modl, const bf16_t* dx) {
    unsigned char* ws = p.ws;
    bf16_t* xres = (bf16_t*)(ws + B_XR); bf16_t* hx = (bf16_t*)(ws + OFF_HX);
    const bf16_t* W = (const bf16_t*)(ws + W_RT) + (size_t)l * 128 * 3072;
    int* eidx = (int*)(ws + OFF_EIDX); float* gatew = (float*)(ws + OFF_GATEW); int* cnt = (int*)(ws + OFF_CNT); int* cntw = (int*)(ws + OFF_CNTW2);
    const int tid = opq_tid(), lane = tid & 63, wid = tid >> 6, fr = lane & 15, fq = lane >> 4;
    const float rbl = p.in[24][l * 64 + lane];
    LAS unsigned char* ahi = lds;
    LAS unsigned char* alo = lds + 33024;
    LAS float* part = (LAS float*)(lds + 66048);
    LAS float* L = (LAS float*)(lds + 66048 + 34816);
    LAS unsigned* kbase = (LAS unsigned*)(lds + 66048 + 34816 + 4224);
    LAS int* cw = (LAS int*)(lds + 66048 + 34816 + 4224 + 2048);
    bf16x8 Bh[4][4], Bl[4][4];
#pragma unroll
    for (int s = 0; s < 4; ++s)
#pragma unroll
        for (int nb = 0; nb < 4; ++nb) { const bf16_t* wp = W + (size_t)(16 * nb + fr) * 3072 + 128 * wid + 32 * s + 8 * fq; Bh[s][nb] = *(const bf16x8*)wp; Bl[s][nb] = *(const bf16x8*)(wp + 2048); }
    const f32x4* gn = (const f32x4*)gnorm + lane;
    u32x2 xa[2][4], da[2][4];
#define NR_LOAD(ROW0) do { _Pragma("unroll") for (int q = 0; q < 2; ++q) { const size_t r_ = (size_t)(ROW0) + 2 * wid + q; _Pragma("unroll") for (int j = 0; j < 4; ++j) { \
        xa[q][j] = ((const u32x2*)(xres + r_ * D) + lane)[64 * j]; da[q][j] = ((const u32x2*)(dx + r_ * D) + lane)[64 * j]; } } } while (0)
    if (bid < 256) NR_LOAD(bid * 128);
    for (int tile = bid; tile < 256; tile += nblk) {
        int cnt_e = 0;
        const int mv = tile >> 6;
        f32x4 ca[4];
#pragma unroll
        for (int j = 0; j < 4; ++j) ca[j] = gn[64 * j] * (((const f32x4*)(modl + (size_t)mv * 6144 + 4096) + lane)[64 * j] + 1.0f);
        const f32x4* sh = (const f32x4*)(modl + (size_t)mv * 6144 + 3072) + lane;
        for (int grp = 0; grp < 8; ++grp) {
            const int row0 = tile * 128 + grp * 16;
#pragma unroll
            for (int q = 0; q < 2; ++q) {
                const int rl = 2 * wid + q; const size_t row = (size_t)row0 + rl;
                f32x4 v[4]; float ss = 0.f;
#pragma unroll
                for (int j = 0; j < 4; ++j) { const u32x2 a = xa[q][j], b = da[q][j];
                    v[j] = (f32x4){bflo(a.x) + bflo(b.x), bfhi(a.x) + bfhi(b.x), bflo(a.y) + bflo(b.y), bfhi(a.y) + bfhi(b.y)};
                    ((u32x2*)(xres + row * D) + lane)[64 * j] = (u32x2){pk2(v[j].x, v[j].y), pk2(v[j].z, v[j].w)};
                    ss += (v[j].x * v[j].x + v[j].y * v[j].y) + (v[j].z * v[j].z + v[j].w * v[j].w); }
                ss = wave_sum(ss);
                const float rinv = 1.0f / sqrtf(ss * (1.0f / D) + 1e-6f);
#pragma unroll
                for (int j = 0; j < 4; ++j) {
                    const f32x4 y = v[j] * rinv * ca[j] + sh[64 * j];
                    u32x2 w; w.x = pk2(y.x, y.y); w.y = pk2(y.z, y.w);
                    ((u32x2*)(hx + row * D) + lane)[64 * j] = w;
                    u32x2 ql; ql.x = pk2(y.x - bflo(w.x), y.y - bfhi(w.x)); ql.y = pk2(y.z - bflo(w.y), y.w - bfhi(w.y));
                    *(LAS u32x2*)(ahi + rl * 2064 + (lane + 64 * j) * 8) = w; *(LAS u32x2*)(alo + rl * 2064 + (lane + 64 * j) * 8) = ql;
                }
            }
            __syncthreads();
            {
                const int nrow0 = grp < 7 ? row0 + 16 : (tile + nblk) * 128;
                if (nrow0 < NTOK) NR_LOAD(nrow0);
            }
            f32x4 acc[4];
#pragma unroll
            for (int nb = 0; nb < 4; ++nb) acc[nb] = (f32x4){0.f, 0.f, 0.f, 0.f};
#pragma unroll
            for (int s = 0; s < 4; ++s) {
                const int ko = fr * 2064 + (128 * wid + 32 * s + 8 * fq) * 2;
                const bf16x8 Ah = *(LAS bf16x8*)(ahi + ko), Al = *(LAS bf16x8*)(alo + ko);
#pragma unroll
                for (int nb = 0; nb < 4; ++nb) {
                    acc[nb] = __builtin_amdgcn_mfma_f32_16x16x32_bf16(Bh[s][nb], Ah, acc[nb], 0, 0, 0);
                    acc[nb] = __builtin_amdgcn_mfma_f32_16x16x32_bf16(Bh[s][nb], Al, acc[nb], 0, 0, 0);
                    acc[nb] = __builtin_amdgcn_mfma_f32_16x16x32_bf16(Bl[s][nb], Ah, acc[nb], 0, 0, 0);
                }
            }
#pragma unroll
            for (int nb = 0; nb < 4; ++nb) *(LAS f32x4*)(part + ((wid * 16 + fr) * 68 + 16 * nb + 4 * fq)) = acc[nb];
            __syncthreads();
            if (tid < 256) {
                const int r = tid >> 4, e0 = (tid & 15) * 4;
                f32x4 s = (f32x4){0.f, 0.f, 0.f, 0.f};
#pragma unroll
                for (int w = 0; w < 8; ++w) s = s + *(LAS f32x4*)(part + ((w * 16 + r) * 68 + e0));
                LAS float* o = L + r * 65 + e0; o[0] = s.x; o[1] = s.y; o[2] = s.z; o[3] = s.w;
            }
            __syncthreads();
#pragma unroll 1
            for (int j = 0; j < 2; ++j) {
                const int r = 2 * wid + j, tok = row0 + r;
                const float scv = sigm(L[r * 65 + lane]), sel = scv + rbl;
                const float m1 = max8(sel);
                const int cand = min8(sel == m1 ? lane : 64);
                const float s2 = lane == cand ? -__builtin_inff() : sel;
                const float gs = m1 + max8(s2);
                const int g = lane >> 3; int rank = 0;
#pragma unroll
                for (int gp = 0; gp < 8; ++gp) { const float o = rdlane(gs, gp * 8); rank += (o > gs || (o == gs && gp < g)) ? 1 : 0; }
                const bool keep = rank < 4;
                const unsigned bits = __builtin_bit_cast(unsigned, sel), srt = (bits & 0x80000000u) ? ~bits : (bits | 0x80000000u);
                const unsigned key = keep ? ((srt & ~63u) | (unsigned)(63 - lane)) : 0u;
                LAS unsigned* kb = kbase + wid * 64;
                kb[lane] = key;
                int er = 0;
#pragma unroll
                for (int q4 = 0; q4 < 16; ++q4) { const u32x4 k4 = *(LAS u32x4*)(kb + 4 * q4); er += (k4.x > key ? 1 : 0) + (k4.y > key ? 1 : 0) + (k4.z > key ? 1 : 0) + (k4.w > key ? 1 : 0); }
                const bool chosen = keep && er < 8;
                const float ssum = wave_sum(chosen ? scv : 0.0f);
                if (chosen) { eidx[tok * 8 + er] = lane | (cnt_e << 8); gatew[tok * 8 + er] = scv * (2.5f / ssum); }
                cnt_e += chosen ? 1 : 0;
            }
        }
        cntw[(tile * 8 + wid) * 64 + lane] = cnt_e;
        cw[wid * 64 + lane] = cnt_e;
        __syncthreads();
        if (tid < 64) { int c = 0;
#pragma unroll
            for (int w = 0; w < 8; ++w) c += cw[w * 64 + tid];
            cnt[tile * 64 + tid] = c; }
        __syncthreads();
    }
#undef NR_LOAD
}

__device__ __forceinline__ void phase_scatter(const Params& p, LAS unsigned char* lds, int bid, int nblk, int l) {
    unsigned char* ws = p.ws;
    const int* eidx = (const int*)(ws + OFF_EIDX); const float* gatew = (const float*)(ws + OFF_GATEW); const int* cnt = (const int*)(ws + OFF_CNT); const int* cntw = (const int*)(ws + OFF_CNTW2);
    int* slotof = (int*)(ws + OFF_SLOTOF); int* tokof = (int*)(ws + OFF_TOKOF); float* wof = (float*)(ws + OFF_WOF); int* meta = (int*)(ws + OFF_META);
    const int tid = opq_tid();
    LAS int* ps = (LAS int*)lds;
    LAS int* tot = (LAS int*)(lds + 2048);
    LAS int* sst = (LAS int*)(lds + 2048 + 256);
    LAS int* base = (LAS int*)(lds + 4096);
    LAS int* cl = (LAS int*)(lds + 8192);
    for (int i = tid; i < 256 * 64; i += NTHR) cl[i] = cnt[i];
    __syncthreads();
    {
        const int e = tid & 63, part = tid >> 6; int s = 0;
#pragma unroll 8
        for (int r = part * 32; r < part * 32 + 32; ++r) s += cl[r * 64 + e];
        ps[part * 64 + e] = s;
    }
    __syncthreads();
    if (tid < 64) { int s = 0; for (int q = 0; q < 8; ++q) s += ps[q * 64 + tid]; tot[tid] = s; }
    __syncthreads();
    if (tid == 0) { int a = 0; for (int e = 0; e < 64; ++e) { sst[e] = a; a += (tot[e] + TM - 1) / TM * TM; } sst[64] = a; sst[65] = a + NTOK; }
    __syncthreads();
    for (int tile = bid; tile < 256; tile += nblk) {
        {
            const int e = tid & 63, part = tid >> 6; int s = 0;
#pragma unroll 8
            for (int r = part * 32; r < part * 32 + 32; ++r) s += r < tile ? cl[r * 64 + e] : 0;
            ps[part * 64 + e] = s;
        }
        __syncthreads();
        {
            const int e = tid & 63, w = tid >> 6; int b = sst[e];
#pragma unroll
            for (int q = 0; q < 8; ++q) b += ps[q * 64 + e];
#pragma unroll
            for (int q = 0; q < 8; ++q) b += q < w ? cntw[(tile * 8 + q) * 64 + e] : 0;
            base[w * 64 + e] = b;
        }
        __syncthreads();
#pragma unroll
        for (int i = 0; i < 2; ++i) {
            const int a = tid + NTHR * i, r = a >> 3, tok = tile * 128 + r, w = (r & 15) >> 1;
            const int code = eidx[tile * 1024 + a], e = code & 63, lr = code >> 8;
            const int slot = base[w * 64 + e] + lr;
            tokof[slot] = tok; wof[slot] = gatew[tile * 1024 + a]; slotof[tile * 1024 + a] = slot;
        }
        if (tile == 0) {
            if (tid < 64) for (int s = sst[tid] + tot[tid]; s < sst[tid + 1]; ++s) { tokof[s] = 0; wof[s] = 0.0f; }
            if (tid < 66) meta[tid] = sst[tid];
        }
        __syncthreads();
    }
    bg_convert(p, lds, l, 1 << 30);
}

__device__ __forceinline__ void phase_inproj1(const Params& p, LAS unsigned char* lds, int bid, int nblk) {
    unsigned char* ws = p.ws;
    const bf16_t* hx = (const bf16_t*)(ws + OFF_HX); const bf16_t* W = (const bf16_t*)(ws + W_BIN); bf16_t* uv = (bf16_t*)(ws + B_UV);
    const int tid = opq_tid(), srow = tid >> 2, skc = (tid & 3) * 8;
    for (int u = bid; u < 256 * 32; u += nblk) {
        const int mt = u >> 5, nt = u & 31;
        const bf16_t* arow = hx + (size_t)(mt * 128 + srow) * D + skc;
        const bf16_t* brow = W + (size_t)(nt * 128 + srow) * D + skc;
        gemm_tile(arow, brow, 32, KDef(), [=](int r, int c, f32x4 v) {
            u32x2 w; w.x = pk2(gelu_t(v.x), gelu_t(v.y)); w.y = pk2(gelu_t(v.z), gelu_t(v.w));
            *(u32x2*)(uv + (size_t)(mt * 128 + r) * 4096 + nt * 128 + c) = w;
        }, lds);
    }
}

__device__ __forceinline__ void phase_sgu(const Params& p, LAS unsigned char* lds, int bid, int nblk) {
    unsigned char* ws = p.ws;
    const bf16_t* Wsb = (const bf16_t*)(ws + W_S); const bf16_t* uv = (const bf16_t*)(ws + B_UV); const float* statp = (const float*)(ws + OFF_STATP);
    bf16_t* z1 = (bf16_t*)(ws + B_Z1); const float* bs = p.in[21]; const float* lng = p.in[18]; const float* lnb = p.in[19];
    const int tid = opq_tid(), lane = tid & 63, wid = tid >> 6, wr = wid >> 2, wc = wid & 3, fr = lane & 15, fq = lane >> 4;
    LAS unsigned char* sa = lds;
    LAS unsigned char* sb = lds + 34816;
    LAS float* st = (LAS float*)(lds + 69632);
    u32x4 ra[4], rb[4], ru[4]; f32x4 rg[2], rbb[2]; float rm = 0.f, rr = 0.f;
#define SG_LOAD(U) do { const int chunk_ = (U) >> 4, g_ = ((U) >> 1) & 7, nt_ = (U) & 1; _Pragma("unroll") for (int k = 0; k < 4; ++k) { const int idx = k * NTHR + tid, r = idx >> 4, c8 = (idx & 15) * 8; \
        ra[k] = *(const u32x4*)(Wsb + (size_t)(g_ * 128 + r) * 128 + c8); rb[k] = *(const u32x4*)(uv + (size_t)(chunk_ * 128 + r) * 4096 + 2048 + g_ * 256 + nt_ * 128 + c8); \
        ru[k] = *(const u32x4*)(uv + (size_t)(chunk_ * 128 + r) * 4096 + g_ * 256 + nt_ * 128 + c8); } \
        { const int ch_ = g_ * 256 + nt_ * 128 + (tid & 15) * 8; rg[0] = *(const f32x4*)(lng + ch_); rg[1] = *(const f32x4*)(lng + ch_ + 4); rbb[0] = *(const f32x4*)(lnb + ch_); rbb[1] = *(const f32x4*)(lnb + ch_ + 4); } \
        if (tid < 128) { const f32x4* sp = (const f32x4*)(statp + (size_t)(chunk_ * 128 + tid) * 64); float S_ = 0.f, Q_ = 0.f; \
            _Pragma("unroll") for (int k = 0; k < 16; ++k) { const f32x4 t_ = sp[k]; S_ += t_.x + t_.z; Q_ += t_.y + t_.w; } \
            rm = S_ * (1.0f / SW); rr = 1.0f / sqrtf(fmaxf(Q_ * (1.0f / SW) - rm * rm, 0.0f) + 1e-6f); } } while (0)
    if (bid < 4096) SG_LOAD(bid);
    for (int u = bid; u < 256 * 16; u += nblk) {
        const int chunk = u >> 4, g = (u >> 1) & 7, nt = u & 1, R0 = chunk * 128;
        if (tid < 128) { st[tid * 2] = rm; st[tid * 2 + 1] = rr; }
        __syncthreads();
#pragma unroll
        for (int k = 0; k < 4; ++k) {
            const int idx = k * NTHR + tid, r = idx >> 4, c16 = (idx & 15) * 16;
            *(LAS u32x4*)(sa + r * 272 + c16) = ra[k];
            const float mean = st[r * 2], rstd = st[r * 2 + 1]; const u32x4 w = rb[k];
            const f32x4 x0 = ((f32x4){bflo(w.x), bfhi(w.x), bflo(w.y), bfhi(w.y)} - mean) * rstd * rg[0] + rbb[0];
            const f32x4 x1 = ((f32x4){bflo(w.z), bfhi(w.z), bflo(w.w), bfhi(w.w)} - mean) * rstd * rg[1] + rbb[1];
            *(LAS u32x4*)(sb + r * 272 + c16) = pack8(x0, x1);
        }
        u32x4 uc[4];
#pragma unroll
        for (int k = 0; k < 4; ++k) uc[k] = ru[k];
        float bsv[4];
#pragma unroll
        for (int m = 0; m < 4; ++m) bsv[m] = bs[g * 128 + wr * 64 + m * 16 + fr];
        __syncthreads();
        if (u + nblk < 4096) SG_LOAD(u + nblk);
        f32x4 acc[4][2];
#pragma unroll
        for (int m = 0; m < 4; ++m)
#pragma unroll
            for (int n = 0; n < 2; ++n) acc[m][n] = (f32x4){0.f, 0.f, 0.f, 0.f};
#pragma unroll
        for (int ks = 0; ks < 4; ++ks) {
            bf16x8 af[4], bfv[2];
#pragma unroll
            for (int m = 0; m < 4; ++m) af[m] = *(LAS bf16x8*)(sa + (wr * 64 + m * 16 + fr) * 272 + ks * 64 + fq * 16);
#pragma unroll
            for (int n = 0; n < 2; ++n) {
                const LAS unsigned short* bp = (const LAS unsigned short*)(sb + (ks * 32 + fq * 8) * 272 + (wc * 32 + n * 16 + fr) * 2);
#pragma unroll
                for (int j = 0; j < 8; ++j) bfv[n][j] = (short)bp[j * 136];
            }
#pragma unroll
            for (int m = 0; m < 4; ++m)
#pragma unroll
                for (int n = 0; n < 2; ++n) acc[m][n] = __builtin_amdgcn_mfma_f32_16x16x32_bf16(bfv[n], af[m], acc[m][n], 0, 0, 0);
        }
        __syncthreads();
#pragma unroll
        for (int m = 0; m < 4; ++m) { const int r = wr * 64 + m * 16 + fr; const float b = bsv[m];
#pragma unroll
            for (int n = 0; n < 2; ++n) { const f32x4 v = acc[m][n]; u32x2 o; o.x = pk2(v.x + b, v.y + b); o.y = pk2(v.z + b, v.w + b); *(LAS u32x2*)(sa + r * 272 + (wc * 32 + n * 16 + fq * 4) * 2) = o; } }
        __syncthreads();
#pragma unroll
        for (int k = 0; k < 4; ++k) {
            const int idx = k * NTHR + tid, r = idx >> 4, c8 = (idx & 15) * 8;
            const u32x4 ov = *(LAS u32x4*)(sa + r * 272 + c8 * 2), uw = uc[k];
            u32x4 z; z.x = pk2(bflo(uw.x) * bflo(ov.x), bfhi(uw.x) * bfhi(ov.x)); z.y = pk2(bflo(uw.y) * bflo(ov.y), bfhi(uw.y) * bfhi(ov.y));
            z.z = pk2(bflo(uw.z) * bflo(ov.z), bfhi(uw.z) * bfhi(ov.z)); z.w = pk2(bflo(uw.w) * bflo(ov.w), bfhi(uw.w) * bfhi(ov.w));
            *(u32x4*)(z1 + (size_t)(R0 + r) * SW + g * 256 + nt * 128 + c8) = z;
        }
        __syncthreads();
    }
#undef SG_LOAD
}

template <class F> struct EpiP8 {
    static constexpr int PERM = 1; F f;
    __device__ __forceinline__ void operator()(const f32x4 (&acc)[2][2][4][2], const pg::Unit& u, int wr, int wc, int fr, int fq) const {
#pragma unroll
        for (int ai = 0; ai < 2; ++ai)
#pragma unroll
            for (int m = 0; m < 4; ++m)
#pragma unroll
                for (int bj = 0; bj < 2; ++bj) f(u, ai * 128 + wr * 64 + m * 16 + fr, bj * 128 + wc * 32 + 8 * fq, acc[ai][bj][m][0], acc[ai][bj][m][1]);
    }
};
template <class F> struct EpiP4 {
    static constexpr int PERM = 0; F f;
    __device__ __forceinline__ void operator()(const f32x4 (&acc)[2][2][4][2], const pg::Unit& u, int wr, int wc, int fr, int fq) const {
#pragma unroll
        for (int ai = 0; ai < 2; ++ai)
#pragma unroll
            for (int m = 0; m < 4; ++m)
#pragma unroll
                for (int bj = 0; bj < 2; ++bj)
#pragma unroll
                    for (int n = 0; n < 2; ++n) f(u, ai * 128 + wr * 64 + m * 16 + fr, bj * 128 + wc * 32 + 16 * n + 4 * fq, acc[ai][bj][m][n]);
    }
};
template <class F> __device__ __forceinline__ EpiP8<F> make_p8(F f) { return EpiP8<F>{f}; }
template <class F> __device__ __forceinline__ EpiP4<F> make_p4(F f) { return EpiP4<F>{f}; }
__device__ __forceinline__ f32x4 gelu4(f32x4 v) { return (f32x4){gelu_t(v.x), gelu_t(v.y), gelu_t(v.z), gelu_t(v.w)}; }

__device__ __forceinline__ void stg_sync() { asm volatile("s_waitcnt lgkmcnt(0)" ::: "memory"); __builtin_amdgcn_s_barrier(); asm volatile("" ::: "memory"); }
template <class RowPtr>
__device__ __forceinline__ void stg_step512(LAS unsigned char* stg, int wr, int wc, int fr, int fq, int o0, int o1, u32x4 p0, u32x4 p1, RowPtr rp) {
    LAS unsigned char* w = stg + (wr * 16 + fr) * 528;
    *(LAS u32x4*)(w + o0) = p0; *(LAS u32x4*)(w + o1) = p1;
    stg_sync();
    const int tid = (wr * 4 + wc) * 64 + fq * 16 + fr;
#pragma unroll
    for (int k = 0; k < 2; ++k) { const int idx = k * 512 + tid, rl = idx >> 5, c = idx & 31; const u32x4 v = *(LAS u32x4*)(stg + rl * 528 + c * 16); *(u32x4*)(rp(rl) + c * 16) = v; }
    stg_sync();
}
template <class RowPtr>
__device__ __forceinline__ void stg_step256(LAS unsigned char* stg, int wr, int wc, int fr, int fq, u32x4 p0, RowPtr rp) {
    *(LAS u32x4*)(stg + (wr * 16 + fr) * 272 + wc * 64 + fq * 16) = p0;
    stg_sync();
    const int tid = (wr * 4 + wc) * 64 + fq * 16 + fr, rl = tid >> 4, c = tid & 15;
    const u32x4 v = *(LAS u32x4*)(stg + rl * 272 + c * 16); *(u32x4*)(rp(rl) + c * 16) = v;
    stg_sync();
}
template <class Xf, class RowPtr> struct EpiStage {
    static constexpr int PERM = 1; LAS unsigned char* stg; Xf xf; RowPtr rowptr;
    __device__ __forceinline__ void operator()(const f32x4 (&acc)[2][2][4][2], const pg::Unit& u, int wr, int wc, int fr, int fq) const {
#pragma unroll
        for (int ai = 0; ai < 2; ++ai)
#pragma unroll
            for (int m = 0; m < 4; ++m) {
                const u32x4 p0 = xf(u, 0, wc, fq, acc[ai][0][m][0], acc[ai][0][m][1]), p1 = xf(u, 1, wc, fq, acc[ai][1][m][0], acc[ai][1][m][1]);
                stg_step512(stg, wr, wc, fr, fq, wc * 64 + fq * 16, 256 + wc * 64 + fq * 16, p0, p1,
                            [&](int rl) { return rowptr(u, ai * 128 + (rl >> 4) * 64 + m * 16 + (rl & 15)); });
            }
    }
};
template <class Xf, class RowPtr> __device__ __forceinline__ EpiStage<Xf, RowPtr> make_stage(LAS unsigned char* stg, Xf xf, RowPtr rp) { return EpiStage<Xf, RowPtr>{stg, xf, rp}; }
template <class Xf, class RowPtr> struct EpiDirect {
    static constexpr int PERM = 2; Xf xf; RowPtr rowptr;
    __device__ __forceinline__ void operator()(const f32x4 (&acc)[2][2][4][2], const pg::Unit& u, int wr, int wc, int fr, int fq) const {
#pragma unroll
        for (int ai = 0; ai < 2; ++ai)
#pragma unroll
            for (int m = 0; m < 4; ++m) {
                unsigned char* rp = rowptr(u, ai * 128 + wr * 64 + m * 16 + fr) + (64 * wc + 8 * fq) * 2;
                *(u32x4*)rp = xf(u, 0, wc, fq, acc[ai][0][m][0], acc[ai][0][m][1]);
                *(u32x4*)(rp + 64) = xf(u, 1, wc, fq, acc[ai][1][m][0], acc[ai][1][m][1]);
            }
    }
};
template <class Xf, class RowPtr> __device__ __forceinline__ EpiDirect<Xf, RowPtr> make_direct(Xf xf, RowPtr rp) { return EpiDirect<Xf, RowPtr>{xf, rp}; }

struct SchedIn0 {
    const char* A; const char* B; int G, c;
    __device__ __forceinline__ bool next(int i, pg::Unit& u) const {
        const int L = i * G + c; if (L >= 1300) return false;
        if (L < 1280) { const int wgid = pg::xcd_remap(L, 1280); u.pm = (wgid / 80) * 8 + (wgid % 80) % 8; u.pn = (wgid % 80) / 8; }
        else { const int q = L - 1280; u.pm = 128 + q / 5; u.pn = 5 + q % 5; }
        u.e = 0; u.rows = nullptr; u.a = A + (size_t)u.pm * 256 * D * 2; u.b = B + (size_t)u.pn * 256 * D * 2; return true;
    }
};
__device__ __forceinline__ void phase_inproj0_pg(const Params& p, LAS unsigned char* lds, int bid, int nblk) {
    unsigned char* ws = p.ws;
    unsigned char* gate0 = ws + B_GATE0; unsigned char* upre = ws + B_UPRE;
    SchedIn0 S{(const char*)(ws + OFF_HX), (const char*)(ws + W_AIN), nblk, bid};
    auto E = make_direct(
        [=](const pg::Unit& u, int bj, int wc, int fq, f32x4 v0, f32x4 v1) { return u.pn < 5 ? pack8(gelu4(v0), gelu4(v1)) : pack8(v0, v1); },
        [=](const pg::Unit& u, int r) { const size_t row = (size_t)u.pm * 256 + r; return u.pn < 5 ? gate0 + (row * RW + u.pn * 256) * 2 : upre + (row * RW + (u.pn - 5) * 256) * 2; });
    pg::gemm<false>(lds, D, D, D, S, E);
    if (bg_idle(1300, nblk, bid)) bg_convert(p, lds, 0, 4);
}
__device__ __forceinline__ void phase_outproj_pg(const Params& p, LAS unsigned char* lds, int bid, int nblk, const bf16_t* Z, int K, const bf16_t* W, const float* modl, unsigned char* dx) {
    pg::SchedPlain S{(const char*)Z, (const char*)W, K, K, 128, 4, 512, nblk, bid};
    auto E = make_direct(
        [=](const pg::Unit& u, int bj, int wc, int fq, f32x4 v0, f32x4 v1) {
            const float* g1 = modl + (size_t)(u.pm >> 5) * 6144 + 2048 + u.pn * 256 + wc * 64 + bj * 32 + 8 * fq;
            return pack8(v0 * *(const f32x4*)g1, v1 * *(const f32x4*)(g1 + 4)); },
        [=](const pg::Unit& u, int r) { return dx + (((size_t)u.pm * 256 + r) * D + u.pn * 256) * 2; });
    pg::gemm<false>(lds, K, K, K, S, E);
}
struct EpiIn1 {
    static constexpr int PERM = 2; unsigned char* uv; float* statp;
    __device__ __forceinline__ void operator()(const f32x4 (&acc)[2][2][4][2], const pg::Unit& u, int wr, int wc, int fr, int fq) const {
#pragma unroll
        for (int ai = 0; ai < 2; ++ai)
#pragma unroll
            for (int m = 0; m < 4; ++m) {
                const size_t row = (size_t)u.pm * 256 + ai * 128 + wr * 64 + m * 16 + fr;
                const u32x4 p0 = pack8(gelu4(acc[ai][0][m][0]), gelu4(acc[ai][0][m][1])), p1 = pack8(gelu4(acc[ai][1][m][0]), gelu4(acc[ai][1][m][1]));
                unsigned char* rp = uv + (row * 4096 + u.pn * 256 + 64 * wc + 8 * fq) * 2;
                *(u32x4*)rp = p0; *(u32x4*)(rp + 64) = p1;
                if (u.pn >= 8) {
                    float s = 0.f, q = 0.f;
#pragma unroll
                    for (int k = 0; k < 8; ++k) { const unsigned w = k < 4 ? p0[k] : p1[k - 4]; const float a = bflo(w), b = bfhi(w); s += a + b; q += a * a + b * b; }
                    s += __shfl_xor(s, 16); q += __shfl_xor(q, 16); s += __shfl_xor(s, 32); q += __shfl_xor(q, 32);
                    if (fq == 0) { float* sp = statp + (row * 32 + (u.pn - 8) * 4 + wc) * 2; sp[0] = s; sp[1] = q; }
                }
            }
    }
};
__device__ __forceinline__ void phase_inproj1_pg(const Params& p, LAS unsigned char* lds, int bid, int nblk) {
    unsigned char* ws = p.ws;
    pg::SchedPlain S{(const char*)(ws + OFF_HX), (const char*)(ws + W_BIN), D, D, 128, 16, 2048, nblk, bid};
    EpiIn1 E{ws + B_UV, (float*)(ws + OFF_STATP)};
    pg::gemm<false>(lds, D, D, D, S, E);
}

constexpr int MOE_T_SS = 131072, MOE_T_S0 = 131072 + 512, MOE_T_E = 131072 + 512 + 4864;
__device__ __forceinline__ int moe_meta(const Params& p, LAS unsigned char* lds) {
    LAS int* ss = (LAS int*)(lds + MOE_T_SS); LAS int* ts0 = (LAS int*)(lds + MOE_T_S0); LAS unsigned char* te = lds + MOE_T_E;
    const int* meta = (const int*)(p.ws + OFF_META);
    const int tid = opq_tid();
    if (tid < 66) ss[tid] = meta[tid];
    __syncthreads();
    const int ntile = ss[65] / TM;
    for (int t = tid; t < ntile; t += NTHR) {
        const int slot0 = t * TM; int e = 0;
        for (int q = 1; q < 65; ++q) e = (ss[q] <= slot0) ? q : e;
        ts0[t] = slot0; te[t] = (unsigned char)e;
    }
    __syncthreads();
    return ntile;
}
template <int NPN, bool GATHER>
struct SchedMoe {
    const char* A; const char* W; const int* tokof; const int* ident; LAS unsigned char* lds; int lda, wrows, wk, nunits, G, c;
    __device__ __forceinline__ bool next(int i, pg::Unit& u) const {
        const int L = i * G + c; if (L >= nunits) return false;
        const int wgid = pg::xcd_remap(L, nunits), tile = wgid / NPN;
        const int slot0 = __builtin_amdgcn_readfirstlane(((LAS int*)(lds + MOE_T_S0))[tile]);
        const int e = __builtin_amdgcn_readfirstlane((int)(lds + MOE_T_E)[tile]);
        const int ss64 = __builtin_amdgcn_readfirstlane(((LAS int*)(lds + MOE_T_SS))[64]);
        u.pm = slot0; u.pn = wgid % NPN; u.e = e;
        u.rows = e < 64 ? tokof + slot0 : ident + (slot0 - ss64);
        u.a = GATHER ? A : A + (size_t)slot0 * lda * 2;
        u.b = W + ((size_t)e * wrows + (size_t)u.pn * 256) * wk * 2;
        return true;
    }
};
__device__ __forceinline__ f32x4 silu4(f32x4 v) { return (f32x4){silu(v.x), silu(v.y), silu(v.z), silu(v.w)}; }
struct EpiUp {
    static constexpr int PERM = 1; unsigned char* hh; const float* wof; LAS unsigned char* stg;
    __device__ __forceinline__ void operator()(const f32x4 (&acc)[2][2][4][2], const pg::Unit& u, int wr, int wc, int fr, int fq) const {
        float w[8];
#pragma unroll
        for (int i = 0; i < 8; ++i) w[i] = u.e < 64 ? wof[u.pm + (i >> 2) * 128 + wr * 64 + (i & 3) * 16 + fr] : 1.0f;
#pragma unroll
        for (int ai = 0; ai < 2; ++ai)
#pragma unroll
            for (int m = 0; m < 4; ++m) {
                const float ww = w[ai * 4 + m];
                const u32x4 p0 = pack8(silu4(acc[ai][0][m][0]) * acc[ai][1][m][0] * ww, silu4(acc[ai][0][m][1]) * acc[ai][1][m][1] * ww);
                LAS unsigned char* sbuf = stg + ((ai * 4 + m) & 1) * 8704;
                *(LAS u32x4*)(sbuf + (wr * 16 + fr) * 272 + wc * 64 + fq * 16) = p0;
                stg_sync();
                { const int tid = (wr * 4 + wc) * 64 + fq * 16 + fr, rl = tid >> 4, c = tid & 15;
                  const u32x4 v = *(LAS u32x4*)(sbuf + rl * 272 + c * 16);
                  *(u32x4*)(hh + ((size_t)(u.pm + ai * 128 + (rl >> 4) * 64 + m * 16 + (rl & 15)) * EFF + u.pn * 128) * 2 + c * 16) = v; }
            }
    }
};
__device__ __forceinline__ void phase_moe_up(const Params& p, LAS unsigned char* lds, int bid, int nblk, int l) {
    unsigned char* ws = p.ws;
    const int ntile = moe_meta(p, lds);
    SchedMoe<2, true> S{(const char*)(ws + OFF_HX), (const char*)(ws + W_GU) + (size_t)l * 65 * 512 * 1024 * 2, (const int*)(ws + OFF_TOKOF), (const int*)(ws + OFF_IDENT), lds, D, 512, D, ntile * 2, nblk, bid};
    EpiUp E{ws + B_HH, (const float*)(ws + OFF_WOF), lds + STG_OFF};
    pg::gemm<true>(lds, D, D, D, S, E);
    if (l == 0 && bg_idle(ntile * 2, nblk, bid)) bg_convert(p, lds, 1, 3);
}
struct EpiDown {
    static constexpr int PERM = 1; LAS unsigned char* stg; unsigned char* Y; unsigned char* ys; int ss64;
    __device__ __forceinline__ void operator()(const f32x4 (&acc)[2][2][4][2], const pg::Unit& u, int wr, int wc, int fr, int fq) const {
        const int tid = (wr * 4 + wc) * 64 + fq * 16 + fr, rl = tid >> 4, c = tid & 15;
        unsigned char* base = u.e < 64 ? Y + ((size_t)u.pm * D + u.pn * 256) : ys + ((size_t)(u.pm - ss64) * D + u.pn * 256);
#pragma unroll
        for (int ai = 0; ai < 2; ++ai)
#pragma unroll
            for (int m = 0; m < 4; ++m) {
                LAS unsigned char* sbuf = stg + ((ai * 4 + m) & 1) * 8704;
                LAS unsigned char* w = sbuf + (wr * 16 + fr) * 272 + wc * 32 + fq * 8;
                *(LAS u32x2*)w = (u32x2){pk4_fp8(acc[ai][0][m][0]), pk4_fp8(acc[ai][0][m][1])};
                *(LAS u32x2*)(w + 128) = (u32x2){pk4_fp8(acc[ai][1][m][0]), pk4_fp8(acc[ai][1][m][1])};
                stg_sync();
                const u32x4 v = *(LAS u32x4*)(sbuf + rl * 272 + c * 16);
                *(u32x4*)(base + (size_t)(ai * 128 + (rl >> 4) * 64 + m * 16 + (rl & 15)) * D + c * 16) = v;
            }
    }
};
__device__ __forceinline__ void phase_moe_down(const Params& p, LAS unsigned char* lds, int bid, int nblk, int l) {
    unsigned char* ws = p.ws;
    const int ntile = moe_meta(p, lds);
    const int ss64 = ((LAS int*)(lds + MOE_T_SS))[64];
    SchedMoe<4, false> S{(const char*)(ws + B_HH), (const char*)(ws + W_DN) + (size_t)l * 65 * 1024 * 256 * 2, nullptr, nullptr, lds, EFF, 1024, EFF, ntile * 4, nblk, bid};
    EpiDown E{lds + STG_OFF, ws + B_YY, ws + B_YS, ss64};
    pg::gemm<false>(lds, EFF, EFF, EFF, S, E);
    if (l == 0 && bg_idle(ntile * 4, nblk, bid)) bg_convert(p, lds, 1, 1);
}

typedef _Float16 h16x2 __attribute__((ext_vector_type(2)));
__device__ __forceinline__ unsigned pkh2(float a, float b) { h16x2 v; v.x = (_Float16)a; v.y = (_Float16)b; return __builtin_bit_cast(unsigned, v); }
__device__ __forceinline__ float h2lo(unsigned w) { return (float)__builtin_bit_cast(h16x2, w).x; }
__device__ __forceinline__ float h2hi(unsigned w) { return (float)__builtin_bit_cast(h16x2, w).y; }
template <int CTRL> __device__ __forceinline__ float dppf(float oldv, float v) {
    return __builtin_bit_cast(float, __builtin_amdgcn_update_dpp(__builtin_bit_cast(int, oldv), __builtin_bit_cast(int, v), CTRL, 0xf, 0xf, false));
}
template <bool SHL> __device__ __forceinline__ void scan16(float& A, float& H) {
#define SC_STEP(N) { const float Ap = dppf<(SHL ? 0x100 : 0x110) + N>(1.0f, A); const float Hp = dppf<(SHL ? 0x100 : 0x110) + N>(0.0f, H); H = A * Hp + H; A = A * Ap; }
    SC_STEP(1) SC_STEP(2) SC_STEP(4) SC_STEP(8)
#undef SC_STEP
}
struct SchedGates {
    const char* U; const char* W; int G, c;
    __device__ __forceinline__ bool next(int i, pg::Unit& u) const {
        const int L = i * G + c; if (L >= 2640) return false;
        const int wgid = pg::xcd_remap(L, 2640), pm = wgid / 20, rem = wgid % 20, h = rem >> 2, q = rem & 3;
        u.pm = pm; u.pn = q; u.e = h; u.rows = nullptr;
        u.a = U + ((size_t)pm * 256 * RW + h * 256) * 2; u.b = W + ((size_t)h * 1024 + q * 256) * 256 * 2; return true;
    }
};
struct EpiGates {
    static constexpr int PERM = 0;
    const bf16_t* uu; const float* rbias; const float* ibias; const float* cdec; unsigned char* ab; LAS unsigned char* stg;
    __device__ __forceinline__ void operator()(const f32x4 (&acc)[2][2][4][2], const pg::Unit& u, int wr, int wc, int fr, int fq) const {
        const int ch0 = u.e * 256 + u.pn * 64 + 16 * wc + 4 * fq;
        const f32x4 rb0 = *(const f32x4*)(rbias + ch0), rb1 = *(const f32x4*)(rbias + RW + ch0), ib0 = *(const f32x4*)(ibias + ch0), ib1 = *(const f32x4*)(ibias + RW + ch0);
        const f32x4 cd0 = *(const f32x4*)(cdec + ch0), cd1 = *(const f32x4*)(cdec + RW + ch0);
        u32x2 uws[8];
#pragma unroll
        for (int i = 0; i < 8; ++i) uws[i] = *(const u32x2*)(uu + ((size_t)u.pm * 256 + (i >> 2) * 128 + wr * 64 + (i & 3) * 16 + fr) * RW + ch0);
#pragma unroll
        for (int ai = 0; ai < 2; ++ai)
#pragma unroll
            for (int m = 0; m < 4; ++m) {
                const int rl = ai * 128 + wr * 64 + m * 16 + fr; const size_t R = (size_t)u.pm * 256 + rl;
                const u32x2 uw = uws[ai * 4 + m];
                const float uv[4] = {bflo(uw.x), bfhi(uw.x), bflo(uw.y), bfhi(uw.y)};
                unsigned o[8];
#pragma unroll
                for (int gi = 0; gi < 4; ++gi) {
                    const f32x4 v = acc[ai][gi >> 1][m][gi & 1];
                    const float r0 = sigm(v.x + rb0[gi]), i0 = sigm(v.y + ib0[gi]), r1 = sigm(v.z + rb1[gi]), i1 = sigm(v.w + ib1[gi]);
                    const float la0 = r0 * cd0[gi], la1 = r1 * cd1[gi];
                    float a0 = __expf(la0), a1 = __expf(la1);
                    float m0 = __builtin_amdgcn_sqrtf(fmaxf(1.0f - a0 * a0, 0.0f)), m1 = __builtin_amdgcn_sqrtf(fmaxf(1.0f - a1 * a1, 0.0f));
                    if (u.pm >= 128) { if (rl == 0) m0 = 1.0f; if (rl == CTXL - 1) m1 = 1.0f; }
                    float h0 = m0 * i0 * uv[gi], h1 = m1 * i1 * uv[gi];
#define GS_STEP(N) asm volatile("s_nop 1\n\tv_fmac_f32_dpp %0, %0, %2 row_shr:" #N " row_mask:0xf bank_mask:0xf\n\tv_fmac_f32_dpp %1, %1, %3 row_shl:" #N " row_mask:0xf bank_mask:0xf\n\tv_mul_f32_dpp %2, %2, %2 row_shr:" #N " row_mask:0xf bank_mask:0xf\n\tv_mul_f32_dpp %3, %3, %3 row_shl:" #N " row_mask:0xf bank_mask:0xf" : "+v"(h0), "+v"(h1), "+v"(a0), "+v"(a1));
                    GS_STEP(1) GS_STEP(2) GS_STEP(4) GS_STEP(8)
#undef GS_STEP
                    o[gi * 2] = pkh2(a0, h0); o[gi * 2 + 1] = pkh2(a1, h1);
                }
                u32x4* dst = (u32x4*)(ab + (R * RW + ch0) * 8);
                dst[0] = (u32x4){o[0], o[1], o[2], o[3]}; dst[1] = (u32x4){o[4], o[5], o[6], o[7]};
            }
    }
};
__device__ __forceinline__ void phase_gates_pg(const Params& p, LAS unsigned char* lds, int bid, int nblk) {
    unsigned char* ws = p.ws;
    SchedGates S{(const char*)(ws + B_UU), (const char*)(ws + W_GATE), nblk, bid};
    EpiGates E{(const bf16_t*)(ws + B_UU), p.in[12], p.in[14], (const float*)(ws + OFF_CDEC), ws + B_AB, lds + STG_OFF};
    pg::gemm<false>(lds, 256, RW, 256, S, E);
    if (bg_idle(2640, nblk, bid)) bg_convert(p, lds, 0, 2);
}
__device__ __forceinline__ void phase_scan_sb(const Params& p, int bid, int nblk) {
    unsigned char* ws = p.ws;
    const unsigned* ab = (const unsigned*)(ws + B_AB); float* sbc = (float*)(ws + OFF_AGG);
    const int gt = bid * NTHR + opq_tid(), ngt = nblk * NTHR;
    for (int i = gt; i < 2 * 132 * RW; i += ngt) {
        const int d = i / (132 * RW), sb = (i / RW) % 132, ch = i % RW;
        float A = 1.0f, H = 0.0f;
#pragma unroll 16
        for (int j = 0; j < 16; ++j) {
            const int k = d == 0 ? j : 15 - j; const size_t row = (size_t)sb * 256 + 16 * k + (d == 0 ? 15 : 0);
            const unsigned w = ab[(row * RW + ch) * 2 + d];
            H = h2lo(w) * H + h2hi(w); A *= h2lo(w);
        }
        sbc[(size_t)i * 2] = A; sbc[(size_t)i * 2 + 1] = H;
    }
}
__device__ __forceinline__ void phase_scan_carry(const Params& p, int bid, int nblk) {
    unsigned char* ws = p.ws;
    const unsigned* ab = (const unsigned*)(ws + B_AB); const float* sbc = (const float*)(ws + OFF_AGG); float* car = (float*)(ws + B_CAR);
    const int gt = bid * NTHR + opq_tid(), ngt = nblk * NTHR;
    for (int i = gt; i < 2 * 128 * RW; i += ngt) {
        const int d = i / (128 * RW), sb = (i / RW) % 128, ch = i % RW, b = sb >> 5, sl = sb & 31;
        float c = sbc[((size_t)(d * 132 + 128 + b) * RW + ch) * 2 + 1];
        const int nprev = d == 0 ? sl : 31 - sl;
        for (int j = 0; j < nprev; ++j) {
            const int s2 = d == 0 ? b * 32 + j : b * 32 + 31 - j;
            const float* q = sbc + ((size_t)(d * 132 + s2) * RW + ch) * 2;
            c = q[0] * c + q[1];
        }
#pragma unroll 16
        for (int j = 0; j < 16; ++j) {
            const int k = d == 0 ? j : 15 - j; const size_t row = (size_t)sb * 256 + 16 * k + (d == 0 ? 15 : 0);
            car[((size_t)d * 2048 + sb * 16 + k) * RW + ch] = c;
            const unsigned w = ab[(row * RW + ch) * 2 + d];
            c = h2lo(w) * c + h2hi(w);
        }
    }
}
__device__ __forceinline__ void phase_scan_apply(const Params& p, int bid, int nblk) {
    unsigned char* ws = p.ws;
    const unsigned char* ab = ws + B_AB; const float* car = (const float*)(ws + B_CAR); const bf16_t* gate0 = (const bf16_t*)(ws + B_GATE0); bf16_t* z0 = (bf16_t*)(ws + B_Z0);
    const int gt = bid * NTHR + opq_tid(), ngt = nblk * NTHR;
    for (int item = gt; item < 2048 * 320; item += ngt) {
        const int blk = item / 320, c4 = (item % 320) * 4;
        const f32x4 cf = *(const f32x4*)(car + (size_t)blk * RW + c4), cb = *(const f32x4*)(car + ((size_t)2048 + blk) * RW + c4);
#pragma unroll 8
        for (int r = 0; r < 16; ++r) {
            const size_t e = ((size_t)blk * 16 + r) * RW + c4;
            const u32x4 w0 = *(const u32x4*)(ab + e * 8), w1 = *(const u32x4*)(ab + e * 8 + 16);
            const u32x2 g = *(const u32x2*)(gate0 + e);
            const float y0 = (h2hi(w0.x) + h2lo(w0.x) * cf.x) + (h2hi(w0.y) + h2lo(w0.y) * cb.x);
            const float y1 = (h2hi(w0.z) + h2lo(w0.z) * cf.y) + (h2hi(w0.w) + h2lo(w0.w) * cb.y);
            const float y2 = (h2hi(w1.x) + h2lo(w1.x) * cf.z) + (h2hi(w1.y) + h2lo(w1.y) * cb.z);
            const float y3 = (h2hi(w1.z) + h2lo(w1.z) * cf.w) + (h2hi(w1.w) + h2lo(w1.w) * cb.w);
            u32x2 o; o.x = pk2(bflo(g.x) * y0, bfhi(g.x) * y1); o.y = pk2(bflo(g.y) * y2, bfhi(g.y) * y3);
            *(u32x2*)(z0 + e) = o;
        }
    }
}

#define XB_TMO      128
#define XB_XCNT(j)  (256  + 64 * (j))
#define XB_XSUB(j)  (1280 + 64 * (j))
#define XB_XGEN(j)  (2304 + 64 * (j))
#define XB_TOP      3328
#define XB_TOPGEN   3392
#define XCD_BAR_WORDS 3456
#define XB_SPIN_CAP (1u << 18)
__device__ __forceinline__ unsigned xb_ld(unsigned* p)              { return __hip_atomic_load(p, __ATOMIC_RELAXED, __HIP_MEMORY_SCOPE_AGENT); }
__device__ __forceinline__ unsigned xb_add(unsigned* p, unsigned v) { return __hip_atomic_fetch_add(p, v, __ATOMIC_RELAXED, __HIP_MEMORY_SCOPE_AGENT); }
__device__ __forceinline__ unsigned xb_xcc_id() { return (unsigned)__builtin_amdgcn_s_getreg((3 << 11) | 20) & 0xFu; }
#define XB_SPIN(cond, bar) do { unsigned _sp = 0; while (cond) { __builtin_amdgcn_s_sleep(1); \
    if ((++_sp & 255u) == 0u) { if (xb_ld(&(bar)[XB_TMO])) break; if (_sp > XB_SPIN_CAP) { atomicAdd(&(bar)[XB_TMO], 1u); break; } } } } while (0)
struct XcdBarrier { unsigned* bar; unsigned x; volatile LAS unsigned* st; };
__device__ __forceinline__ XcdBarrier xcd_barrier_post(unsigned* bar, volatile LAS unsigned* st) {
    XcdBarrier b; b.bar = bar; b.x = xb_xcc_id(); b.st = st;
    if (threadIdx.x == 0) (void)xb_add(&bar[XB_XCNT(b.x)], 1u);
    return b;
}
__device__ __forceinline__ void xcd_barrier_complete(unsigned* bar, unsigned x, unsigned& nloc, unsigned& nx) {
    const unsigned G = gridDim.x * gridDim.y * gridDim.z;
    unsigned sum, cnt, mine, sp = 0u;
    for (;;) {
        sum = 0u; cnt = 0u; mine = 0u;
#pragma unroll
        for (unsigned j = 0; j < 16; ++j) { const unsigned c = xb_ld(&bar[XB_XCNT(j)]); sum += c; cnt += (c > 0u) ? 1u : 0u; mine = (j == x) ? c : mine; }
        if (sum == G) break;
        __builtin_amdgcn_s_sleep(1);
        if ((++sp & 255u) == 0u) { if (xb_ld(&bar[XB_TMO])) break; if (sp > XB_SPIN_CAP) { atomicAdd(&bar[XB_TMO], 1u); break; } }
    }
    nloc = mine > 0u ? mine : 1u; nx = cnt > 0u ? cnt : 1u;
}
__device__ __forceinline__ void xcd_barrier(const XcdBarrier& b) {
    asm volatile("s_waitcnt vmcnt(0)" ::: "memory");
    __syncthreads();
    if (threadIdx.x == 0) {
        unsigned* bar = b.bar;
        __builtin_amdgcn_s_waitcnt(0);
        unsigned nloc = b.st[0], nx = b.st[1];
        if (nloc == 0u) { xcd_barrier_complete(bar, b.x, nloc, nx); b.st[0] = nloc; b.st[1] = nx; }
        const unsigned old = xb_add(&bar[XB_XSUB(b.x)], 1u);
        const unsigned gen = old / nloc;
        if (old + 1u == (gen + 1u) * nloc) {
            __builtin_amdgcn_fence(__ATOMIC_RELEASE, "agent");
            asm volatile("s_waitcnt vmcnt(0)" ::: "memory");
            const unsigned og = xb_add(&bar[XB_TOP], 1u);
            const unsigned tg = og / nx;
            if (og + 1u == (tg + 1u) * nx) xb_add(&bar[XB_TOPGEN], 1u);
            else XB_SPIN(xb_ld(&bar[XB_TOPGEN]) == tg, bar);
            __builtin_amdgcn_fence(__ATOMIC_ACQUIRE, "agent");
            xb_add(&bar[XB_XGEN(b.x)], 1u);
            asm volatile("s_waitcnt vmcnt(0)" ::: "memory");
        } else {
            XB_SPIN(xb_ld(&bar[XB_XGEN(b.x)]) == gen, bar);
            __builtin_amdgcn_fence(__ATOMIC_ACQUIRE, "agent");
            asm volatile("s_waitcnt vmcnt(0)" ::: "memory");
        }
    }
    __syncthreads();
}

#ifndef PROBE_G
#define PROBE_G 0
#endif
#define PH(g, call) do { unsigned long long _t0 = 0; if (PROBE_G == (g)) _t0 = __builtin_amdgcn_s_memrealtime(); call; xcd_barrier(xb); if (PROBE_G == (g)) tacc += __builtin_amdgcn_s_memrealtime() - _t0; } while (0)
__global__ void __launch_bounds__(NTHR) mk_fwd(Params p) {
    extern __shared__ __attribute__((aligned(16))) unsigned char lds_raw[];
    LAS unsigned char* lds = (LAS unsigned char*)lds_raw;
    cg::grid_group grid = cg::this_grid();
    const int bid = blockIdx.x, nblk = gridDim.x;
    unsigned char* ws = p.ws;
    const float* mod0 = (const float*)(ws + OFF_MOD); const float* mod1 = mod0 + 5 * 6144;
    unsigned long long tacc = 0;
    { volatile LAS unsigned* st0 = (volatile LAS unsigned*)(lds + LDS_BYTES - 16); if (threadIdx.x < 4) st0[threadIdx.x] = 0u; }
    __syncthreads();
    XcdBarrier xb = xcd_barrier_post((unsigned*)ws, (volatile LAS unsigned*)(lds + LDS_BYTES - 16));
    { unsigned long long _t0 = 0; if (PROBE_G == 1) _t0 = __builtin_amdgcn_s_memrealtime();
      phase0(p, lds, bid, nblk);
      if (p.ws == nullptr) grid.sync();
      xcd_barrier(xb);
      if (PROBE_G == 1) tacc += __builtin_amdgcn_s_memrealtime() - _t0; }
    PH(2, (row_phase<0, false, false>(p, bid, nblk, p.in[6], mod0, 0, 1024, nullptr, nullptr)));
    PH(6, phase_inproj0_pg(p, lds, bid, nblk));
    PH(12, phase_conv(p, bid, nblk));
    PH(7, phase_gates_pg(p, lds, bid, nblk));
    PH(3, phase_scan_sb(p, bid, nblk));
    PH(3, phase_scan_carry(p, bid, nblk));
    PH(13, phase_scan_apply(p, bid, nblk));
    PH(6, phase_outproj_pg(p, lds, bid, nblk, (const bf16_t*)(ws + B_Z0), RW, (const bf16_t*)(ws + W_AOUT), mod0, ws + B_DX0));
    PH(4, phase_normroute(p, lds, bid, nblk, 0, p.in[7], mod0, (const bf16_t*)(ws + B_DX0)));
    PH(10, phase_scatter(p, lds, bid, nblk, 0));
    PH(8, phase_moe_up(p, lds, bid, nblk, 0));
    PH(9, phase_moe_down(p, lds, bid, nblk, 0));
    PH(2, (row_phase<2, false, false>(p, bid, nblk, p.in[6] + D, mod1, 0, 1024, mod0, nullptr)));
    PH(6, phase_inproj1_pg(p, lds, bid, nblk));
    PH(11, phase_sgu(p, lds, bid, nblk));
    PH(6, phase_outproj_pg(p, lds, bid, nblk, (const bf16_t*)(ws + B_Z1), SW, (const bf16_t*)(ws + W_BOUT), mod1, ws + B_DX1));
    PH(4, phase_normroute(p, lds, bid, nblk, 1, p.in[7] + D, mod1, (const bf16_t*)(ws + B_DX1)));
    PH(10, phase_scatter(p, lds, bid, nblk, 1));
    PH(8, phase_moe_up(p, lds, bid, nblk, 1));
    PH(9, phase_moe_down(p, lds, bid, nblk, 1));
    { unsigned long long _t0 = 0; if (PROBE_G == 2) _t0 = __builtin_amdgcn_s_memrealtime();
      row_phase<2, false, true>(p, bid, nblk, p.in[29], mod1, 0, 0, mod1, nullptr);
      if (PROBE_G == 2) tacc += __builtin_amdgcn_s_memrealtime() - _t0; }
    if (PROBE_G != 0 && bid == 0 && threadIdx.x == 0) {
        const unsigned long long t0 = __builtin_amdgcn_s_memrealtime();
        while (__builtin_amdgcn_s_memrealtime() - t0 < 3ull * tacc) __builtin_amdgcn_s_sleep(20);
    }
}

extern "C" void kernel_launch(void* const* d_in, const int* in_sizes, int n_in, void* d_out, int out_size, void* d_ws, size_t ws_size, hipStream_t stream) {
    static int grid_blocks = 0;
    if (grid_blocks == 0) {
        if (n_in != 30 || out_size != NTOK * D || ws_size < WS_NEED) { fprintf(stderr, "kernel_launch: unexpected shapes (n_in %d out %d ws %zu need %zu)\n", n_in, out_size, ws_size, (size_t)WS_NEED); grid_blocks = -1; return; }
        int dev = 0, cus = 0, per_cu = 0;
        (void)hipGetDevice(&dev);
        (void)hipDeviceGetAttribute(&cus, hipDeviceAttributeMultiprocessorCount, dev);
        if (hipFuncSetAttribute((const void*)mk_fwd, hipFuncAttributeMaxDynamicSharedMemorySize, LDS_BYTES) != hipSuccess) { fprintf(stderr, "kernel_launch: hipFuncSetAttribute failed\n"); grid_blocks = -1; return; }
        (void)hipOccupancyMaxActiveBlocksPerMultiprocessor(&per_cu, mk_fwd, NTHR, LDS_BYTES);
        if (per_cu < 1) per_cu = 1;
        if (per_cu > 2) per_cu = 2;
        grid_blocks = cus * per_cu;
        fprintf(stderr, "kernel_launch: cus %d per_cu %d grid %d\n", cus, per_cu, grid_blocks);
    }
    if (grid_blocks < 0) return;
    if (hipMemsetAsync(d_ws, 0, 65536, stream) != hipSuccess) { fprintf(stderr, "kernel_launch: memset failed\n"); return; }
    Params p{};
    for (int i = 0; i < 30; ++i) p.in[i] = (const float*)d_in[i];
    p.out = (float*)d_out; p.ws = (unsigned char*)d_ws;
    void* args[] = {&p};
    hipError_t e = hipLaunchCooperativeKernel((void*)mk_fwd, dim3(grid_blocks), dim3(NTHR), args, LDS_BYTES, stream);
    if (e != hipSuccess) fprintf(stderr, "cooperative launch failed: %s (grid %d)\n", hipGetErrorString(e), grid_blocks);
}
```

```cpp
#include <hip/hip_runtime.h>
#include <hip/hip_cooperative_groups.h>
#include <cstdio>
#include <cstdint>
namespace cg = cooperative_groups;

#define LAS __attribute__((address_space(3)))
typedef unsigned short bf16_t;
typedef short bf16x8 __attribute__((ext_vector_type(8)));
typedef float f32x4 __attribute__((ext_vector_type(4)));
typedef unsigned u32x4 __attribute__((ext_vector_type(4)));
typedef unsigned u32x2 __attribute__((ext_vector_type(2)));

constexpr int D = 1024, NB = 4, SEQ = 8192, NTOK = NB * SEQ, CTXL = 256, NCTX = NB * CTXL, NROW = NTOK + NCTX;
constexpr int RW = 1280;
constexpr int SW = 2048;
constexpr int NE = 64, TOPK = 8, EFF = 256;
constexpr int TM = 256;
constexpr int NSLOT = 278528;
constexpr int NTHR = 512;
constexpr int STG_OFF = 139264;
constexpr int LDS_BYTES = 157248;

constexpr size_t MiB = (size_t)1 << 20;
constexpr size_t OFF_MOD = 1 * MiB;
constexpr size_t OFF_POS = OFF_MOD + 262144;
constexpr size_t OFF_CDEC = OFF_POS + 262144;
constexpr size_t OFF_CNT = OFF_CDEC + 16384;
constexpr size_t OFF_META = OFF_CNT + 65536;
constexpr size_t OFF_IDENT = OFF_META + 4096 + 45056;
constexpr size_t OFF_AGG = 2 * MiB;
constexpr size_t OFF_CARRY = 8 * MiB;
constexpr size_t OFF_EIDX = 11 * MiB;
constexpr size_t OFF_GATEW = 12 * MiB;
constexpr size_t OFF_SLOTOF = 13 * MiB;
constexpr size_t OFF_TOKOF = 14 * MiB;
constexpr size_t OFF_WOF = 16 * MiB;
constexpr size_t OFF_CNTW2 = 17 * MiB + 512 * 1024;
constexpr size_t OFF_W = 18 * MiB;
constexpr size_t W_AIN = OFF_W;
constexpr size_t W_AOUT = W_AIN + (size_t)2560 * 1024 * 2;
constexpr size_t W_GATE = W_AOUT + (size_t)1024 * 1280 * 2;
constexpr size_t W_BIN = W_GATE + (size_t)5 * 1024 * 256 * 2;
constexpr size_t W_BOUT = W_BIN + (size_t)4096 * 1024 * 2;
constexpr size_t W_S = W_BOUT + (size_t)1024 * 2048 * 2;
constexpr size_t W_RT = W_S + (size_t)8 * 128 * 128 * 2;
constexpr size_t W_GU = W_RT + (size_t)2 * 128 * 3072 * 2;
constexpr size_t W_DN = W_GU + (size_t)2 * 65 * 512 * 1024 * 2;
constexpr size_t W_END = W_DN + (size_t)2 * 65 * 1024 * 256 * 2;
constexpr size_t OFF_HX = 237 * MiB;
constexpr size_t OFF_BIG = OFF_HX + 66 * MiB;
constexpr size_t OFF_STATP = OFF_BIG + 320 * MiB;
constexpr size_t B_GATE0 = OFF_BIG;
constexpr size_t B_UPRE = OFF_BIG + 80 * MiB;
constexpr size_t B_UU = OFF_BIG + 163 * MiB;
constexpr size_t B_Z0 = OFF_BIG + 246 * MiB;
constexpr size_t B_AB = OFF_BIG + 326 * MiB;
constexpr size_t B_CAR = OFF_BIG + 80 * MiB;
constexpr size_t B_DX0 = OFF_BIG + 326 * MiB;
constexpr size_t B_DX1 = OFF_BIG + 256 * MiB;
constexpr size_t B_UV = OFF_BIG;
constexpr size_t B_VNT = OFF_BIG + 256 * MiB;
constexpr size_t B_Z1 = OFF_BIG + 384 * MiB;
constexpr size_t B_HLO = OFF_BIG;
constexpr size_t B_HH = OFF_BIG;
constexpr size_t B_YY = OFF_BIG + 160 * MiB;
constexpr size_t B_YS = OFF_BIG + 448 * MiB;
constexpr size_t B_XR = OFF_BIG + 656 * MiB;
constexpr size_t WS_NEED = OFF_BIG + 720 * MiB;
static_assert(W_END <= OFF_HX, "weights overflow");
static_assert((size_t)(NSLOT + NTOK) * 256 * 2 <= 160 * MiB, "H overflow");
static_assert((size_t)NSLOT * 1024 * 2 <= 544 * MiB, "Y overflow");
static_assert(WS_NEED <= 1024 * MiB, "ws overflow");
constexpr long LO_DELTA = (long)((B_HLO - OFF_HX) / 2);

__device__ __forceinline__ unsigned f2bf(float f) { unsigned u = __builtin_bit_cast(unsigned, f); return (u + 0x7fffu + ((u >> 16) & 1u)) >> 16; }
__device__ __forceinline__ unsigned pk2(float lo, float hi) { unsigned r; asm volatile("v_cvt_pk_bf16_f32 %0, %1, %2" : "=v"(r) : "v"(lo), "v"(hi)); return r; }
__device__ __forceinline__ float bf2f(unsigned b) { return __builtin_bit_cast(float, b << 16); }
__device__ __forceinline__ float bflo(unsigned w) { return __builtin_bit_cast(float, w << 16); }
__device__ __forceinline__ float bfhi(unsigned w) { return __builtin_bit_cast(float, w & 0xffff0000u); }
__device__ __forceinline__ float sigm(float x) { return __builtin_amdgcn_rcpf(1.0f + __expf(-x)); }
__device__ __forceinline__ float silu(float x) { return x * __builtin_amdgcn_rcpf(1.0f + __expf(-x)); }
__device__ __forceinline__ float gelu_t(float x) { const float y = 1.5957691216057308f * (x + 0.044715f * x * x * x); return x * __builtin_amdgcn_rcpf(1.0f + __expf(-y)); }
template <int CTRL> __device__ __forceinline__ float dpp_mv(float v) { return __builtin_bit_cast(float, __builtin_amdgcn_update_dpp(__builtin_bit_cast(int, v), __builtin_bit_cast(int, v), CTRL, 0xf, 0xf, false)); }
template <int CTRL> __device__ __forceinline__ int dpp_mvi(int v) { return __builtin_amdgcn_update_dpp(v, v, CTRL, 0xf, 0xf, false); }
__device__ __forceinline__ float wave_sum(float v) {
    v += dpp_mv<0xB1>(v); v += dpp_mv<0x4E>(v); v += dpp_mv<0x141>(v); v += dpp_mv<0x140>(v);
    const int b = __builtin_bit_cast(int, v);
    return (__builtin_bit_cast(float, __builtin_amdgcn_readlane(b, 0)) + __builtin_bit_cast(float, __builtin_amdgcn_readlane(b, 16)))
         + (__builtin_bit_cast(float, __builtin_amdgcn_readlane(b, 32)) + __builtin_bit_cast(float, __builtin_amdgcn_readlane(b, 48)));
}
__device__ __forceinline__ float max8(float v) { v = fmaxf(v, dpp_mv<0xB1>(v)); v = fmaxf(v, dpp_mv<0x4E>(v)); return fmaxf(v, dpp_mv<0x141>(v)); }
__device__ __forceinline__ int min8(int v) { v = min(v, dpp_mvi<0xB1>(v)); v = min(v, dpp_mvi<0x4E>(v)); return min(v, dpp_mvi<0x141>(v)); }

__device__ __forceinline__ int opq_tid() { int t = threadIdx.x; asm volatile("" : "+v"(t)); return t; }
__device__ __forceinline__ u32x4 pack8(f32x4 a, f32x4 b) { u32x4 w; w.x = pk2(a.x, a.y); w.y = pk2(a.z, a.w); w.z = pk2(b.x, b.y); w.w = pk2(b.z, b.w); return w; }
__device__ __forceinline__ unsigned pk4_fp8(f32x4 v) { int w = 0; w = __builtin_amdgcn_cvt_pk_fp8_f32(v.x, v.y, w, false); w = __builtin_amdgcn_cvt_pk_fp8_f32(v.z, v.w, w, true); return (unsigned)w; }
__device__ __forceinline__ f32x4 up4_fp8(unsigned w) { return (f32x4){__builtin_amdgcn_cvt_f32_fp8((int)w, 0), __builtin_amdgcn_cvt_f32_fp8((int)w, 1), __builtin_amdgcn_cvt_f32_fp8((int)w, 2), __builtin_amdgcn_cvt_f32_fp8((int)w, 3)}; }
struct Params { const float* in[30]; float* out; unsigned char* ws; };

struct KDef { __device__ __forceinline__ long operator()(int kt) const { return (long)kt * 32; } };

template <class KOffA, class Epi>
__device__ __forceinline__ void gemm_tile(const bf16_t* arow, const bf16_t* brow, int nk, KOffA koffa, Epi epi, LAS unsigned char* lds) {
    const int tid = opq_tid(), lane = tid & 63, wid = tid >> 6, wr = wid >> 2, wc = wid & 3, fr = lane & 15, fq = lane >> 4;
    const int sw = (tid >> 2) * 80 + (tid & 3) * 16;
    f32x4 acc[4][2];
#pragma unroll
    for (int m = 0; m < 4; ++m)
#pragma unroll
        for (int n = 0; n < 2; ++n) acc[m][n] = (f32x4){0.f, 0.f, 0.f, 0.f};
    u32x4 ra = *(const u32x4*)(arow + koffa(0));
    u32x4 rb = *(const u32x4*)(brow);
    const int aoff = (wr * 64 + fr) * 80 + fq * 16, boff = 10240 + (wc * 32 + fr) * 80 + fq * 16;
    for (int kt = 0; kt < nk; ++kt) {
        LAS unsigned char* buf = lds + (kt & 1) * 20480;
        *(LAS u32x4*)(buf + sw) = ra;
        *(LAS u32x4*)(buf + 10240 + sw) = rb;
        __syncthreads();
        if (kt + 1 < nk) { ra = *(const u32x4*)(arow + koffa(kt + 1)); rb = *(const u32x4*)(brow + (long)(kt + 1) * 32); }
        bf16x8 af[4], bfv[2];
#pragma unroll
        for (int m = 0; m < 4; ++m) af[m] = *(LAS bf16x8*)(buf + aoff + m * 1280);
#pragma unroll
        for (int n = 0; n < 2; ++n) bfv[n] = *(LAS bf16x8*)(buf + boff + n * 1280);
#pragma unroll
        for (int m = 0; m < 4; ++m)
#pragma unroll
            for (int n = 0; n < 2; ++n) acc[m][n] = __builtin_amdgcn_mfma_f32_16x16x32_bf16(bfv[n], af[m], acc[m][n], 0, 0, 0);
    }
    __syncthreads();
#pragma unroll
    for (int m = 0; m < 4; ++m)
#pragma unroll
        for (int n = 0; n < 2; ++n) epi(wr * 64 + m * 16 + fr, wc * 32 + n * 16 + fq * 4, acc[m][n]);
}

namespace pg {
constexpr int BM = 256, BK = 64, HALF = 128, HTB = HALF * BK * 2, STAGE_BYTES = 8 * HTB;
__device__ __forceinline__ int lds_byte(int r, int c) { const int st = (r >> 4) * 2 + (c >> 5), rr = r & 15, cc = c & 31, ob = rr * 64 + cc * 2; return st * 1024 + (ob ^ (((ob >> 9) & 1) << 5)); }
__device__ __forceinline__ void stage_rc(int b, int& R, int& C) { const int st = b / 1024, sb = b % 1024, swz = sb ^ (((sb >> 9) & 1) << 5); R = (st >> 1) * 16 + swz / 64; C = (st & 1) * 32 + (swz % 64) / 2; }
__device__ __forceinline__ int perm32(int rho) { const int n = rho >> 4, i = rho & 15; return 8 * (i >> 2) + 4 * n + (i & 3); }
__device__ __forceinline__ int xcd_remap(int L, int nwg) { const int q = nwg / 8, r = nwg % 8, xcd = L % 8, off = L / 8; return (xcd < r ? xcd * (q + 1) : r * (q + 1) + (xcd - r) * q) + off; }

struct Unit { const char* a; const char* b; const int* rows; int pm, pn, e; };

template <bool GATHER, class Sched, class Epi>
__device__ __forceinline__ void gemm(LAS unsigned char* lds, const int K, const int lda, const int ldb, const Sched& S, const Epi& E) {
    const int tid = opq_tid(), wid = __builtin_amdgcn_readfirstlane(tid >> 6), lane = tid & 63, wr = wid >> 2, wc = wid & 3, fr = lane & 15, fq = lane >> 4;
    const int nt = K / BK;
    int RA[2]; unsigned ca2[2], voffB[2][2];
#pragma unroll
    for (int i = 0; i < 2; ++i) { int R, C; stage_rc(tid * 16 + i * 8192, R, C);
        RA[i] = R; ca2[i] = (unsigned)C * 2u;
#pragma unroll
        for (int h = 0; h < 2; ++h) {
            const int Rb = (int)Epi::PERM == 2 ? 64 * (R >> 5) + 32 * h + perm32(R & 31) : HALF * h + ((int)Epi::PERM == 1 ? ((R & ~31) + perm32(R & 31)) : R);
            voffB[h][i] = (unsigned)(Rb * ldb + C) * 2u; } }
    const unsigned lda2 = (unsigned)lda * 2u;
    const size_t kstep = (size_t)(BK * 2);
    const unsigned ldsw = (unsigned)wid * 1024u;
    const int aoff = lds_byte(wr * 64 + fr, fq * 8), boff = lds_byte(wc * 32 + fr, fq * 8);
    unsigned vc[2][2], vn[2][2];
#define PG_SA(b, h) (((b) * 2 + (h)) * HTB)
#define PG_SB(b, h) ((4 + (b) * 2 + (h)) * HTB)
#define PG_GL(bufoff, gp0, gp1) do { \
        __builtin_amdgcn_global_load_lds((const unsigned*)(gp0), (LAS unsigned*)(lds + (bufoff) + ldsw), 16, 0, 0); \
        __builtin_amdgcn_global_load_lds((const unsigned*)(gp1), (LAS unsigned*)(lds + (bufoff) + ldsw + 8192), 16, 0, 0); } while (0)
#define PG_STB(bufoff, gbase, h) PG_GL(bufoff, (const char*)(gbase) + voffB[h][0], (const char*)(gbase) + voffB[h][1])
#define PG_STA(bufoff, gbase, V, h) PG_GL(bufoff, (const char*)(gbase) + V[h][0], (const char*)(gbase) + V[h][1])
#define PG_LDA(dst, b, h) do { _Pragma("unroll") for (int m = 0; m < 4; ++m) _Pragma("unroll") for (int k = 0; k < 2; ++k) dst[m][k] = *(const LAS bf16x8*)(lds + PG_SA(b, h) + aoff + m * 2048 + k * 1024); } while (0)
#define PG_LDB(dst, b, h) do { _Pragma("unroll") for (int n = 0; n < 2; ++n) _Pragma("unroll") for (int k = 0; k < 2; ++k) dst[n][k] = *(const LAS bf16x8*)(lds + PG_SB(b, h) + boff + n * 2048 + k * 1024); } while (0)
#define PG_MMA(ai, bj, At, Bt) do { __builtin_amdgcn_s_setprio(1); _Pragma("unroll") for (int m = 0; m < 4; ++m) _Pragma("unroll") for (int n = 0; n < 2; ++n) _Pragma("unroll") for (int k = 0; k < 2; ++k) \
        acc[ai][bj][m][n] = __builtin_amdgcn_mfma_f32_16x16x32_bf16(Bt[n][k], At[m][k], acc[ai][bj][m][n], 0, 0, 0); __builtin_amdgcn_s_setprio(0); } while (0)
#define PG_WAIT_V(n) asm volatile("s_waitcnt vmcnt(" #n ")" ::: "memory")
#define PG_WAIT_L(n) asm volatile("s_waitcnt lgkmcnt(" #n ")" ::: "memory")
#define PG_BAR __builtin_amdgcn_s_barrier()
#define PG_SCHED __builtin_amdgcn_sched_barrier(0)
#define PG_SETOFF(V, U) do { _Pragma("unroll") for (int h = 0; h < 2; ++h) _Pragma("unroll") for (int i = 0; i < 2; ++i) \
        V[h][i] = (GATHER ? (unsigned)(U).rows[RA[i] + HALF * h] : (unsigned)(RA[i] + HALF * h)) * lda2 + ca2[i]; } while (0)
    Unit cur, nxt; int ui = 0;
    if (!S.next(0, cur)) return;
    PG_SETOFF(vc, cur);
    f32x4 acc[2][2][4][2];
#pragma unroll
    for (int a = 0; a < 2; ++a)
#pragma unroll
        for (int b = 0; b < 2; ++b)
#pragma unroll
            for (int m = 0; m < 4; ++m)
#pragma unroll
                for (int n = 0; n < 2; ++n) acc[a][b][m][n] = (f32x4){0.f, 0.f, 0.f, 0.f};
    bf16x8 At[4][2], B0[2][2], B1[2][2];
    const char* cA = cur.a; const char* cB = cur.b;
    PG_STB(PG_SB(0, 0), cB, 0); PG_STB(PG_SB(0, 1), cB, 1); PG_STA(PG_SA(0, 0), cA, vc, 0); PG_STA(PG_SA(0, 1), cA, vc, 1);
    if (wr == 1) PG_BAR;
    PG_WAIT_V(2); PG_BAR;
    PG_STB(PG_SB(1, 0), cB + kstep, 0); PG_STA(PG_SA(1, 0), cA + kstep, vc, 0); PG_STB(PG_SB(1, 1), cB + kstep, 1);
    PG_WAIT_V(6); PG_BAR;
#define PG_PAIR(a1, a2, b2, a3, b3, SWAP) do { \
        PG_LDB(B0, 0, 0); PG_LDB(B1, 0, 1); PG_SCHED; PG_LDA(At, 0, 0); PG_STA(PG_SA(1, 1), a1, vc, 1); \
        if (GATHER) { if (SWAP) { vc[0][0] = vn[0][0]; vc[0][1] = vn[0][1]; vc[1][0] = vn[1][0]; vc[1][1] = vn[1][1]; } } \
        PG_WAIT_V(8); PG_WAIT_L(0); PG_BAR; PG_MMA(0, 0, At, B0); PG_MMA(0, 1, At, B1); PG_BAR; PG_SCHED; \
        PG_LDA(At, 0, 1); PG_STB(PG_SB(0, 0), b2, 0); PG_STB(PG_SB(0, 1), b2, 1); PG_STA(PG_SA(0, 0), a2, vc, 0); \
        PG_WAIT_V(8); PG_WAIT_L(0); PG_BAR; PG_MMA(1, 0, At, B0); PG_MMA(1, 1, At, B1); PG_BAR; PG_SCHED; \
        PG_LDB(B0, 1, 0); PG_LDB(B1, 1, 1); PG_SCHED; PG_LDA(At, 1, 0); PG_STA(PG_SA(0, 1), a2, vc, 1); \
        PG_WAIT_V(8); PG_WAIT_L(0); PG_BAR; PG_MMA(0, 0, At, B0); PG_MMA(0, 1, At, B1); PG_BAR; PG_SCHED; \
        PG_LDA(At, 1, 1); PG_STB(PG_SB(1, 0), b3, 0); PG_STB(PG_SB(1, 1), b3, 1); PG_STA(PG_SA(1, 0), a3, vc, 0); \
        PG_WAIT_V(8); PG_WAIT_L(0); PG_BAR; PG_MMA(1, 0, At, B0); PG_MMA(1, 1, At, B1); PG_BAR; PG_SCHED; } while (0)
    for (;;) {
        const bool has_next = S.next(ui + 1, nxt);
        const char* nA = has_next ? nxt.a : cA; const char* nB = has_next ? nxt.b : cB;
        if (GATHER) { if (has_next) { PG_SETOFF(vn, nxt); } }
#pragma nounroll
        for (int t = 0; t < nt; t += 2) {
            const bool last = (t == nt - 2);
            const char* a1 = cA + (size_t)(t + 1) * kstep;
            const char* a2 = last ? nA : cA + (size_t)(t + 2) * kstep; const char* b2 = last ? nB : cB + (size_t)(t + 2) * kstep;
            const char* a3 = a2 + kstep; const char* b3 = b2 + kstep;
            PG_PAIR(a1, a2, b2, a3, b3, (last && has_next));
        }
        if (wr == 0) PG_BAR;
        { int efr = fr, efq = fq; asm volatile("" : "+v"(efr), "+v"(efq)); E(acc, cur, wr, wc, efr, efq); }
        if (!has_next) break;
#pragma unroll
        for (int a = 0; a < 2; ++a)
#pragma unroll
            for (int b = 0; b < 2; ++b)
#pragma unroll
                for (int m = 0; m < 4; ++m)
#pragma unroll
                    for (int n = 0; n < 2; ++n) acc[a][b][m][n] = (f32x4){0.f, 0.f, 0.f, 0.f};
        cur = nxt; cA = nA; cB = nB; ++ui;
        if (wr == 1) PG_BAR;
    }
    PG_WAIT_V(0);
    PG_BAR;
#undef PG_SA
#undef PG_SB
#undef PG_GL
#undef PG_STB
#undef PG_STA
#undef PG_LDA
#undef PG_LDB
#undef PG_MMA
#undef PG_WAIT_V
#undef PG_WAIT_L
#undef PG_BAR
#undef PG_SCHED
#undef PG_SETOFF
#undef PG_PAIR
}

struct SchedPlain {
    const char* A; const char* B; int lda, ldb, nM, nN, nwg, G, c;
    __device__ __forceinline__ bool next(int i, Unit& u) const {
        const long L = (long)i * G + c; if (L >= nwg) return false;
        const int wgid = xcd_remap((int)L, nwg);
        const int nig = 8 * nN, gid = wgid / nig, fm = gid * 8, gsz = (nM - fm) < 8 ? (nM - fm) : 8;
        u.pm = fm + ((wgid % nig) % gsz); u.pn = (wgid % nig) / gsz; u.e = 0; u.rows = nullptr;
        u.a = A + (size_t)u.pm * BM * lda * 2; u.b = B + (size_t)u.pn * BM * ldb * 2; return true;
    }
};
}

__device__ __forceinline__ void tr_item(const float* W, int N, int k0, int n0, bf16_t* WT, int ldt, int mode, int rmul, int radd, LAS float* scr, int lane) {
    f32x4 t[16];
#pragma unroll
    for (int i = 0; i < 16; ++i) t[i] = *(const f32x4*)(W + (size_t)(k0 + (lane >> 4) + 4 * i) * N + n0 + (lane & 15) * 4);
#pragma unroll
    for (int i = 0; i < 16; ++i) { LAS float* d = scr + ((lane >> 4) + 4 * i) * 65 + (lane & 15) * 4; d[0] = t[i].x; d[1] = t[i].y; d[2] = t[i].z; d[3] = t[i].w; }
    asm volatile("s_waitcnt lgkmcnt(0)" ::: "memory");
    const int c = lane & 7;
#pragma unroll
    for (int j = 0; j < 8; ++j) {
        const int n = (lane >> 3) + 8 * j; const LAS float* s = scr + (8 * c) * 65 + n;
        u32x4 o; o.x = pk2(s[0 * 65], s[1 * 65]); o.y = pk2(s[2 * 65], s[3 * 65]); o.z = pk2(s[4 * 65], s[5 * 65]); o.w = pk2(s[6 * 65], s[7 * 65]);
        const int ng = n0 + n;
        const int drow = mode == 1 ? (((ng & 255) >> 7) * 256 + (ng >> 8) * 128 + (ng & 127))
                       : mode == 2 ? ((ng >> 6) * 256 + ((ng >> 1) & 1) * 128 + ((ng >> 4) & 3) * 32 + (ng & 1) * 16 + ((ng >> 2) & 3) * 4 + radd) : ng * rmul + radd;
        *(u32x4*)(WT + (size_t)drow * ldt + k0 + 8 * c) = o;
    }
    asm volatile("s_waitcnt lgkmcnt(0)" ::: "memory");
}

__device__ __forceinline__ void phase0(const Params& p, LAS unsigned char* lds, int bid, int nblk) {
    const int tid = opq_tid(), lane = tid & 63, wid = tid >> 6;
    unsigned char* ws = p.ws;
    const int gt = bid * NTHR + tid, ngt = nblk * NTHR;
    float* pos = (float*)(ws + OFF_POS);
    for (int i = gt; i < 128 * 512; i += ngt) {
        const int r = i >> 9, c = i & 511, q = c & 255;
        const float omega = 1.0f / exp2f((float)q * (13.287712379549449f / 256.0f));
        const float ang = (float)r * omega;
        pos[i] = c < 256 ? __sinf(ang) : __cosf(ang);
    }
    float* cdec = (float*)(ws + OFF_CDEC);
    for (int i = gt; i < 2 * RW; i += ngt) cdec[i] = -8.0f * log1pf(expf(-p.in[15][i]));
    { int* ident = (int*)(ws + OFF_IDENT); for (int i = gt; i < NTOK; i += ngt) ident[i] = i; }
    {
        bf16_t* ws_s = (bf16_t*)(ws + W_S);
        for (int i = gt; i < 8 * 128 * 128; i += ngt) ws_s[i] = (bf16_t)f2bf(p.in[20][i]);
        bf16_t* wrt = (bf16_t*)(ws + W_RT);
        for (int i = gt; i < 2 * 1024 * 64; i += ngt) {
            const int l = i >> 16, k = (i >> 6) & 1023, e = i & 63;
            const float w = p.in[23][i];
            const unsigned hi = f2bf(w); const unsigned lo = f2bf(w - bf2f(hi));
            bf16_t* row = wrt + ((size_t)(l * 128 + e)) * 3072;
            row[k] = (bf16_t)hi; row[1024 + k] = (bf16_t)hi; row[2048 + k] = (bf16_t)lo;
        }
        unsigned* wz = (unsigned*)wrt;
        for (int i = gt; i < 2 * 64 * 1536; i += ngt) { const int l = i / (64 * 1536), r = i % (64 * 1536); wz[(size_t)(l * 128 + 64) * 1536 + r] = 0u; }
    }
    for (int it = bid; it < 192; it += nblk) {
        LAS float* sv = (LAS float*)lds;
        LAS float* red = (LAS float*)(lds + 20480);
        for (int i = tid; i < 5 * 1024; i += NTHR) { const float cv = i < 4096 ? p.in[1][i] : p.in[3][i - 4096]; sv[i] = silu(cv); }
        __syncthreads();
        const int l = it / 96, col0 = (it % 96) * 64;
        const float* w = p.in[4] + (size_t)l * 1024 * 6144 + col0 + lane;
        float a0 = 0.f, a1 = 0.f, a2 = 0.f, a3 = 0.f, a4 = 0.f;
        const int kb = wid * 128;
        for (int k0 = kb; k0 < kb + 128; k0 += 32) {
            float wv[32];
#pragma unroll
            for (int i = 0; i < 32; ++i) wv[i] = w[(size_t)(k0 + i) * 6144];
#pragma unroll
            for (int i = 0; i < 32; ++i) { const int k = k0 + i;
                a0 += sv[k] * wv[i]; a1 += sv[1024 + k] * wv[i]; a2 += sv[2048 + k] * wv[i]; a3 += sv[3072 + k] * wv[i]; a4 += sv[4096 + k] * wv[i]; }
        }
        red[(wid * 5 + 0) * 64 + lane] = a0; red[(wid * 5 + 1) * 64 + lane] = a1; red[(wid * 5 + 2) * 64 + lane] = a2;
        red[(wid * 5 + 3) * 64 + lane] = a3; red[(wid * 5 + 4) * 64 + lane] = a4;
        __syncthreads();
        if (tid < 320) {
            const int v = tid >> 6, ln = tid & 63; float s = 0.f;
#pragma unroll
            for (int w8 = 0; w8 < 8; ++w8) s += red[(w8 * 5 + v) * 64 + ln];
            ((float*)(ws + OFF_MOD))[(size_t)(l * 5 + v) * 6144 + col0 + ln] = s + p.in[5][l * 6144 + col0 + ln];
        }
        __syncthreads();
    }
    LAS float* scr = (LAS float*)(lds + wid * 16640);
    const int gw = bid * 8 + wid, ngw = nblk * 8;
    constexpr int I_AIN = 16 * 40, I_AOUT = 20 * 16, I_GATE = 20 * 16, I_BIN = 16 * 64, I_BOUT = 32 * 16;
    constexpr int NITEMS = I_AIN + I_AOUT + I_GATE + I_BIN + I_BOUT;
    for (int it = gw; it < NITEMS; it += ngw) {
        int r = it;
        if (r < I_AIN) { const int kb = r / 40, nb = r % 40; tr_item(p.in[8], 2560, kb * 64, nb * 64, (bf16_t*)(ws + W_AIN), 1024, 0, 1, 0, scr, lane); continue; }
        r -= I_AIN;
        if (r < I_AOUT) { const int kb = r / 16, nb = r % 16; tr_item(p.in[16], 1024, kb * 64, nb * 64, (bf16_t*)(ws + W_AOUT), 1280, 0, 1, 0, scr, lane); continue; }
        r -= I_AOUT;
        if (r < I_GATE) {
            const int mi = r >> 4, q = r & 15, kb = q >> 2, nb = q & 3, h = mi % 5, dg = mi / 5, d = dg >> 1, g = dg & 1;
            const float* src = (g ? p.in[13] : p.in[11]) + (size_t)(d * 5 + h) * 65536;
            tr_item(src, 256, kb * 64, nb * 64, (bf16_t*)(ws + W_GATE) + (size_t)h * 1024 * 256, 256, 2, 4, d * 2 + g, scr, lane); continue; }
        r -= I_GATE;
        if (r < I_BIN) { const int kb = r / 64, nb = r % 64; tr_item(p.in[17], 4096, kb * 64, nb * 64, (bf16_t*)(ws + W_BIN), 1024, 0, 1, 0, scr, lane); continue; }
        r -= I_BIN;
        { const int kb = r / 16, nb = r % 16; tr_item(p.in[22], 1024, kb * 64, nb * 64, (bf16_t*)(ws + W_BOUT), 2048, 0, 1, 0, scr, lane); }
    }
}

constexpr int BG_TILES = 65 * 128 + 65 * 64, BG_CHUNKS = BG_TILES / 8;
__device__ __forceinline__ void bg_tile(const Params& p, int l, int t, LAS float* scr, int lane) {
    unsigned char* ws = p.ws;
    if (t < 65 * 128) { const int e = t >> 7, q = t & 127, kb = q >> 3, nb = q & 7, le = l * 65 + e;
        const float* src = e < 64 ? p.in[25] + (size_t)(l * 64 + e) * 1024 * 512 : p.in[27] + (size_t)l * 1024 * 512;
        tr_item(src, 512, kb * 64, nb * 64, (bf16_t*)(ws + W_GU) + (size_t)le * 512 * 1024, 1024, 1, 1, 0, scr, lane);
    } else { const int r = t - 65 * 128, e = r >> 6, q = r & 63, kb = q >> 4, nb = q & 15, le = l * 65 + e;
        const float* src = e < 64 ? p.in[26] + (size_t)(l * 64 + e) * 256 * 1024 : p.in[28] + (size_t)l * 256 * 1024;
        tr_item(src, 1024, kb * 64, nb * 64, (bf16_t*)(ws + W_DN) + (size_t)le * 1024 * 256, 256, 0, 1, 0, scr, lane); }
}
__device__ __forceinline__ void bg_convert(const Params& p, LAS unsigned char* lds, int l, int maxchunks) {
    const int tid = opq_tid(), lane = tid & 63, wid = tid >> 6;
    unsigned* q = (unsigned*)(p.ws + 32768) + l * 64;
    LAS int* slot = (LAS int*)(lds + LDS_BYTES - 64);
    LAS float* scr = (LAS float*)(lds + wid * 16640);
    for (int n = 0; n < maxchunks; ++n) {
        if (tid == 0) *slot = (int)atomicAdd(q, 1u);
        __syncthreads();
        const int c = *slot;
        __syncthreads();
        if (c >= BG_CHUNKS) break;
        bg_tile(p, l, c * 8 + wid, scr, lane);
    }
    __syncthreads();
}
__device__ __forceinline__ bool bg_idle(int nunits, int G, int c) { return (nunits - c + G - 1) / G < (nunits + G - 1) / G; }

template <int MODE, bool WRITE_LO, bool FINAL>
__device__ __forceinline__ void row_phase(const Params& p, int bid, int nblk, const float* gnorm, const float* modl  , int off_sh, int off_sc,
                                           const float* modprev  , const bf16_t* dx  ) {
    const int tid = opq_tid(), lane = tid & 63, wid = tid >> 6;
    unsigned char* ws = p.ws;
    float* xout = p.out;
    bf16_t* xres = (bf16_t*)(ws + B_XR);
    bf16_t* hx = (bf16_t*)(ws + OFF_HX);
    bf16_t* hlo = (bf16_t*)(ws + B_HLO);
    const float* pos = (const float*)(ws + OFF_POS);
    const int* slotof = (const int*)(ws + OFF_SLOTOF);
    const bf16_t* Y = (const bf16_t*)(ws + B_YY);
    const int nrows = MODE == 0 ? NROW : NTOK;
    for (int row = bid * 8 + wid; row < nrows; row += nblk * 8) {
        f32x4 v[4];
        int mv;
        if (MODE == 0) {
            if (row < NTOK) {
                mv = row >> 13; const int t = row & (SEQ - 1);
                const f32x4* xr = (const f32x4*)(p.in[0] + (size_t)row * D) + lane;
                const f32x4* pr = (const f32x4*)(pos + (size_t)(t >> 6) * 512) + lane;
                const f32x4* pc = (const f32x4*)(pos + (size_t)(t & 63) * 512) + lane;
                v[0] = xr[0] + pr[0]; v[1] = xr[64] + pr[64]; v[2] = xr[128] + pc[0]; v[3] = xr[192] + pc[64];
                u32x2* xo = (u32x2*)(xres + (size_t)row * D) + lane;
#pragma unroll
                for (int j = 0; j < 4; ++j) xo[64 * j] = (u32x2){pk2(v[j].x, v[j].y), pk2(v[j].z, v[j].w)};
            } else {
                mv = 4;
                const f32x4* xr = (const f32x4*)(p.in[2] + (size_t)(row - NTOK) * D) + lane;
#pragma unroll
                for (int j = 0; j < 4; ++j) v[j] = xr[64 * j];
            }
        } else {
            mv = row >> 13;
            u32x2* xo = (u32x2*)(xres + (size_t)row * D) + lane;
#pragma unroll
            for (int j = 0; j < 4; ++j) { const u32x2 w = xo[64 * j]; v[j] = (f32x4){bflo(w.x), bfhi(w.x), bflo(w.y), bfhi(w.y)}; }
            if (MODE == 1) {
                const u32x2* dr = (const u32x2*)(dx + (size_t)row * D) + lane;
#pragma unroll
                for (int j = 0; j < 4; ++j) { const u32x2 w = dr[64 * j]; v[j].x += bflo(w.x); v[j].y += bfhi(w.x); v[j].z += bflo(w.y); v[j].w += bfhi(w.y); xo[64 * j] = (u32x2){pk2(v[j].x, v[j].y), pk2(v[j].z, v[j].w)}; }
            }
            if (MODE == 2) {
                f32x4 s[4];
                {
                    const unsigned* yr = (const unsigned*)(ws + B_YS + (size_t)row * D) + lane;
#pragma unroll
                    for (int j = 0; j < 4; ++j) s[j] = up4_fp8(yr[64 * j]);
                }
#pragma unroll
                for (int k = 0; k < TOPK; ++k) {
                    const int slot = slotof[row * 8 + k];
                    const unsigned* yr = (const unsigned*)(ws + B_YY + (size_t)slot * D) + lane;
#pragma unroll
                    for (int j = 0; j < 4; ++j) s[j] = s[j] + up4_fp8(yr[64 * j]);
                }
                const f32x4* g2 = (const f32x4*)(modprev + (size_t)mv * 6144 + 5120) + lane;
#pragma unroll
                for (int j = 0; j < 4; ++j) { v[j] = v[j] + g2[64 * j] * s[j]; if (!FINAL) xo[64 * j] = (u32x2){pk2(v[j].x, v[j].y), pk2(v[j].z, v[j].w)}; }
            }
        }
        float ss = 0.f;
#pragma unroll
        for (int j = 0; j < 4; ++j) ss += (v[j].x * v[j].x + v[j].y * v[j].y) + (v[j].z * v[j].z + v[j].w * v[j].w);
        ss = wave_sum(ss);
        const float rinv = 1.0f / sqrtf(ss * (1.0f / D) + 1e-6f);
        const f32x4* gn = (const f32x4*)gnorm + lane;
        if (FINAL) {
            f32x4* xo = (f32x4*)(xout + (size_t)row * D) + lane;
#pragma unroll
            for (int j = 0; j < 4; ++j) xo[64 * j] = v[j] * rinv * gn[64 * j];
        } else {
            const f32x4* sh = (const f32x4*)(modl + (size_t)mv * 6144 + off_sh) + lane;
            const f32x4* sc = (const f32x4*)(modl + (size_t)mv * 6144 + off_sc) + lane;
            u32x2* ho = (u32x2*)(hx + (size_t)row * D) + lane;
            u32x2* lo = (u32x2*)(hlo + (size_t)row * D) + lane;
#pragma unroll
            for (int j = 0; j < 4; ++j) {
                const f32x4 y = v[j] * rinv * gn[64 * j] * (sc[64 * j] + 1.0f) + sh[64 * j];
                u32x2 w; w.x = pk2(y.x, y.y); w.y = pk2(y.z, y.w);
                ho[64 * j] = w;
                if (WRITE_LO) { u32x2 q; q.x = pk2(y.x - bflo(w.x), y.y - bfhi(w.x)); q.y = pk2(y.z - bflo(w.y), y.w - bfhi(w.y)); lo[64 * j] = q; }
            }
        }
    }
}

__device__ __forceinline__ void phase_inproj0(const Params& p, LAS unsigned char* lds, int bid, int nblk) {
    unsigned char* ws = p.ws;
    const bf16_t* hx = (const bf16_t*)(ws + OFF_HX); const bf16_t* W = (const bf16_t*)(ws + W_AIN);
    bf16_t* gate0 = (bf16_t*)(ws + B_GATE0); bf16_t* upre = (bf16_t*)(ws + B_UPRE);
    const int tid = opq_tid(), srow = tid >> 2, skc = (tid & 3) * 8;
    constexpr int NU = 256 * 20 + 8 * 10;
    for (int u = bid; u < NU; u += nblk) {
        int mt, nt;
        if (u < 5120) { mt = u / 20; nt = u % 20; } else { const int q = u - 5120; mt = 256 + q / 10; nt = 10 + q % 10; }
        const bf16_t* arow = hx + (size_t)(mt * 128 + srow) * D + skc;
        const bf16_t* brow = W + (size_t)(nt * 128 + srow) * D + skc;
        gemm_tile(arow, brow, 32, KDef(), [=](int r, int c, f32x4 v) {
            const int row = mt * 128 + r, col = nt * 128 + c;
            if (col < RW) { u32x2 w; w.x = pk2(gelu_t(v.x), gelu_t(v.y)); w.y = pk2(gelu_t(v.z), gelu_t(v.w)); *(u32x2*)(gate0 + (size_t)row * RW + col) = w; }
            else { u32x2 w; w.x = pk2(v.x, v.y); w.y = pk2(v.z, v.w); *(u32x2*)(upre + (size_t)row * RW + (col - RW)) = w; }
        }, lds);
    }
}

__device__ __forceinline__ void phase_conv(const Params& p, int bid, int nblk) {
    unsigned char* ws = p.ws;
    const bf16_t* upre = (const bf16_t*)(ws + B_UPRE); bf16_t* uu = (bf16_t*)(ws + B_UU);
    const float* cw = p.in[9]; const float* cb = p.in[10];
    const int gt = bid * NTHR + opq_tid(), ngt = nblk * NTHR;
    for (int item = gt; item < (NROW / 16) * 160; item += ngt) {
        const int rb = item / 160, cg8 = (item % 160) * 8, R0 = rb * 16;
        int t0, T;
        if (R0 < NTOK) { t0 = R0 & (SEQ - 1); T = SEQ; } else { t0 = (R0 - NTOK) & (CTXL - 1); T = CTXL; }
        f32x4 wa[4], wb[4];
#pragma unroll
        for (int k = 0; k < 4; ++k) { wa[k] = *(const f32x4*)(cw + k * RW + cg8); wb[k] = *(const f32x4*)(cw + k * RW + cg8 + 4); }
        const f32x4 ba = *(const f32x4*)(cb + cg8), bb = *(const f32x4*)(cb + cg8 + 4);
        u32x4 raw[19];
#pragma unroll
        for (int j = 0; j < 19; ++j) { const int tt = t0 + j - 2; raw[j] = (tt >= 0 && tt < T) ? *(const u32x4*)(upre + (size_t)(R0 + j - 2) * RW + cg8) : (u32x4){0u, 0u, 0u, 0u}; }
#pragma unroll
        for (int r = 0; r < 16; ++r) {
            f32x4 oa = ba, ob = bb;
#pragma unroll
            for (int k = 0; k < 4; ++k) { const u32x4 w = raw[r + k];
                oa = oa + wa[k] * (f32x4){bflo(w.x), bfhi(w.x), bflo(w.y), bfhi(w.y)}; ob = ob + wb[k] * (f32x4){bflo(w.z), bfhi(w.z), bflo(w.w), bfhi(w.w)}; }
            *(u32x4*)(uu + (size_t)(R0 + r) * RW + cg8) = pack8(oa, ob);
        }
    }
}

__device__ __forceinline__ void phase_outproj(const Params& p, LAS unsigned char* lds, int bid, int nblk, const bf16_t* Z, int K, const bf16_t* W, const float* modl) {
    float* xres = p.out;
    const int tid = opq_tid(), srow = tid >> 2, skc = (tid & 3) * 8;
    for (int u = bid; u < 256 * 8; u += nblk) {
        const int mt = u >> 3, nt = u & 7;
        const bf16_t* arow = Z + (size_t)(mt * 128 + srow) * K + skc;
        const bf16_t* brow = W + (size_t)(nt * 128 + srow) * K + skc;
        gemm_tile(arow, brow, K / 32, KDef(), [=](int r, int c, f32x4 v) {
            const int row = mt * 128 + r, col = nt * 128 + c;
            const f32x4 g1 = *(const f32x4*)(modl + (size_t)(row >> 13) * 6144 + 2048 + col);
            f32x4* xo = (f32x4*)(xres + (size_t)row * D + col);
            *xo = *xo + g1 * v;
        }, lds);
    }
}

__device__ __forceinline__ float rdlane(float v, int l) { return __builtin_bit_cast(float, __builtin_amdgcn_readlane(__builtin_bit_cast(int, v), l)); }
__device__ __forceinline__ float xmax(float v, int m) { return fmaxf(v, __shfl_xor(v, m)); }
__device__ __forceinline__ void phase_router(const Params& p, LAS unsigned char* lds, int bid, int nblk, int l) {
    unsigned char* ws = p.ws;
    const bf16_t* hx = (const bf16_t*)(ws + OFF_HX); const bf16_t* W = (const bf16_t*)(ws + W_RT) + (size_t)l * 128 * 3072;
    int* eidx = (int*)(ws + OFF_EIDX); float* gatew = (float*)(ws + OFF_GATEW); int* cnt = (int*)(ws + OFF_CNT); int* cntw = (int*)(ws + OFF_CNTW2);
    const int tid = opq_tid(), lane = tid & 63, wid = tid >> 6, fr = lane & 15, fq = lane >> 4;
    const float rbl = p.in[24][l * 64 + lane];
    LAS float* part = (LAS float*)lds;
    LAS float* L = (LAS float*)(lds + 69632);
    LAS int* cw = (LAS int*)(lds + 69632 + 8320);
    bf16x8 Bh[4][4], Bl[4][4];
#pragma unroll
    for (int s = 0; s < 4; ++s)
#pragma unroll
        for (int nb = 0; nb < 4; ++nb) { const bf16_t* wp = W + (size_t)(16 * nb + fr) * 3072 + 128 * wid + 32 * s + 8 * fq; Bh[s][nb] = *(const bf16x8*)wp; Bl[s][nb] = *(const bf16x8*)(wp + 2048); }
    bf16x8 Ah[2][4], Al[2][4];
#define RT_LOADA(ROW0) do { _Pragma("unroll") for (int g = 0; g < 2; ++g) _Pragma("unroll") for (int s = 0; s < 4; ++s) { \
        const bf16_t* ap = hx + (size_t)((ROW0) + 16 * g + fr) * D + 128 * wid + 32 * s + 8 * fq; Ah[g][s] = *(const bf16x8*)ap; Al[g][s] = *(const bf16x8*)(ap + LO_DELTA); } } while (0)
    if (bid < 256) RT_LOADA(bid * 128);
    for (int tile = bid; tile < 256; tile += nblk) {
        int cnt_e = 0;
        for (int it = 0; it < 4; ++it) {
            const int row0 = tile * 128 + it * 32;
            f32x4 acc[2][4];
#pragma unroll
            for (int g = 0; g < 2; ++g)
#pragma unroll
                for (int nb = 0; nb < 4; ++nb) acc[g][nb] = (f32x4){0.f, 0.f, 0.f, 0.f};
#pragma unroll
            for (int g = 0; g < 2; ++g)
#pragma unroll
                for (int s = 0; s < 4; ++s)
#pragma unroll
                    for (int nb = 0; nb < 4; ++nb) {
                        acc[g][nb] = __builtin_amdgcn_mfma_f32_16x16x32_bf16(Bh[s][nb], Ah[g][s], acc[g][nb], 0, 0, 0);
                        acc[g][nb] = __builtin_amdgcn_mfma_f32_16x16x32_bf16(Bh[s][nb], Al[g][s], acc[g][nb], 0, 0, 0);
                        acc[g][nb] = __builtin_amdgcn_mfma_f32_16x16x32_bf16(Bl[s][nb], Ah[g][s], acc[g][nb], 0, 0, 0);
                    }
            {
                const int nrow0 = it < 3 ? row0 + 32 : (tile + nblk) * 128;
                if (nrow0 < NTOK) RT_LOADA(nrow0);
            }
#pragma unroll
            for (int g = 0; g < 2; ++g)
#pragma unroll
                for (int nb = 0; nb < 4; ++nb) *(LAS f32x4*)(part + ((wid * 32 + 16 * g + fr) * 68 + 16 * nb + 4 * fq)) = acc[g][nb];
            __syncthreads();
            {
                const int r = tid >> 4, e0 = (tid & 15) * 4;
                f32x4 s = (f32x4){0.f, 0.f, 0.f, 0.f};
#pragma unroll
                for (int w = 0; w < 8; ++w) s = s + *(LAS f32x4*)(part + ((w * 32 + r) * 68 + e0));
                LAS float* o = L + r * 65 + e0; o[0] = s.x; o[1] = s.y; o[2] = s.z; o[3] = s.w;
            }
            __syncthreads();
#pragma unroll 1
            for (int j = 0; j < 4; ++j) {
                const int r = 4 * wid + j, tok = row0 + r;
                const float sc = sigm(L[r * 65 + lane]), sel = sc + rbl;
                const float m1 = xmax(xmax(xmax(sel, 1), 2), 4);
                int cand = sel == m1 ? lane : 64; cand = min(cand, __shfl_xor(cand, 1)); cand = min(cand, __shfl_xor(cand, 2)); cand = min(cand, __shfl_xor(cand, 4));
                const float s2 = lane == cand ? -__builtin_inff() : sel;
                const float gs = m1 + xmax(xmax(xmax(s2, 1), 2), 4);
                const int g = lane >> 3; int rank = 0;
#pragma unroll
                for (int gp = 0; gp < 8; ++gp) { const float o = rdlane(gs, gp * 8); rank += (o > gs || (o == gs && gp < g)) ? 1 : 0; }
                const bool keep = rank < 4;
                const unsigned bits = __builtin_bit_cast(unsigned, sel), srt = (bits & 0x80000000u) ? ~bits : (bits | 0x80000000u);
                const unsigned key = keep ? ((srt & ~63u) | (unsigned)(63 - lane)) : 0u;
                LAS unsigned* kb = (LAS unsigned*)(lds + 80000) + wid * 64;
                kb[lane] = key;
                int er = 0;
#pragma unroll
                for (int q4 = 0; q4 < 16; ++q4) { const u32x4 k4 = *(LAS u32x4*)(kb + 4 * q4); er += (k4.x > key ? 1 : 0) + (k4.y > key ? 1 : 0) + (k4.z > key ? 1 : 0) + (k4.w > key ? 1 : 0); }
                const bool chosen = keep && er < 8;
                const float ssum = wave_sum(chosen ? sc : 0.0f);
                if (chosen) { eidx[tok * 8 + er] = lane | (cnt_e << 8); gatew[tok * 8 + er] = sc * (2.5f / ssum); }
                cnt_e += chosen ? 1 : 0;
            }
        }
        cntw[(tile * 8 + wid) * 64 + lane] = cnt_e;
        cw[wid * 64 + lane] = cnt_e;
        __syncthreads();
        if (tid < 64) { int c = 0;
#pragma unroll
            for (int w = 0; w < 8; ++w) c += cw[w * 64 + tid];
            cnt[tile * 64 + tid] = c; }
        __syncthreads();
    }
}

__device__ __forceinline__ void phase_normroute(const Params& p, LAS unsigned char* lds, int bid, int nblk, int l, const float* gnorm, const float* modl, const bf16_t* dx) {
    unsigned char* ws = p.ws;
    bf16_t* xres = (bf16_t*)(ws + B_XR); bf16_t* hx = (bf16_t*)(ws + OFF_HX);
    const bf16_t* W = (const bf16_t*)(ws + W_RT) + (size_t)l * 128 * 3072;
    int* eidx = (int*)(ws + OFF_EIDX); float* gatew = (float*)(ws + OFF_GATEW); int* cnt = (int*)(ws + OFF_CNT); int* cntw = (int*)(ws + OFF_CNTW2);
    const int tid = opq_tid(), lane = tid & 63, wid = tid >> 6, fr = lane & 15, fq = lane >> 4;
    const float rbl = p.in[24][l * 64 + lane];
    LAS unsigned char* ahi = lds;
    LAS unsigned char* alo = lds + 33024;
    LAS float* part = (LAS float*)(lds + 66048);
    LAS float* L = (LAS float*)(lds + 66048 + 34816);
    LAS unsigned* kbase = (LAS unsigned*)(lds + 66048 + 34816 + 4224);
    LAS int* cw = (LAS int*)(lds + 66048 + 34816 + 4224 + 2048);
    bf16x8 Bh[4][4], Bl[4][4];
#pragma unroll
    for (int s = 0; s < 4; ++s)
#pragma unroll
        for (int nb = 0; nb < 4; ++nb) { const bf16_t* wp = W + (size_t)(16 * nb + fr) * 3072 + 128 * wid + 32 * s + 8 * fq; Bh[s][nb] = *(const bf16x8*)wp; Bl[s][nb] = *(const bf16x8*)(wp + 2048); }
    const f32x4* gn = (const f32x4*)gnorm + lane;
    u32x2 xa[2][4], da[2][4];
#define NR_LOAD(ROW0) do { _Pragma("unroll") for (int q = 0; q < 2; ++q) { const size_t r_ = (size_t)(ROW0) + 2 * wid + q; _Pragma("unroll") for (int j = 0; j < 4; ++j) { \
        xa[q][j] = ((const u32x2*)(xres + r_ * D) + lane)[64 * j]; da[q][j] = ((const u32x2*)(dx + r_ * D) + lane)[64 * j]; } } } while (0)
    if (bid < 256) NR_LOAD(bid * 128);
    for (int tile = bid; tile < 256; tile += nblk) {
        int cnt_e = 0;
        const int mv = tile >> 6;
        f32x4 ca[4];
#pragma unroll
        for (int j = 0; j < 4; ++j) ca[j] = gn[64 * j] * (((const f32x4*)(modl + (size_t)mv * 6144 + 4096) + lane)[64 * j] + 1.0f);
        const f32x4* sh = (const f32x4*)(modl + (size_t)mv * 6144 + 3072) + lane;
        for (int grp = 0; grp < 8; ++grp) {
            const int row0 = tile * 128 + grp * 16;
#pragma unroll
            for (int q = 0; q < 2; ++q) {
                const int rl = 2 * wid + q; const size_t row = (size_t)row0 + rl;
                f32x4 v[4]; float ss = 0.f;
#pragma unroll
                for (int j = 0; j < 4; ++j) { const u32x2 a = xa[q][j], b = da[q][j];
                    v[j] = (f32x4){bflo(a.x) + bflo(b.x), bfhi(a.x) + bfhi(b.x), bflo(a.y) + bflo(b.y), bfhi(a.y) + bfhi(b.y)};
                    ((u32x2*)(xres + row * D) + lane)[64 * j] = (u32x2){pk2(v[j].x, v[j].y), pk2(v[j].z, v[j].w)};
                    ss += (v[j].x * v[j].x + v[j].y * v[j].y) + (v[j].z * v[j].z + v[j].w * v[j].w); }
                ss = wave_sum(ss);
                const float rinv = 1.0f / sqrtf(ss * (1.0f / D) + 1e-6f);
#pragma unroll
                for (int j = 0; j < 4; ++j) {
                    const f32x4 y = v[j] * rinv * ca[j] + sh[64 * j];
                    u32x2 w; w.x = pk2(y.x, y.y); w.y = pk2(y.z, y.w);
                    ((u32x2*)(hx + row * D) + lane)[64 * j] = w;
                    u32x2 ql; ql.x = pk2(y.x - bflo(w.x), y.y - bfhi(w.x)); ql.y = pk2(y.z - bflo(w.y), y.w - bfhi(w.y));
                    *(LAS u32x2*)(ahi + rl * 2064 + (lane + 64 * j) * 8) = w; *(LAS u32x2*)(alo + rl * 2064 + (lane + 64 * j) * 8) = ql;
                }
            }
            __syncthreads();
            {
                const int nrow0 = grp < 7 ? row0 + 16 : (tile + nblk) * 128;
                if (nrow0 < NTOK) NR_LOAD(nrow0);
            }
            f32x4 acc[4];
#pragma unroll
            for (int nb = 0; nb < 4; ++nb) acc[nb] = (f32x4){0.f, 0.f, 0.f, 0.f};
#pragma unroll
            for (int s = 0; s < 4; ++s) {
                const int ko = fr * 2064 + (128 * wid + 32 * s + 8 * fq) * 2;
                const bf16x8 Ah = *(LAS bf16x8*)(ahi + ko), Al = *(LAS bf16x8*)(alo + ko);
#pragma unroll
                for (int nb = 0; nb < 4; ++nb) {
                    acc[nb] = __builtin_amdgcn_mfma_f32_16x16x32_bf16(Bh[s][nb], Ah, acc[nb], 0, 0, 0);
                    acc[nb] = __builtin_amdgcn_mfma_f32_16x16x32_bf16(Bh[s][nb], Al, acc[nb], 0, 0, 0);
                    acc[nb] = __builtin_amdgcn_mfma_f32_16x16x32_bf16(Bl[s][nb], Ah, acc[nb], 0, 0, 0);
                }
            }
#pragma unroll
            for (int nb = 0; nb < 4; ++nb) *(LAS f32x4*)(part + ((wid * 16 + fr) * 68 + 16 * nb + 4 * fq)) = acc[nb];
            __syncthreads();
            if (tid < 256) {
                const int r = tid >> 4, e0 = (tid & 15) * 4;
                f32x4 s = (f32x4){0.f, 0.f, 0.f, 0.f};
#pragma unroll
                for (int w = 0; w < 8; ++w) s = s + *(LAS f32x4*)(part + ((w * 16 + r) * 68 + e0));
                LAS float* o = L + r * 65 + e0; o[0] = s.x; o[1] = s.y; o[2] = s.z; o[3] = s.w;
            }
            __syncthreads();
#pragma unroll 1
            for (int j = 0; j < 2; ++j) {
                const int r = 2 * wid + j, tok = row0 + r;
                const float scv = sigm(L[r * 65 + lane]), sel = scv + rbl;
                const float m1 = max8(sel);
                const int cand = min8(sel == m1 ? lane : 64);
                const float s2 = lane == cand ? -__builtin_inff() : sel;
                const float gs = m1 + max8(s2);
                const int g = lane >> 3; int rank = 0;
#pragma unroll
                for (int gp = 0; gp < 8; ++gp) { const float o = rdlane(gs, gp * 8); rank += (o > gs || (o == gs && gp < g)) ? 1 : 0; }
                const bool keep = rank < 4;
                const unsigned bits = __builtin_bit_cast(unsigned, sel), srt = (bits & 0x80000000u) ? ~bits : (bits | 0x80000000u);
                const unsigned key = keep ? ((srt & ~63u) | (unsigned)(63 - lane)) : 0u;
                LAS unsigned* kb = kbase + wid * 64;
                kb[lane] = key;
                int er = 0;
#pragma unroll
                for (int q4 = 0; q4 < 16; ++q4) { const u32x4 k4 = *(LAS u32x4*)(kb + 4 * q4); er += (k4.x > key ? 1 : 0) + (k4.y > key ? 1 : 0) + (k4.z > key ? 1 : 0) + (k4.w > key ? 1 : 0); }
                const bool chosen = keep && er < 8;
                const float ssum = wave_sum(chosen ? scv : 0.0f);
                if (chosen) { eidx[tok * 8 + er] = lane | (cnt_e << 8); gatew[tok * 8 + er] = scv * (2.5f / ssum); }
                cnt_e += chosen ? 1 : 0;
            }
        }
        cntw[(tile * 8 + wid) * 64 + lane] = cnt_e;
        cw[wid * 64 + lane] = cnt_e;
        __syncthreads();
        if (tid < 64) { int c = 0;
#pragma unroll
            for (int w = 0; w < 8; ++w) c += cw[w * 64 + tid];
            cnt[tile * 64 + tid] = c; }
        __syncthreads();
    }
#undef NR_LOAD
}

__device__ __forceinline__ void phase_scatter(const Params& p, LAS unsigned char* lds, int bid, int nblk, int l) {
    unsigned char* ws = p.ws;
    const int* eidx = (const int*)(ws + OFF_EIDX); const float* gatew = (const float*)(ws + OFF_GATEW); const int* cnt = (const int*)(ws + OFF_CNT); const int* cntw = (const int*)(ws + OFF_CNTW2);
    int* slotof = (int*)(ws + OFF_SLOTOF); int* tokof = (int*)(ws + OFF_TOKOF); float* wof = (float*)(ws + OFF_WOF); int* meta = (int*)(ws + OFF_META);
    const int tid = opq_tid();
    LAS int* ps = (LAS int*)lds;
    LAS int* tot = (LAS int*)(lds + 2048);
    LAS int* sst = (LAS int*)(lds + 2048 + 256);
    LAS int* base = (LAS int*)(lds + 4096);
    LAS int* cl = (LAS int*)(lds + 8192);
    for (int i = tid; i < 256 * 64; i += NTHR) cl[i] = cnt[i];
    __syncthreads();
    {
        const int e = tid & 63, part = tid >> 6; int s = 0;
#pragma unroll 8
        for (int r = part * 32; r < part * 32 + 32; ++r) s += cl[r * 64 + e];
        ps[part * 64 + e] = s;
    }
    __syncthreads();
    if (tid < 64) { int s = 0; for (int q = 0; q < 8; ++q) s += ps[q * 64 + tid]; tot[tid] = s; }
    __syncthreads();
    if (tid == 0) { int a = 0; for (int e = 0; e < 64; ++e) { sst[e] = a; a += (tot[e] + TM - 1) / TM * TM; } sst[64] = a; sst[65] = a + NTOK; }
    __syncthreads();
    for (int tile = bid; tile < 256; tile += nblk) {
        {
            const int e = tid & 63, part = tid >> 6; int s = 0;
#pragma unroll 8
            for (int r = part * 32; r < part * 32 + 32; ++r) s += r < tile ? cl[r * 64 + e] : 0;
            ps[part * 64 + e] = s;
        }
        __syncthreads();
        {
            const int e = tid & 63, w = tid >> 6; int b = sst[e];
#pragma unroll
            for (int q = 0; q < 8; ++q) b += ps[q * 64 + e];
#pragma unroll
            for (int q = 0; q < 8; ++q) b += q < w ? cntw[(tile * 8 + q) * 64 + e] : 0;
            base[w * 64 + e] = b;
        }
        __syncthreads();
#pragma unroll
        for (int i = 0; i < 2; ++i) {
            const int a = tid + NTHR * i, r = a >> 3, tok = tile * 128 + r, w = (r & 15) >> 1;
            const int code = eidx[tile * 1024 + a], e = code & 63, lr = code >> 8;
            const int slot = base[w * 64 + e] + lr;
            tokof[slot] = tok; wof[slot] = gatew[tile * 1024 + a]; slotof[tile * 1024 + a] = slot;
        }
        if (tile == 0) {
            if (tid < 64) for (int s = sst[tid] + tot[tid]; s < sst[tid + 1]; ++s) { tokof[s] = 0; wof[s] = 0.0f; }
            if (tid < 66) meta[tid] = sst[tid];
        }
        __syncthreads();
    }
    bg_convert(p, lds, l, 1 << 30);
}

__device__ __forceinline__ void phase_inproj1(const Params& p, LAS unsigned char* lds, int bid, int nblk) {
    unsigned char* ws = p.ws;
    const bf16_t* hx = (const bf16_t*)(ws + OFF_HX); const bf16_t* W = (const bf16_t*)(ws + W_BIN); bf16_t* uv = (bf16_t*)(ws + B_UV);
    const int tid = opq_tid(), srow = tid >> 2, skc = (tid & 3) * 8;
    for (int u = bid; u < 256 * 32; u += nblk) {
        const int mt = u >> 5, nt = u & 31;
        const bf16_t* arow = hx + (size_t)(mt * 128 + srow) * D + skc;
        const bf16_t* brow = W + (size_t)(nt * 128 + srow) * D + skc;
        gemm_tile(arow, brow, 32, KDef(), [=](int r, int c, f32x4 v) {
            u32x2 w; w.x = pk2(gelu_t(v.x), gelu_t(v.y)); w.y = pk2(gelu_t(v.z), gelu_t(v.w));
            *(u32x2*)(uv + (size_t)(mt * 128 + r) * 4096 + nt * 128 + c) = w;
        }, lds);
    }
}

__device__ __forceinline__ void phase_sgu(const Params& p, LAS unsigned char* lds, int bid, int nblk) {
    unsigned char* ws = p.ws;
    const bf16_t* Wsb = (const bf16_t*)(ws + W_S); const bf16_t* uv = (const bf16_t*)(ws + B_UV); const float* statp = (const float*)(ws + OFF_STATP);
    bf16_t* z1 = (bf16_t*)(ws + B_Z1); const float* bs = p.in[21]; const float* lng = p.in[18]; const float* lnb = p.in[19];
    const int tid = opq_tid(), lane = tid & 63, wid = tid >> 6, wr = wid >> 2, wc = wid & 3, fr = lane & 15, fq = lane >> 4;
    LAS unsigned char* sa = lds;
    LAS unsigned char* sb = lds + 34816;
    LAS float* st = (LAS float*)(lds + 69632);
    u32x4 ra[4], rb[4], ru[4]; f32x4 rg[2], rbb[2]; float rm = 0.f, rr = 0.f;
#define SG_LOAD(U) do { const int chunk_ = (U) >> 4, g_ = ((U) >> 1) & 7, nt_ = (U) & 1; _Pragma("unroll") for (int k = 0; k < 4; ++k) { const int idx = k * NTHR + tid, r = idx >> 4, c8 = (idx & 15) * 8; \
        ra[k] = *(const u32x4*)(Wsb + (size_t)(g_ * 128 + r) * 128 + c8); rb[k] = *(const u32x4*)(uv + (size_t)(chunk_ * 128 + r) * 4096 + 2048 + g_ * 256 + nt_ * 128 + c8); \
        ru[k] = *(const u32x4*)(uv + (size_t)(chunk_ * 128 + r) * 4096 + g_ * 256 + nt_ * 128 + c8); } \
        { const int ch_ = g_ * 256 + nt_ * 128 + (tid & 15) * 8; rg[0] = *(const f32x4*)(lng + ch_); rg[1] = *(const f32x4*)(lng + ch_ + 4); rbb[0] = *(const f32x4*)(lnb + ch_); rbb[1] = *(const f32x4*)(lnb + ch_ + 4); } \
        if (tid < 128) { const f32x4* sp = (const f32x4*)(statp + (size_t)(chunk_ * 128 + tid) * 64); float S_ = 0.f, Q_ = 0.f; \
            _Pragma("unroll") for (int k = 0; k < 16; ++k) { const f32x4 t_ = sp[k]; S_ += t_.x + t_.z; Q_ += t_.y + t_.w; } \
            rm = S_ * (1.0f / SW); rr = 1.0f / sqrtf(fmaxf(Q_ * (1.0f / SW) - rm * rm, 0.0f) + 1e-6f); } } while (0)
    if (bid < 4096) SG_LOAD(bid);
    for (int u = bid; u < 256 * 16; u += nblk) {
        const int chunk = u >> 4, g = (u >> 1) & 7, nt = u & 1, R0 = chunk * 128;
        if (tid < 128) { st[tid * 2] = rm; st[tid * 2 + 1] = rr; }
        __syncthreads();
#pragma unroll
        for (int k = 0; k < 4; ++k) {
            const int idx = k * NTHR + tid, r = idx >> 4, c16 = (idx & 15) * 16;
            *(LAS u32x4*)(sa + r * 272 + c16) = ra[k];
            const float mean = st[r * 2], rstd = st[r * 2 + 1]; const u32x4 w = rb[k];
            const f32x4 x0 = ((f32x4){bflo(w.x), bfhi(w.x), bflo(w.y), bfhi(w.y)} - mean) * rstd * rg[0] + rbb[0];
            const f32x4 x1 = ((f32x4){bflo(w.z), bfhi(w.z), bflo(w.w), bfhi(w.w)} - mean) * rstd * rg[1] + rbb[1];
            *(LAS u32x4*)(sb + r * 272 + c16) = pack8(x0, x1);
        }
        u32x4 uc[4];
#pragma unroll
        for (int k = 0; k < 4; ++k) uc[k] = ru[k];
        float bsv[4];
#pragma unroll
        for (int m = 0; m < 4; ++m) bsv[m] = bs[g * 128 + wr * 64 + m * 16 + fr];
        __syncthreads();
        if (u + nblk < 4096) SG_LOAD(u + nblk);
        f32x4 acc[4][2];
#pragma unroll
        for (int m = 0; m < 4; ++m)
#pragma unroll
            for (int n = 0; n < 2; ++n) acc[m][n] = (f32x4){0.f, 0.f, 0.f, 0.f};
#pragma unroll
        for (int ks = 0; ks < 4; ++ks) {
            bf16x8 af[4], bfv[2];
#pragma unroll
            for (int m = 0; m < 4; ++m) af[m] = *(LAS bf16x8*)(sa + (wr * 64 + m * 16 + fr) * 272 + ks * 64 + fq * 16);
#pragma unroll
            for (int n = 0; n < 2; ++n) {
                const LAS unsigned short* bp = (const LAS unsigned short*)(sb + (ks * 32 + fq * 8) * 272 + (wc * 32 + n * 16 + fr) * 2);
#pragma unroll
                for (int j = 0; j < 8; ++j) bfv[n][j] = (short)bp[j * 136];
            }
#pragma unroll
            for (int m = 0; m < 4; ++m)
#pragma unroll
                for (int n = 0; n < 2; ++n) acc[m][n] = __builtin_amdgcn_mfma_f32_16x16x32_bf16(bfv[n], af[m], acc[m][n], 0, 0, 0);
        }
        __syncthreads();
#pragma unroll
        for (int m = 0; m < 4; ++m) { const int r = wr * 64 + m * 16 + fr; const float b = bsv[m];
#pragma unroll
            for (int n = 0; n < 2; ++n) { const f32x4 v = acc[m][n]; u32x2 o; o.x = pk2(v.x + b, v.y + b); o.y = pk2(v.z + b, v.w + b); *(LAS u32x2*)(sa + r * 272 + (wc * 32 + n * 16 + fq * 4) * 2) = o; } }
        __syncthreads();
#pragma unroll
        for (int k = 0; k < 4; ++k) {
            const int idx = k * NTHR + tid, r = idx >> 4, c8 = (idx & 15) * 8;
            const u32x4 ov = *(LAS u32x4*)(sa + r * 272 + c8 * 2), uw = uc[k];
            u32x4 z; z.x = pk2(bflo(uw.x) * bflo(ov.x), bfhi(uw.x) * bfhi(ov.x)); z.y = pk2(bflo(uw.y) * bflo(ov.y), bfhi(uw.y) * bfhi(ov.y));
            z.z = pk2(bflo(uw.z) * bflo(ov.z), bfhi(uw.z) * bfhi(ov.z)); z.w = pk2(bflo(uw.w) * bflo(ov.w), bfhi(uw.w) * bfhi(ov.w));
            *(u32x4*)(z1 + (size_t)(R0 + r) * SW + g * 256 + nt * 128 + c8) = z;
        }
        __syncthreads();
    }
#undef SG_LOAD
}

template <class F> struct EpiP8 {
    static constexpr int PERM = 1; F f;
    __device__ __forceinline__ void operator()(const f32x4 (&acc)[2][2][4][2], const pg::Unit& u, int wr, int wc, int fr, int fq) const {
#pragma unroll
        for (int ai = 0; ai < 2; ++ai)
#pragma unroll
            for (int m = 0; m < 4; ++m)
#pragma unroll
                for (int bj = 0; bj < 2; ++bj) f(u, ai * 128 + wr * 64 + m * 16 + fr, bj * 128 + wc * 32 + 8 * fq, acc[ai][bj][m][0], acc[ai][bj][m][1]);
    }
};
template <class F> struct EpiP4 {
    static constexpr int PERM = 0; F f;
    __device__ __forceinline__ void operator()(const f32x4 (&acc)[2][2][4][2], const pg::Unit& u, int wr, int wc, int fr, int fq) const {
#pragma unroll
        for (int ai = 0; ai < 2; ++ai)
#pragma unroll
            for (int m = 0; m < 4; ++m)
#pragma unroll
                for (int bj = 0; bj < 2; ++bj)
#pragma unroll
                    for (int n = 0; n < 2; ++n) f(u, ai * 128 + wr * 64 + m * 16 + fr, bj * 128 + wc * 32 + 16 * n + 4 * fq, acc[ai][bj][m][n]);
    }
};
template <class F> __device__ __forceinline__ EpiP8<F> make_p8(F f) { return EpiP8<F>{f}; }
template <class F> __device__ __forceinline__ EpiP4<F> make_p4(F f) { return EpiP4<F>{f}; }
__device__ __forceinline__ f32x4 gelu4(f32x4 v) { return (f32x4){gelu_t(v.x), gelu_t(v.y), gelu_t(v.z), gelu_t(v.w)}; }

__device__ __forceinline__ void stg_sync() { asm volatile("s_waitcnt lgkmcnt(0)" ::: "memory"); __builtin_amdgcn_s_barrier(); asm volatile("" ::: "memory"); }
template <class RowPtr>
__device__ __forceinline__ void stg_step512(LAS unsigned char* stg, int wr, int wc, int fr, int fq, int o0, int o1, u32x4 p0, u32x4 p1, RowPtr rp) {
    LAS unsigned char* w = stg + (wr * 16 + fr) * 528;
    *(LAS u32x4*)(w + o0) = p0; *(LAS u32x4*)(w + o1) = p1;
    stg_sync();
    const int tid = (wr * 4 + wc) * 64 + fq * 16 + fr;
#pragma unroll
    for (int k = 0; k < 2; ++k) { const int idx = k * 512 + tid, rl = idx >> 5, c = idx & 31; const u32x4 v = *(LAS u32x4*)(stg + rl * 528 + c * 16); *(u32x4*)(rp(rl) + c * 16) = v; }
    stg_sync();
}
template <class RowPtr>
__device__ __forceinline__ void stg_step256(LAS unsigned char* stg, int wr, int wc, int fr, int fq, u32x4 p0, RowPtr rp) {
    *(LAS u32x4*)(stg + (wr * 16 + fr) * 272 + wc * 64 + fq * 16) = p0;
    stg_sync();
    const int tid = (wr * 4 + wc) * 64 + fq * 16 + fr, rl = tid >> 4, c = tid & 15;
    const u32x4 v = *(LAS u32x4*)(stg + rl * 272 + c * 16); *(u32x4*)(rp(rl) + c * 16) = v;
    stg_sync();
}
template <class Xf, class RowPtr> struct EpiStage {
    static constexpr int PERM = 1; LAS unsigned char* stg; Xf xf; RowPtr rowptr;
    __device__ __forceinline__ void operator()(const f32x4 (&acc)[2][2][4][2], const pg::Unit& u, int wr, int wc, int fr, int fq) const {
#pragma unroll
        for (int ai = 0; ai < 2; ++ai)
#pragma unroll
            for (int m = 0; m < 4; ++m) {
                const u32x4 p0 = xf(u, 0, wc, fq, acc[ai][0][m][0], acc[ai][0][m][1]), p1 = xf(u, 1, wc, fq, acc[ai][1][m][0], acc[ai][1][m][1]);
                stg_step512(stg, wr, wc, fr, fq, wc * 64 + fq * 16, 256 + wc * 64 + fq * 16, p0, p1,
                            [&](int rl) { return rowptr(u, ai * 128 + (rl >> 4) * 64 + m * 16 + (rl & 15)); });
            }
    }
};
template <class Xf, class RowPtr> __device__ __forceinline__ EpiStage<Xf, RowPtr> make_stage(LAS unsigned char* stg, Xf xf, RowPtr rp) { return EpiStage<Xf, RowPtr>{stg, xf, rp}; }
template <class Xf, class RowPtr> struct EpiDirect {
    static constexpr int PERM = 2; Xf xf; RowPtr rowptr;
    __device__ __forceinline__ void operator()(const f32x4 (&acc)[2][2][4][2], const pg::Unit& u, int wr, int wc, int fr, int fq) const {
#pragma unroll
        for (int ai = 0; ai < 2; ++ai)
#pragma unroll
            for (int m = 0; m < 4; ++m) {
                unsigned char* rp = rowptr(u, ai * 128 + wr * 64 + m * 16 + fr) + (64 * wc + 8 * fq) * 2;
                *(u32x4*)rp = xf(u, 0, wc, fq, acc[ai][0][m][0], acc[ai][0][m][1]);
                *(u32x4*)(rp + 64) = xf(u, 1, wc, fq, acc[ai][1][m][0], acc[ai][1][m][1]);
            }
    }
};
template <class Xf, class RowPtr> __device__ __forceinline__ EpiDirect<Xf, RowPtr> make_direct(Xf xf, RowPtr rp) { return EpiDirect<Xf, RowPtr>{xf, rp}; }

struct SchedIn0 {
    const char* A; const char* B; int G, c;
    __device__ __forceinline__ bool next(int i, pg::Unit& u) const {
        const int L = i * G + c; if (L >= 1300) return false;
        if (L < 1280) { const int wgid = pg::xcd_remap(L, 1280); u.pm = (wgid / 80) * 8 + (wgid % 80) % 8; u.pn = (wgid % 80) / 8; }
        else { const int q = L - 1280; u.pm = 128 + q / 5; u.pn = 5 + q % 5; }
        u.e = 0; u.rows = nullptr; u.a = A + (size_t)u.pm * 256 * D * 2; u.b = B + (size_t)u.pn * 256 * D * 2; return true;
    }
};
__device__ __forceinline__ void phase_inproj0_pg(const Params& p, LAS unsigned char* lds, int bid, int nblk) {
    unsigned char* ws = p.ws;
    unsigned char* gate0 = ws + B_GATE0; unsigned char* upre = ws + B_UPRE;
    SchedIn0 S{(const char*)(ws + OFF_HX), (const char*)(ws + W_AIN), nblk, bid};
    auto E = make_direct(
        [=](const pg::Unit& u, int bj, int wc, int fq, f32x4 v0, f32x4 v1) { return u.pn < 5 ? pack8(gelu4(v0), gelu4(v1)) : pack8(v0, v1); },
        [=](const pg::Unit& u, int r) { const size_t row = (size_t)u.pm * 256 + r; return u.pn < 5 ? gate0 + (row * RW + u.pn * 256) * 2 : upre + (row * RW + (u.pn - 5) * 256) * 2; });
    pg::gemm<false>(lds, D, D, D, S, E);
    if (bg_idle(1300, nblk, bid)) bg_convert(p, lds, 0, 4);
}
__device__ __forceinline__ void phase_outproj_pg(const Params& p, LAS unsigned char* lds, int bid, int nblk, const bf16_t* Z, int K, const bf16_t* W, const float* modl, unsigned char* dx) {
    pg::SchedPlain S{(const char*)Z, (const char*)W, K, K, 128, 4, 512, nblk, bid};
    auto E = make_direct(
        [=](const pg::Unit& u, int bj, int wc, int fq, f32x4 v0, f32x4 v1) {
            const float* g1 = modl + (size_t)(u.pm >> 5) * 6144 + 2048 + u.pn * 256 + wc * 64 + bj * 32 + 8 * fq;
            return pack8(v0 * *(const f32x4*)g1, v1 * *(const f32x4*)(g1 + 4)); },
        [=](const pg::Unit& u, int r) { return dx + (((size_t)u.pm * 256 + r) * D + u.pn * 256) * 2; });
    pg::gemm<false>(lds, K, K, K, S, E);
}
struct EpiIn1 {
    static constexpr int PERM = 2; unsigned char* uv; float* statp;
    __device__ __forceinline__ void operator()(const f32x4 (&acc)[2][2][4][2], const pg::Unit& u, int wr, int wc, int fr, int fq) const {
#pragma unroll
        for (int ai = 0; ai < 2; ++ai)
#pragma unroll
            for (int m = 0; m < 4; ++m) {
                const size_t row = (size_t)u.pm * 256 + ai * 128 + wr * 64 + m * 16 + fr;
                const u32x4 p0 = pack8(gelu4(acc[ai][0][m][0]), gelu4(acc[ai][0][m][1])), p1 = pack8(gelu4(acc[ai][1][m][0]), gelu4(acc[ai][1][m][1]));
                unsigned char* rp = uv + (row * 4096 + u.pn * 256 + 64 * wc + 8 * fq) * 2;
                *(u32x4*)rp = p0; *(u32x4*)(rp + 64) = p1;
                if (u.pn >= 8) {
                    float s = 0.f, q = 0.f;
#pragma unroll
                    for (int k = 0; k < 8; ++k) { const unsigned w = k < 4 ? p0[k] : p1[k - 4]; const float a = bflo(w), b = bfhi(w); s += a + b; q += a * a + b * b; }
                    s += __shfl_xor(s, 16); q += __shfl_xor(q, 16); s += __shfl_xor(s, 32); q += __shfl_xor(q, 32);
                    if (fq == 0) { float* sp = statp + (row * 32 + (u.pn - 8) * 4 + wc) * 2; sp[0] = s; sp[1] = q; }
                }
            }
    }
};
__device__ __forceinline__ void phase_inproj1_pg(const Params& p, LAS unsigned char* lds, int bid, int nblk) {
    unsigned char* ws = p.ws;
    pg::SchedPlain S{(const char*)(ws + OFF_HX), (const char*)(ws + W_BIN), D, D, 128, 16, 2048, nblk, bid};
    EpiIn1 E{ws + B_UV, (float*)(ws + OFF_STATP)};
    pg::gemm<false>(lds, D, D, D, S, E);
}

constexpr int MOE_T_SS = 131072, MOE_T_S0 = 131072 + 512, MOE_T_E = 131072 + 512 + 4864;
__device__ __forceinline__ int moe_meta(const Params& p, LAS unsigned char* lds) {
    LAS int* ss = (LAS int*)(lds + MOE_T_SS); LAS int* ts0 = (LAS int*)(lds + MOE_T_S0); LAS unsigned char* te = lds + MOE_T_E;
    const int* meta = (const int*)(p.ws + OFF_META);
    const int tid = opq_tid();
    if (tid < 66) ss[tid] = meta[tid];
    __syncthreads();
    const int ntile = ss[65] / TM;
    for (int t = tid; t < ntile; t += NTHR) {
        const int slot0 = t * TM; int e = 0;
        for (int q = 1; q < 65; ++q) e = (ss[q] <= slot0) ? q : e;
        ts0[t] = slot0; te[t] = (unsigned char)e;
    }
    __syncthreads();
    return ntile;
}
template <int NPN, bool GATHER>
struct SchedMoe {
    const char* A; const char* W; const int* tokof; const int* ident; LAS unsigned char* lds; int lda, wrows, wk, nunits, G, c;
    __device__ __forceinline__ bool next(int i, pg::Unit& u) const {
        const int L = i * G + c; if (L >= nunits) return false;
        const int wgid = pg::xcd_remap(L, nunits), tile = wgid / NPN;
        const int slot0 = __builtin_amdgcn_readfirstlane(((LAS int*)(lds + MOE_T_S0))[tile]);
        const int e = __builtin_amdgcn_readfirstlane((int)(lds + MOE_T_E)[tile]);
        const int ss64 = __builtin_amdgcn_readfirstlane(((LAS int*)(lds + MOE_T_SS))[64]);
        u.pm = slot0; u.pn = wgid % NPN; u.e = e;
        u.rows = e < 64 ? tokof + slot0 : ident + (slot0 - ss64);
        u.a = GATHER ? A : A + (size_t)slot0 * lda * 2;
        u.b = W + ((size_t)e * wrows + (size_t)u.pn * 256) * wk * 2;
        return true;
    }
};
__device__ __forceinline__ f32x4 silu4(f32x4 v) { return (f32x4){silu(v.x), silu(v.y), silu(v.z), silu(v.w)}; }
struct EpiUp {
    static constexpr int PERM = 1; unsigned char* hh; const float* wof; LAS unsigned char* stg;
    __device__ __forceinline__ void operator()(const f32x4 (&acc)[2][2][4][2], const pg::Unit& u, int wr, int wc, int fr, int fq) const {
        float w[8];
#pragma unroll
        for (int i = 0; i < 8; ++i) w[i] = u.e < 64 ? wof[u.pm + (i >> 2) * 128 + wr * 64 + (i & 3) * 16 + fr] : 1.0f;
#pragma unroll
        for (int ai = 0; ai < 2; ++ai)
#pragma unroll
            for (int m = 0; m < 4; ++m) {
                const float ww = w[ai * 4 + m];
                const u32x4 p0 = pack8(silu4(acc[ai][0][m][0]) * acc[ai][1][m][0] * ww, silu4(acc[ai][0][m][1]) * acc[ai][1][m][1] * ww);
                LAS unsigned char* sbuf = stg + ((ai * 4 + m) & 1) * 8704;
                *(LAS u32x4*)(sbuf + (wr * 16 + fr) * 272 + wc * 64 + fq * 16) = p0;
                stg_sync();
                { const int tid = (wr * 4 + wc) * 64 + fq * 16 + fr, rl = tid >> 4, c = tid & 15;
                  const u32x4 v = *(LAS u32x4*)(sbuf + rl * 272 + c * 16);
                  *(u32x4*)(hh + ((size_t)(u.pm + ai * 128 + (rl >> 4) * 64 + m * 16 + (rl & 15)) * EFF + u.pn * 128) * 2 + c * 16) = v; }
            }
    }
};
__device__ __forceinline__ void phase_moe_up(const Params& p, LAS unsigned char* lds, int bid, int nblk, int l) {
    unsigned char* ws = p.ws;
    const int ntile = moe_meta(p, lds);
    SchedMoe<2, true> S{(const char*)(ws + OFF_HX), (const char*)(ws + W_GU) + (size_t)l * 65 * 512 * 1024 * 2, (const int*)(ws + OFF_TOKOF), (const int*)(ws + OFF_IDENT), lds, D, 512, D, ntile * 2, nblk, bid};
    EpiUp E{ws + B_HH, (const float*)(ws + OFF_WOF), lds + STG_OFF};
    pg::gemm<true>(lds, D, D, D, S, E);
    if (l == 0 && bg_idle(ntile * 2, nblk, bid)) bg_convert(p, lds, 1, 3);
}
struct EpiDown {
    static constexpr int PERM = 1; LAS unsigned char* stg; unsigned char* Y; unsigned char* ys; int ss64;
    __device__ __forceinline__ void operator()(const f32x4 (&acc)[2][2][4][2], const pg::Unit& u, int wr, int wc, int fr, int fq) const {
        const int tid = (wr * 4 + wc) * 64 + fq * 16 + fr, rl = tid >> 4, c = tid & 15;
        unsigned char* base = u.e < 64 ? Y + ((size_t)u.pm * D + u.pn * 256) : ys + ((size_t)(u.pm - ss64) * D + u.pn * 256);
#pragma unroll
        for (int ai = 0; ai < 2; ++ai)
#pragma unroll
            for (int m = 0; m < 4; ++m) {
                LAS unsigned char* sbuf = stg + ((ai * 4 + m) & 1) * 8704;
                LAS unsigned char* w = sbuf + (wr * 16 + fr) * 272 + wc * 32 + fq * 8;
                *(LAS u32x2*)w = (u32x2){pk4_fp8(acc[ai][0][m][0]), pk4_fp8(acc[ai][0][m][1])};
                *(LAS u32x2*)(w + 128) = (u32x2){pk4_fp8(acc[ai][1][m][0]), pk4_fp8(acc[ai][1][m][1])};
                stg_sync();
                const u32x4 v = *(LAS u32x4*)(sbuf + rl * 272 + c * 16);
                *(u32x4*)(base + (size_t)(ai * 128 + (rl >> 4) * 64 + m * 16 + (rl & 15)) * D + c * 16) = v;
            }
    }
};
__device__ __forceinline__ void phase_moe_down(const Params& p, LAS unsigned char* lds, int bid, int nblk, int l) {
    unsigned char* ws = p.ws;
    const int ntile = moe_meta(p, lds);
    const int ss64 = ((LAS int*)(lds + MOE_T_SS))[64];
    SchedMoe<4, false> S{(const char*)(ws + B_HH), (const char*)(ws + W_DN) + (size_t)l * 65 * 1024 * 256 * 2, nullptr, nullptr, lds, EFF, 1024, EFF, ntile * 4, nblk, bid};
    EpiDown E{lds + STG_OFF, ws + B_YY, ws + B_YS, ss64};
    pg::gemm<false>(lds, EFF, EFF, EFF, S, E);
    if (l == 0 && bg_idle(ntile * 4, nblk, bid)) bg_convert(p, lds, 1, 1);
}

typedef _Float16 h16x2 __attribute__((ext_vector_type(2)));
__device__ __forceinline__ unsigned pkh2(float a, float b) { h16x2 v; v.x = (_Float16)a; v.y = (_Float16)b; return __builtin_bit_cast(unsigned, v); }
__device__ __forceinline__ float h2lo(unsigned w) { return (float)__builtin_bit_cast(h16x2, w).x; }
__device__ __forceinline__ float h2hi(unsigned w) { return (float)__builtin_bit_cast(h16x2, w).y; }
template <int CTRL> __device__ __forceinline__ float dppf(float oldv, float v) {
    return __builtin_bit_cast(float, __builtin_amdgcn_update_dpp(__builtin_bit_cast(int, oldv), __builtin_bit_cast(int, v), CTRL, 0xf, 0xf, false));
}
template <bool SHL> __device__ __forceinline__ void scan16(float& A, float& H) {
#define SC_STEP(N) { const float Ap = dppf<(SHL ? 0x100 : 0x110) + N>(1.0f, A); const float Hp = dppf<(SHL ? 0x100 : 0x110) + N>(0.0f, H); H = A * Hp + H; A = A * Ap; }
    SC_STEP(1) SC_STEP(2) SC_STEP(4) SC_STEP(8)
#undef SC_STEP
}
struct SchedGates {
    const char* U; const char* W; int G, c;
    __device__ __forceinline__ bool next(int i, pg::Unit& u) const {
        const int L = i * G + c; if (L >= 2640) return false;
        const int wgid = pg::xcd_remap(L, 2640), pm = wgid / 20, rem = wgid % 20, h = rem >> 2, q = rem & 3;
        u.pm = pm; u.pn = q; u.e = h; u.rows = nullptr;
        u.a = U + ((size_t)pm * 256 * RW + h * 256) * 2; u.b = W + ((size_t)h * 1024 + q * 256) * 256 * 2; return true;
    }
};
struct EpiGates {
    static constexpr int PERM = 0;
    const bf16_t* uu; const float* rbias; const float* ibias; const float* cdec; unsigned char* ab; LAS unsigned char* stg;
    __device__ __forceinline__ void operator()(const f32x4 (&acc)[2][2][4][2], const pg::Unit& u, int wr, int wc, int fr, int fq) const {
        const int ch0 = u.e * 256 + u.pn * 64 + 16 * wc + 4 * fq;
        const f32x4 rb0 = *(const f32x4*)(rbias + ch0), rb1 = *(const f32x4*)(rbias + RW + ch0), ib0 = *(const f32x4*)(ibias + ch0), ib1 = *(const f32x4*)(ibias + RW + ch0);
        const f32x4 cd0 = *(const f32x4*)(cdec + ch0), cd1 = *(const f32x4*)(cdec + RW + ch0);
        u32x2 uws[8];
#pragma unroll
        for (int i = 0; i < 8; ++i) uws[i] = *(const u32x2*)(uu + ((size_t)u.pm * 256 + (i >> 2) * 128 + wr * 64 + (i & 3) * 16 + fr) * RW + ch0);
#pragma unroll
        for (int ai = 0; ai < 2; ++ai)
#pragma unroll
            for (int m = 0; m < 4; ++m) {
                const int rl = ai * 128 + wr * 64 + m * 16 + fr; const size_t R = (size_t)u.pm * 256 + rl;
                const u32x2 uw = uws[ai * 4 + m];
                const float uv[4] = {bflo(uw.x), bfhi(uw.x), bflo(uw.y), bfhi(uw.y)};
                unsigned o[8];
#pragma unroll
                for (int gi = 0; gi < 4; ++gi) {
                    const f32x4 v = acc[ai][gi >> 1][m][gi & 1];
                    const float r0 = sigm(v.x + rb0[gi]), i0 = sigm(v.y + ib0[gi]), r1 = sigm(v.z + rb1[gi]), i1 = sigm(v.w + ib1[gi]);
                    const float la0 = r0 * cd0[gi], la1 = r1 * cd1[gi];
                    float a0 = __expf(la0), a1 = __expf(la1);
                    float m0 = __builtin_amdgcn_sqrtf(fmaxf(1.0f - a0 * a0, 0.0f)), m1 = __builtin_amdgcn_sqrtf(fmaxf(1.0f - a1 * a1, 0.0f));
                    if (u.pm >= 128) { if (rl == 0) m0 = 1.0f; if (rl == CTXL - 1) m1 = 1.0f; }
                    float h0 = m0 * i0 * uv[gi], h1 = m1 * i1 * uv[gi];
#define GS_STEP(N) asm volatile("s_nop 1\n\tv_fmac_f32_dpp %0, %0, %2 row_shr:" #N " row_mask:0xf bank_mask:0xf\n\tv_fmac_f32_dpp %1, %1, %3 row_shl:" #N " row_mask:0xf bank_mask:0xf\n\tv_mul_f32_dpp %2, %2, %2 row_shr:" #N " row_mask:0xf bank_mask:0xf\n\tv_mul_f32_dpp %3, %3, %3 row_shl:" #N " row_mask:0xf bank_mask:0xf" : "+v"(h0), "+v"(h1), "+v"(a0), "+v"(a1));
                    GS_STEP(1) GS_STEP(2) GS_STEP(4) GS_STEP(8)
#undef GS_STEP
                    o[gi * 2] = pkh2(a0, h0); o[gi * 2 + 1] = pkh2(a1, h1);
                }
                u32x4* dst = (u32x4*)(ab + (R * RW + ch0) * 8);
                dst[0] = (u32x4){o[0], o[1], o[2], o[3]}; dst[1] = (u32x4){o[4], o[5], o[6], o[7]};
            }
    }
};
__device__ __forceinline__ void phase_gates_pg(const Params& p, LAS unsigned char* lds, int bid, int nblk) {
    unsigned char* ws = p.ws;
    SchedGates S{(const char*)(ws + B_UU), (const char*)(ws + W_GATE), nblk, bid};
    EpiGates E{(const bf16_t*)(ws + B_UU), p.in[12], p.in[14], (const float*)(ws + OFF_CDEC), ws + B_AB, lds + STG_OFF};
    pg::gemm<false>(lds, 256, RW, 256, S, E);
    if (bg_idle(2640, nblk, bid)) bg_convert(p, lds, 0, 2);
}
__device__ __forceinline__ void phase_scan_sb(const Params& p, int bid, int nblk) {
    unsigned char* ws = p.ws;
    const unsigned* ab = (const unsigned*)(ws + B_AB); float* sbc = (float*)(ws + OFF_AGG);
    const int gt = bid * NTHR + opq_tid(), ngt = nblk * NTHR;
    for (int i = gt; i < 2 * 132 * RW; i += ngt) {
        const int d = i / (132 * RW), sb = (i / RW) % 132, ch = i % RW;
        float A = 1.0f, H = 0.0f;
#pragma unroll 16
        for (int j = 0; j < 16; ++j) {
            const int k = d == 0 ? j : 15 - j; const size_t row = (size_t)sb * 256 + 16 * k + (d == 0 ? 15 : 0);
            const unsigned w = ab[(row * RW + ch) * 2 + d];
            H = h2lo(w) * H + h2hi(w); A *= h2lo(w);
        }
        sbc[(size_t)i * 2] = A; sbc[(size_t)i * 2 + 1] = H;
    }
}
__device__ __forceinline__ void phase_scan_carry(const Params& p, int bid, int nblk) {
    unsigned char* ws = p.ws;
    const unsigned* ab = (const unsigned*)(ws + B_AB); const float* sbc = (const float*)(ws + OFF_AGG); float* car = (float*)(ws + B_CAR);
    const int gt = bid * NTHR + opq_tid(), ngt = nblk * NTHR;
    for (int i = gt; i < 2 * 128 * RW; i += ngt) {
        const int d = i / (128 * RW), sb = (i / RW) % 128, ch = i % RW, b = sb >> 5, sl = sb & 31;
        float c = sbc[((size_t)(d * 132 + 128 + b) * RW + ch) * 2 + 1];
        const int nprev = d == 0 ? sl : 31 - sl;
        {
            typedef float f32x2 __attribute__((ext_vector_type(2)));
            f32x2 qv[31];
#pragma unroll
            for (int j = 0; j < 31; ++j) { const int s2 = d == 0 ? b * 32 + j : b * 32 + 31 - j; qv[j] = j < nprev ? *(const f32x2*)(sbc + ((size_t)(d * 132 + s2) * RW + ch) * 2) : (f32x2){1.0f, 0.0f}; }
#pragma unroll
            for (int j = 0; j < 31; ++j) c = qv[j].x * c + qv[j].y;
        }
#pragma unroll 16
        for (int j = 0; j < 16; ++j) {
            const int k = d == 0 ? j : 15 - j; const size_t row = (size_t)sb * 256 + 16 * k + (d == 0 ? 15 : 0);
            car[((size_t)d * 2048 + sb * 16 + k) * RW + ch] = c;
            const unsigned w = ab[(row * RW + ch) * 2 + d];
            c = h2lo(w) * c + h2hi(w);
        }
    }
}
__device__ __forceinline__ void phase_scan_apply(const Params& p, int bid, int nblk) {
    unsigned char* ws = p.ws;
    const unsigned char* ab = ws + B_AB; const float* car = (const float*)(ws + B_CAR); const bf16_t* gate0 = (const bf16_t*)(ws + B_GATE0); bf16_t* z0 = (bf16_t*)(ws + B_Z0);
    const int gt = bid * NTHR + opq_tid(), ngt = nblk * NTHR;
    for (int item = gt; item < 2048 * 320; item += ngt) {
        const int blk = item / 320, c4 = (item % 320) * 4;
        const f32x4 cf = *(const f32x4*)(car + (size_t)blk * RW + c4), cb = *(const f32x4*)(car + ((size_t)2048 + blk) * RW + c4);
#pragma unroll 8
        for (int r = 0; r < 16; ++r) {
            const size_t e = ((size_t)blk * 16 + r) * RW + c4;
            const u32x4 w0 = *(const u32x4*)(ab + e * 8), w1 = *(const u32x4*)(ab + e * 8 + 16);
            const u32x2 g = *(const u32x2*)(gate0 + e);
            const float y0 = (h2hi(w0.x) + h2lo(w0.x) * cf.x) + (h2hi(w0.y) + h2lo(w0.y) * cb.x);
            const float y1 = (h2hi(w0.z) + h2lo(w0.z) * cf.y) + (h2hi(w0.w) + h2lo(w0.w) * cb.y);
            const float y2 = (h2hi(w1.x) + h2lo(w1.x) * cf.z) + (h2hi(w1.y) + h2lo(w1.y) * cb.z);
            const float y3 = (h2hi(w1.z) + h2lo(w1.z) * cf.w) + (h2hi(w1.w) + h2lo(w1.w) * cb.w);
            u32x2 o; o.x = pk2(bflo(g.x) * y0, bfhi(g.x) * y1); o.y = pk2(bflo(g.y) * y2, bfhi(g.y) * y3);
            *(u32x2*)(z0 + e) = o;
        }
    }
}

#define XB_TMO      128
#define XB_XCNT(j)  (256  + 64 * (j))
#define XB_XSUB(j)  (1280 + 64 * (j))
#define XB_XGEN(j)  (2304 + 64 * (j))
#define XB_TOP      3328
#define XB_TOPGEN   3392
#define XCD_BAR_WORDS 3456
#define XB_SPIN_CAP (1u << 18)
__device__ __forceinline__ unsigned xb_ld(unsigned* p)              { return __hip_atomic_load(p, __ATOMIC_RELAXED, __HIP_MEMORY_SCOPE_AGENT); }
__device__ __forceinline__ unsigned xb_add(unsigned* p, unsigned v) { return __hip_atomic_fetch_add(p, v, __ATOMIC_RELAXED, __HIP_MEMORY_SCOPE_AGENT); }
__device__ __forceinline__ unsigned xb_xcc_id() { return (unsigned)__builtin_amdgcn_s_getreg((3 << 11) | 20) & 0xFu; }
#define XB_SPIN(cond, bar) do { unsigned _sp = 0; while (cond) { __builtin_amdgcn_s_sleep(1); \
    if ((++_sp & 255u) == 0u) { if (xb_ld(&(bar)[XB_TMO])) break; if (_sp > XB_SPIN_CAP) { atomicAdd(&(bar)[XB_TMO], 1u); break; } } } } while (0)
struct XcdBarrier { unsigned* bar; unsigned x; volatile LAS unsigned* st; };
__device__ __forceinline__ XcdBarrier xcd_barrier_post(unsigned* bar, volatile LAS unsigned* st) {
    XcdBarrier b; b.bar = bar; b.x = xb_xcc_id(); b.st = st;
    if (threadIdx.x == 0) (void)xb_add(&bar[XB_XCNT(b.x)], 1u);
    return b;
}
__device__ __forceinline__ void xcd_barrier_complete(unsigned* bar, unsigned x, unsigned& nloc, unsigned& nx) {
    const unsigned G = gridDim.x * gridDim.y * gridDim.z;
    unsigned sum, cnt, mine, sp = 0u;
    for (;;) {
        sum = 0u; cnt = 0u; mine = 0u;
#pragma unroll
        for (unsigned j = 0; j < 16; ++j) { const unsigned c = xb_ld(&bar[XB_XCNT(j)]); sum += c; cnt += (c > 0u) ? 1u : 0u; mine = (j == x) ? c : mine; }
        if (sum == G) break;
        __builtin_amdgcn_s_sleep(1);
        if ((++sp & 255u) == 0u) { if (xb_ld(&bar[XB_TMO])) break; if (sp > XB_SPIN_CAP) { atomicAdd(&bar[XB_TMO], 1u); break; } }
    }
    nloc = mine > 0u ? mine : 1u; nx = cnt > 0u ? cnt : 1u;
}
__device__ __forceinline__ void xcd_barrier(const XcdBarrier& b) {
    asm volatile("s_waitcnt vmcnt(0)" ::: "memory");
    __syncthreads();
    if (threadIdx.x == 0) {
        unsigned* bar = b.bar;
        __builtin_amdgcn_s_waitcnt(0);
        unsigned nloc = b.st[0], nx = b.st[1];
        if (nloc == 0u) { xcd_barrier_complete(bar, b.x, nloc, nx); b.st[0] = nloc; b.st[1] = nx; }
        const unsigned old = xb_add(&bar[XB_XSUB(b.x)], 1u);
        const unsigned gen = old / nloc;
        if (old + 1u == (gen + 1u) * nloc) {
            __builtin_amdgcn_fence(__ATOMIC_RELEASE, "agent");
            asm volatile("s_waitcnt vmcnt(0)" ::: "memory");
            const unsigned og = xb_add(&bar[XB_TOP], 1u);
            const unsigned tg = og / nx;
            if (og + 1u == (tg + 1u) * nx) xb_add(&bar[XB_TOPGEN], 1u);
            else XB_SPIN(xb_ld(&bar[XB_TOPGEN]) == tg, bar);
            __builtin_amdgcn_fence(__ATOMIC_ACQUIRE, "agent");
            xb_add(&bar[XB_XGEN(b.x)], 1u);
            asm volatile("s_waitcnt vmcnt(0)" ::: "memory");
        } else {
            XB_SPIN(xb_ld(&bar[XB_XGEN(b.x)]) == gen, bar);
            __builtin_amdgcn_fence(__ATOMIC_ACQUIRE, "agent");
            asm volatile("s_waitcnt vmcnt(0)" ::: "memory");
        }
    }
    __syncthreads();
}

#ifndef PROBE_G
#define PROBE_G 0
#endif
#define PH(g, call) do { unsigned long long _t0 = 0; if (PROBE_G == (g)) _t0 = __builtin_amdgcn_s_memrealtime(); call; xcd_barrier(xb); if (PROBE_G == (g)) tacc += __builtin_amdgcn_s_memrealtime() - _t0; } while (0)
__global__ void __launch_bounds__(NTHR) mk_fwd(Params p) {
    extern __shared__ __attribute__((aligned(16))) unsigned char lds_raw[];
    LAS unsigned char* lds = (LAS unsigned char*)lds_raw;
    cg::grid_group grid = cg::this_grid();
    const int bid = blockIdx.x, nblk = gridDim.x;
    unsigned char* ws = p.ws;
    const float* mod0 = (const float*)(ws + OFF_MOD); const float* mod1 = mod0 + 5 * 6144;
    unsigned long long tacc = 0;
    { volatile LAS unsigned* st0 = (volatile LAS unsigned*)(lds + LDS_BYTES - 16); if (threadIdx.x < 4) st0[threadIdx.x] = 0u; }
    __syncthreads();
    XcdBarrier xb = xcd_barrier_post((unsigned*)ws, (volatile LAS unsigned*)(lds + LDS_BYTES - 16));
    { unsigned long long _t0 = 0; if (PROBE_G == 1) _t0 = __builtin_amdgcn_s_memrealtime();
      phase0(p, lds, bid, nblk);
      if (p.ws == nullptr) grid.sync();
      xcd_barrier(xb);
      if (PROBE_G == 1) tacc += __builtin_amdgcn_s_memrealtime() - _t0; }
    PH(2, (row_phase<0, false, false>(p, bid, nblk, p.in[6], mod0, 0, 1024, nullptr, nullptr)));
    PH(6, phase_inproj0_pg(p, lds, bid, nblk));
    PH(12, phase_conv(p, bid, nblk));
    PH(7, phase_gates_pg(p, lds, bid, nblk));
    PH(3, phase_scan_sb(p, bid, nblk));
    PH(3, phase_scan_carry(p, bid, nblk));
    PH(13, phase_scan_apply(p, bid, nblk));
    PH(6, phase_outproj_pg(p, lds, bid, nblk, (const bf16_t*)(ws + B_Z0), RW, (const bf16_t*)(ws + W_AOUT), mod0, ws + B_DX0));
    PH(4, phase_normroute(p, lds, bid, nblk, 0, p.in[7], mod0, (const bf16_t*)(ws + B_DX0)));
    PH(10, phase_scatter(p, lds, bid, nblk, 0));
    PH(8, phase_moe_up(p, lds, bid, nblk, 0));
    PH(9, phase_moe_down(p, lds, bid, nblk, 0));
    PH(2, (row_phase<2, false, false>(p, bid, nblk, p.in[6] + D, mod1, 0, 1024, mod0, nullptr)));
    PH(6, phase_inproj1_pg(p, lds, bid, nblk));
    PH(11, phase_sgu(p, lds, bid, nblk));
    PH(6, phase_outproj_pg(p, lds, bid, nblk, (const bf16_t*)(ws + B_Z1), SW, (const bf16_t*)(ws + W_BOUT), mod1, ws + B_DX1));
    PH(4, phase_normroute(p, lds, bid, nblk, 1, p.in[7] + D, mod1, (const bf16_t*)(ws + B_DX1)));
    PH(10, phase_scatter(p, lds, bid, nblk, 1));
    PH(8, phase_moe_up(p, lds, bid, nblk, 1));
    PH(9, phase_moe_down(p, lds, bid, nblk, 1));
    { unsigned long long _t0 = 0; if (PROBE_G == 2) _t0 = __builtin_amdgcn_s_memrealtime();
      row_phase<2, false, true>(p, bid, nblk, p.in[29], mod1, 0, 0, mod1, nullptr);
      if (PROBE_G == 2) tacc += __builtin_amdgcn_s_memrealtime() - _t0; }
    if (PROBE_G != 0 && bid == 0 && threadIdx.x == 0) {
        const unsigned long long t0 = __builtin_amdgcn_s_memrealtime();
        while (__builtin_amdgcn_s_memrealtime() - t0 < 3ull * tacc) __builtin_amdgcn_s_sleep(20);
    }
}

extern "C" void kernel_launch(void* const* d_in, const int* in_sizes, int n_in, void* d_out, int out_size, void* d_ws, size_t ws_size, hipStream_t stream) {
    static int grid_blocks = 0;
    if (grid_blocks == 0) {
        if (n_in != 30 || out_size != NTOK * D || ws_size < WS_NEED) { fprintf(stderr, "kernel_launch: unexpected shapes (n_in %d out %d ws %zu need %zu)\n", n_in, out_size, ws_size, (size_t)WS_NEED); grid_blocks = -1; return; }
        int dev = 0, cus = 0, per_cu = 0;
        (void)hipGetDevice(&dev);
        (void)hipDeviceGetAttribute(&cus, hipDeviceAttributeMultiprocessorCount, dev);
        if (hipFuncSetAttribute((const void*)mk_fwd, hipFuncAttributeMaxDynamicSharedMemorySize, LDS_BYTES) != hipSuccess) { fprintf(stderr, "kernel_launch: hipFuncSetAttribute failed\n"); grid_blocks = -1; return; }
        (void)hipOccupancyMaxActiveBlocksPerMultiprocessor(&per_cu, mk_fwd, NTHR, LDS_BYTES);
        if (per_cu < 1) per_cu = 1;
        if (per_cu > 2) per_cu = 2;
        grid_blocks = cus * per_cu;
        fprintf(stderr, "kernel_launch: cus %d per_cu %d grid %d\n", cus, per_cu, grid_blocks);
    }
    if (grid_blocks < 0) return;
    if (hipMemsetAsync(d_ws, 0, 65536, stream) != hipSuccess) { fprintf(stderr, "kernel_launch: memset failed\n"); return; }
    Params p{};
    for (int i = 0; i < 30; ++i) p.in[i] = (const float*)d_in[i];
    p.out = (float*)d_out; p.ws = (unsigned char*)d_ws;
    void* args[] = {&p};
    hipError_t e = hipLaunchCooperativeKernel((void*)mk_fwd, dim3(grid_blocks), dim3(NTHR), args, LDS_BYTES, stream);
    if (e != hipSuccess) fprintf(stderr, "cooperative launch failed: %s (grid %d)\n", hipGetErrorString(e), grid_blocks);
}
```
